# Optimizing an MI355X kernel written in HIP

```python
import math
import jax, jax.numpy as jnp
from jax import lax
import numpy as np

D_MODEL = 2048
BATCH = 8
SEQ = 2048
DEPTH = 1

SSM_WIDTH = D_MODEL // 2
SSM_GROUP_CH = 16
SSM_GROUPS = SSM_WIDTH // SSM_GROUP_CH
SSM_STATE = 64
N_HEADS = 8
HEAD_DIM = 128
N_KV_HEADS = 2
GQA_GROUP = N_HEADS // N_KV_HEADS
ATTN_WIDTH = N_HEADS * HEAD_DIM
KV_WIDTH = N_KV_HEADS * HEAD_DIM
MIX_WIDTH = SSM_WIDTH + ATTN_WIDTH
N_IDX_HEADS = 16
IDX_DIM = 64
INDEX_TOPK = 256
Q_BLOCK = 128
D_FF = 5632
CONV_WIDTH = 3
LN_EPS = 1e-5
DEEPNORM_ALPHA = (2.0 * DEPTH) ** 0.25
DEEPNORM_BETA = (8.0 * DEPTH) ** -0.25
IN_SPLITS = (SSM_WIDTH, ATTN_WIDTH, KV_WIDTH, KV_WIDTH, N_IDX_HEADS * IDX_DIM, IDX_DIM, N_IDX_HEADS)
N_IN = sum(IN_SPLITS)

kernel_name = "hymba_s5_dsa_alibi_convffn_deepnorm"


def _layer_norm(x, g, b):
    xf = x.astype(jnp.float32)
    mu = jnp.mean(xf, axis=-1, keepdims=True)
    xc = xf - mu
    var = jnp.mean(xc * xc, axis=-1, keepdims=True)
    y = xc * lax.rsqrt(var + LN_EPS) * g.astype(jnp.float32) + b.astype(jnp.float32)
    return y.astype(x.dtype)


def _complex_linear_combine(left, right):
    a1r, a1i, b1r, b1i = left
    a2r, a2i, b2r, b2i = right
    ar = a2r * a1r - a2i * a1i
    ai = a2r * a1i + a2i * a1r
    br = a2r * b1r - a2i * b1i + b2r
    bi = a2r * b1i + a2i * b1r + b2i
    return (ar, ai, br, bi)


def _s5_mixer(u, a_re, a_im, log_dt, b_re, b_im, c_re, c_im, d, w_glu, b_glu):
    bsz, seq, _ = u.shape
    f32 = jnp.float32
    uf = u.astype(f32).reshape(bsz, seq, SSM_GROUPS, SSM_GROUP_CH)
    a_re = a_re.astype(f32)
    a_im = a_im.astype(f32)
    dt = jnp.exp(log_dt.astype(f32))[:, None]
    mag = jnp.exp(dt * a_re)
    ang = dt * a_im
    abar_re = mag * jnp.cos(ang)
    abar_im = mag * jnp.sin(ang)
    num_re = abar_re - 1.0
    num_im = abar_im
    den = a_re * a_re + a_im * a_im
    f_re = (num_re * a_re + num_im * a_im) / den
    f_im = (num_im * a_re - num_re * a_im) / den
    b_re = b_re.astype(f32)
    b_im = b_im.astype(f32)
    bbar_re = f_re[..., None] * b_re - f_im[..., None] * b_im
    bbar_im = f_re[..., None] * b_im + f_im[..., None] * b_re
    bu_re = jnp.einsum('bsgh,gph->bsgp', uf, bbar_re)
    bu_im = jnp.einsum('bsgh,gph->bsgp', uf, bbar_im)
    a_full_re = jnp.broadcast_to(abar_re, bu_re.shape)
    a_full_im = jnp.broadcast_to(abar_im, bu_re.shape)
    _, _, h_re, h_im = lax.associative_scan(
        _complex_linear_combine, (a_full_re, a_full_im, bu_re, bu_im), axis=1)
    y = (jnp.einsum('bsgp,ghp->bsgh', h_re, c_re.astype(f32))
         - jnp.einsum('bsgp,ghp->bsgh', h_im, c_im.astype(f32))
         + d.astype(f32) * uf)
    y = jax.nn.gelu(y.reshape(bsz, seq, SSM_WIDTH), approximate=False).astype(u.dtype)
    return y * jax.nn.sigmoid(y @ w_glu + b_glu)


def _alibi_slopes():
    h = jnp.arange(1, N_HEADS + 1, dtype=jnp.float32)
    return jnp.exp2(-8.0 * h / N_HEADS)


def _dsa_attention(q, k, v, q_idx, k_idx, w_idx):
    bsz, seq = q.shape[0], q.shape[1]
    n_keep = min(INDEX_TOPK, seq // 4)
    n_blocks = seq // Q_BLOCK
    slopes = _alibi_slopes().reshape(N_KV_HEADS, GQA_GROUP)
    key_pos = jnp.arange(seq, dtype=jnp.int32)
    scale = HEAD_DIM ** -0.5

    def to_blocks(a):
        return a.reshape(bsz, n_blocks, Q_BLOCK, *a.shape[2:]).swapaxes(0, 1)

    def block_fn(args):
        qb, qib, wb, blk = args
        t = blk * Q_BLOCK + jnp.arange(Q_BLOCK, dtype=jnp.int32)
        rel = jax.nn.relu(jnp.einsum('bqhd,bsd->bqhs', qib, k_idx))
        idx_score = jnp.einsum('bqh,bqhs->bqs', wb, rel).astype(jnp.float32)
        causal = key_pos[None, :] <= t[:, None]
        idx_score = jnp.where(causal[None], idx_score, -jnp.inf)
        _, sel = lax.top_k(idx_score, n_keep)
        valid = sel <= t[None, :, None]
        kg = jax.vmap(lambda kb, ib: kb[ib])(k, sel)
        vg = jax.vmap(lambda vb, ib: vb[ib])(v, sel)
        qg = qb.reshape(bsz, Q_BLOCK, N_KV_HEADS, GQA_GROUP, HEAD_DIM)
        logits = jnp.einsum('bqcgd,bqkcd->bqcgk', qg, kg).astype(jnp.float32) * scale
        dist = (t[None, :, None] - sel).astype(jnp.float32)
        logits = logits - slopes[None, None, :, :, None] * dist[:, :, None, None, :]
        logits = jnp.where(valid[:, :, None, None, :], logits, -jnp.inf)
        probs = jax.nn.softmax(logits, axis=-1).astype(vg.dtype)
        o = jnp.einsum('bqcgk,bqkcd->bqcgd', probs, vg)
        return o.reshape(bsz, Q_BLOCK, ATTN_WIDTH)

    out = lax.map(block_fn, (to_blocks(q), to_blocks(q_idx), to_blocks(w_idx),
                             jnp.arange(n_blocks, dtype=jnp.int32)))
    return out.swapaxes(0, 1).reshape(bsz, seq, ATTN_WIDTH)


def _conv_ffn(x, w_up, w_gate, conv_w, conv_b, w_down):
    seq = x.shape[1]
    h = x @ w_up
    hp = jnp.pad(h, ((0, 0), (CONV_WIDTH - 1, 0), (0, 0)))
    hc = conv_b + sum(conv_w[i] * hp[:, i:i + seq] for i in range(CONV_WIDTH))
    return (jax.nn.gelu(hc, approximate=False) * (x @ w_gate)) @ w_down


def setup_inputs(seed: int = 0) -> dict:
    key = jax.random.key(seed)
    ks = jax.random.split(key, 24)
    f32 = jnp.float32
    L = DEPTH

    def nrm(k, shape, scale):
        return jax.random.normal(k, shape, f32) * scale

    n = jnp.arange(SSM_STATE, dtype=f32)
    G, P, HG = SSM_GROUPS, SSM_STATE, SSM_GROUP_CH
    return {
        "x": nrm(ks[0], (BATCH, SEQ, D_MODEL), 1.0),
        "w_in": nrm(ks[1], (L, D_MODEL, N_IN), D_MODEL ** -0.5),
        "ssm_a_re": -0.5 * jnp.exp(nrm(ks[2], (L, G, P), 0.02)),
        "ssm_a_im": math.pi * n + nrm(ks[3], (L, G, P), 0.02),
        "ssm_log_dt": jax.random.uniform(ks[4], (L, G), f32, math.log(1e-3), math.log(1e-1)),
        "ssm_b_re": nrm(ks[5], (L, G, P, HG), (2.0 * HG) ** -0.5),
        "ssm_b_im": nrm(ks[6], (L, G, P, HG), (2.0 * HG) ** -0.5),
        "ssm_c_re": nrm(ks[7], (L, G, HG, P), P ** -0.5),
        "ssm_c_im": nrm(ks[8], (L, G, HG, P), P ** -0.5),
        "ssm_d": nrm(ks[9], (L, G, HG), 1.0),
        "w_glu": nrm(ks[10], (L, SSM_WIDTH, SSM_WIDTH), SSM_WIDTH ** -0.5),
        "b_glu": nrm(ks[11], (L, SSM_WIDTH), 0.01),
        "w_out": nrm(ks[12], (L, MIX_WIDTH, D_MODEL), MIX_WIDTH ** -0.5 * DEEPNORM_BETA),
        "ln1_g": 1.0 + nrm(ks[13], (L, D_MODEL), 0.02),
        "ln1_b": nrm(ks[14], (L, D_MODEL), 0.02),
        "w_up": nrm(ks[15], (L, D_MODEL, D_FF), D_MODEL ** -0.5),
        "w_gate": nrm(ks[16], (L, D_MODEL, D_FF), D_MODEL ** -0.5),
        "conv_w": nrm(ks[17], (L, CONV_WIDTH, D_FF), CONV_WIDTH ** -0.5),
        "conv_b": nrm(ks[18], (L, D_FF), 0.01),
        "w_down": nrm(ks[19], (L, D_FF, D_MODEL), D_FF ** -0.5 * DEEPNORM_BETA),
        "ln2_g": 1.0 + nrm(ks[20], (L, D_MODEL), 0.02),
        "ln2_b": nrm(ks[21], (L, D_MODEL), 0.02),
    }


def reference(x, w_in, ssm_a_re, ssm_a_im, ssm_log_dt, ssm_b_re, ssm_b_im, ssm_c_re,
              ssm_c_im, ssm_d, w_glu, b_glu, w_out, ln1_g, ln1_b, w_up, w_gate,
              conv_w, conv_b, w_down, ln2_g, ln2_b):
    bsz, seq, _ = x.shape
    split_at = [int(s) for s in np.cumsum(IN_SPLITS)[:-1]]
    idx_w_scale = (N_IDX_HEADS ** -0.5) * (IDX_DIM ** -0.5)
    h = x
    for l in range(DEPTH):
        proj = h @ w_in[l]
        u_ssm, q, k, v, qi, ki, wi = jnp.split(proj, split_at, axis=-1)
        q = q.reshape(bsz, seq, N_HEADS, HEAD_DIM)
        k = k.reshape(bsz, seq, N_KV_HEADS, HEAD_DIM)
        v = v.reshape(bsz, seq, N_KV_HEADS, HEAD_DIM)
        qi = qi.reshape(bsz, seq, N_IDX_HEADS, IDX_DIM)
        wi = wi * idx_w_scale
        y_ssm = _s5_mixer(u_ssm, ssm_a_re[l], ssm_a_im[l], ssm_log_dt[l], ssm_b_re[l],
                          ssm_b_im[l], ssm_c_re[l], ssm_c_im[l], ssm_d[l], w_glu[l], b_glu[l])
        y_attn = _dsa_attention(q, k, v, qi, ki, wi)
        mix = jnp.concatenate([y_ssm.astype(h.dtype), y_attn.astype(h.dtype)], axis=-1) @ w_out[l]
        h = _layer_norm(DEEPNORM_ALPHA * h + mix, ln1_g[l], ln1_b[l])
        f = _conv_ffn(h, w_up[l], w_gate[l], conv_w[l], conv_b[l], w_down[l])
        h = _layer_norm(DEEPNORM_ALPHA * h + f, ln2_g[l], ln2_b[l])
    return h
```

```cpp
#include <hip/hip_runtime.h>
#include <cstdio>
#include <cstdint>
namespace pg8 {
#define PG8_LAS __attribute__((address_space(3)))
typedef unsigned short bf16_t;
typedef short bf16x8 __attribute__((ext_vector_type(8)));
typedef float f32x4 __attribute__((ext_vector_type(4)));
typedef unsigned u32x4 __attribute__((ext_vector_type(4)));
typedef int v8i32 __attribute__((ext_vector_type(8)));
constexpr int BM = 256, BK = 64, HALF = 128, HTB = HALF * BK * 2  , STAGE_BYTES = 8 * HTB, NXCD = 8, WGM = 8;

__host__ __device__ __forceinline__ int lds_byte(int r, int c) { const int st = (r >> 4) * 2 + (c >> 5), rr = r & 15, cc = c & 31, ob = rr * 64 + cc * 2; return st * 1024 + (ob ^ (((ob >> 9) & 1) << 5)); }
__host__ __device__ __forceinline__ void stage_rc(int b, int& R, int& C) { const int st = b / 1024, sb = b % 1024, swz = sb ^ (((sb >> 9) & 1) << 5); R = (st >> 1) * 16 + swz / 64; C = (st & 1) * 32 + (swz % 64) / 2; }
__host__ __device__ __forceinline__ int perm32(int rho) { const int n = rho >> 4, i = rho & 15; return 8 * (i >> 2) + 4 * n + (i & 3); }

struct Unit { int pm, pn; };
struct Gemm { const bf16_t* A; const bf16_t* Bt; int M, N, K; };

struct StaticOrder {
    int nM, nN, nwg, G, c;
    __host__ __device__ void init(int M, int N, int G_, int c_) { nM = M / BM; nN = N / BM; nwg = nM * nN; G = G_; c = c_; }
    __host__ __device__ bool next(int i, Unit& u) const {
        const long L = (long)i * G + c; if (L >= nwg) return false;
        int wgid = (int)L; { const int q = nwg / NXCD, r = nwg % NXCD, xcd = wgid % NXCD, off = wgid / NXCD; wgid = (xcd < r ? xcd * (q + 1) : r * (q + 1) + (xcd - r) * q) + off; }
        const int nig = WGM * nN, gid = wgid / nig, fm = gid * WGM, gsz = (nM - fm) < WGM ? (nM - fm) : WGM;
        u.pm = fm + ((wgid % nig) % gsz); u.pn = (wgid % nig) / gsz; return true;
    }
    __device__ __forceinline__ void a_ready(const Unit&) const {}
    __device__ __forceinline__ void done(const Unit&) const {}
};

struct ListOrder {
    int nM, nN, nwg, L0, dL, cnt;
    __host__ __device__ void init(int M, int N, int L0_, int dL_, int cnt_) { nM = M / BM; nN = N / BM; nwg = nM * nN; L0 = L0_; dL = dL_; cnt = cnt_; }
    __host__ __device__ bool next(int i, Unit& u) const {
        if (i >= cnt) return false; const int L = L0 + i * dL; if (L >= nwg) return false;
        int wgid = L; { const int q = nwg / NXCD, r = nwg % NXCD, xcd = wgid % NXCD, off = wgid / NXCD; wgid = (xcd < r ? xcd * (q + 1) : r * (q + 1) + (xcd - r) * q) + off; }
        const int nig = WGM * nN, gid = wgid / nig, fm = gid * WGM, gsz = (nM - fm) < WGM ? (nM - fm) : WGM;
        u.pm = fm + ((wgid % nig) % gsz); u.pn = (wgid % nig) / gsz; return true;
    }
    __device__ __forceinline__ void a_ready(const Unit&) const {}
    __device__ __forceinline__ void done(const Unit&) const {}
};

__device__ __forceinline__ unsigned cvt_pk_bf16(float lo, float hi) { unsigned r; asm volatile("v_cvt_pk_bf16_f32 %0, %1, %2" : "=v"(r) : "v"(lo), "v"(hi)); return r; }
typedef float f32x2 __attribute__((ext_vector_type(2)));
__device__ __forceinline__ f32x2 gelu_pk(f32x2 v) {
    f32x2 vc; vc.x = __builtin_amdgcn_fmed3f(v.x, -4.6f, 4.6f); vc.y = __builtin_amdgcn_fmed3f(v.y, -4.6f, 4.6f);
    const f32x2 w = vc * vc;
    f32x2 r = w * 7.3846917937e-14f + (-9.6073152826e-12f);
    r = r * w + 5.6255834838e-10f; r = r * w + (-1.9781858177e-08f); r = r * w + 4.7227388803e-07f; r = r * w + (-8.2408235147e-06f); r = r * w + 1.1056416036e-04f;
    r = r * w + (-1.1755027258e-03f); r = r * w + 9.9585457053e-03f; r = r * w + (-6.6482846440e-02f); r = r * w + 3.9894164923e-01f;
    return v * (vc * r + 0.5f);
}

template <int ACT  > struct EpiBf16 {
    static constexpr bool PERM = true, AFTER_DRAIN = false; static_assert(ACT == 0 || ACT == 1, "EpiBf16: ACT is 0 (none) or 1 (gelu_pk)");
    bf16_t* O; int ldc; const float* bias; int split_cols; size_t split_stride; float scale0;
    __device__ __forceinline__ void operator()(const f32x4 (&acc)[2][2][4][2], const Unit& u, int wr, int wc, int fr, int fq) const {
        const int row0 = u.pm * BM + wr * 64 + fr; int colt = u.pn * BM; bf16_t* base = O;
        float sc = 1.f; if (split_cols) { const int t = colt / split_cols; base += (size_t)t * split_stride; colt -= t * split_cols; if (t == 0) sc = scale0; }
        const int col0 = colt + wc * 32 + 8 * fq, bcol0 = u.pn * BM + wc * 32 + 8 * fq;
        f32x4 bv[2][2];
#pragma unroll
        for (int bj = 0; bj < 2; ++bj)
#pragma unroll
            for (int n = 0; n < 2; ++n) bv[bj][n] = bias ? *(const f32x4*)(bias + bcol0 + bj * HALF + 4 * n) : (f32x4){0.f, 0.f, 0.f, 0.f};
#pragma unroll
        for (int ai = 0; ai < 2; ++ai)
#pragma unroll
            for (int m = 0; m < 4; ++m) { bf16_t* rowp = base + (size_t)(row0 + ai * HALF + m * 16) * ldc + col0;
#pragma unroll
                for (int bj = 0; bj < 2; ++bj) { f32x4 v0 = acc[ai][bj][m][0] + bv[bj][0], v1 = acc[ai][bj][m][1] + bv[bj][1];
                    if (ACT == 1) { f32x2 a = gelu_pk((f32x2){v0[0], v0[1]}), b = gelu_pk((f32x2){v0[2], v0[3]}), c = gelu_pk((f32x2){v1[0], v1[1]}), d = gelu_pk((f32x2){v1[2], v1[3]});
                        v0 = (f32x4){a.x, a.y, b.x, b.y}; v1 = (f32x4){c.x, c.y, d.x, d.y}; }
                    v0 = v0 * sc; v1 = v1 * sc; u32x4 w; w.x = cvt_pk_bf16(v0[0], v0[1]); w.y = cvt_pk_bf16(v0[2], v0[3]); w.z = cvt_pk_bf16(v1[0], v1[1]); w.w = cvt_pk_bf16(v1[2], v1[3]);
                    *(u32x4*)(rowp + bj * HALF) = w; } }
    }
};

__device__ __forceinline__ float bf2f(unsigned short b) { return __uint_as_float(((unsigned)b) << 16); }
__device__ __forceinline__ float bflo(unsigned w) { return __uint_as_float(w << 16); }
__device__ __forceinline__ float bfhi(unsigned w) { return __uint_as_float(w & 0xffff0000u); }
__device__ __forceinline__ float dpp_ror1(float x) { return __builtin_bit_cast(float, __builtin_amdgcn_update_dpp(0, __builtin_bit_cast(int, x), 0x121, 0xf, 0xf, false)); }
__device__ __forceinline__ float dpp_ror2(float x) { return __builtin_bit_cast(float, __builtin_amdgcn_update_dpp(0, __builtin_bit_cast(int, x), 0x122, 0xf, 0xf, false)); }
__device__ __forceinline__ float clamp448(float v) { return __builtin_amdgcn_fmed3f(v, -448.f, 448.f); }
__device__ __forceinline__ unsigned pk4_fp8(float a, float b, float c, float d) {
    int w = 0; w = __builtin_amdgcn_cvt_pk_fp8_f32(clamp448(a), clamp448(b), w, false); w = __builtin_amdgcn_cvt_pk_fp8_f32(clamp448(c), clamp448(d), w, true); return (unsigned)w; }
__device__ __forceinline__ float sigmoidf_fast(float v) { return __builtin_amdgcn_rcpf(1.0f + __builtin_amdgcn_exp2f(-1.4426950408889634f * v)); }

struct EpiProj {
    static constexpr bool PERM = true, AFTER_DRAIN = false;
    bf16_t* O; int ldc; bf16_t* kipack; int kcol0; int seq; int col_off; float ascale;
    __device__ __forceinline__ void operator()(const f32x4 (&acc)[2][2][4][2], const Unit& u, int wr, int wc, int fr, int fq) const {
        const int row0 = u.pm * BM + wr * 64 + fr, col0 = col_off + u.pn * BM + wc * 32 + 8 * fq;
        const bool kt_tile = (col_off + u.pn * BM == kcol0) && (wc < 2);
#pragma unroll
        for (int ai = 0; ai < 2; ++ai)
#pragma unroll
            for (int m = 0; m < 4; ++m) { const int row = row0 + ai * HALF + m * 16; bf16_t* rowp = O + (size_t)row * ldc + col0;
#pragma unroll
                for (int bj = 0; bj < 2; ++bj) { const f32x4 v0 = acc[ai][bj][m][0] * ascale, v1 = acc[ai][bj][m][1] * ascale;
                    u32x4 w; w.x = cvt_pk_bf16(v0[0], v0[1]); w.y = cvt_pk_bf16(v0[2], v0[3]); w.z = cvt_pk_bf16(v1[0], v1[1]); w.w = cvt_pk_bf16(v1[2], v1[3]);
                    *(u32x4*)(rowp + bj * HALF) = w;
                    if (bj == 0 && kt_tile) { const int b = row / seq, t = row % seq, d0 = wc * 32 + 8 * fq;
                        *(u32x4*)(kipack + ((size_t)((b * (seq / 32) + (t >> 5)) * 4 + (d0 >> 4)) * 64 + (t & 31) + 32 * ((d0 >> 3) & 1)) * 8) = w; } } }
    }
};
struct EpiGlu {
    static constexpr bool PERM = true, AFTER_DRAIN = false;
    const bf16_t* yg; unsigned char* O; int ldy, ldo; const float* bias; float oscale;
    __device__ __forceinline__ void operator()(const f32x4 (&acc)[2][2][4][2], const Unit& u, int wr, int wc, int fr, int fq) const {
        const int row0 = u.pm * BM + wr * 64 + fr, col0 = u.pn * BM + wc * 32 + 8 * fq;
        f32x4 bv[2][2];
#pragma unroll
        for (int bj = 0; bj < 2; ++bj)
#pragma unroll
            for (int n = 0; n < 2; ++n) bv[bj][n] = *(const f32x4*)(bias + col0 + bj * HALF + 4 * n);
#pragma unroll
        for (int ai = 0; ai < 2; ++ai)
#pragma unroll
            for (int m = 0; m < 4; ++m) { const size_t row = (size_t)(row0 + ai * HALF + m * 16);
#pragma unroll
                for (int bj = 0; bj < 2; ++bj) { const int c = col0 + bj * HALF;
                    const u32x4 yv = *(const u32x4*)(yg + row * ldy + c);
                    const f32x4 v0 = acc[ai][bj][m][0] + bv[bj][0], v1 = acc[ai][bj][m][1] + bv[bj][1];
                    float o[8];
                    o[0] = bflo(yv.x) * sigmoidf_fast(v0[0]); o[1] = bfhi(yv.x) * sigmoidf_fast(v0[1]); o[2] = bflo(yv.y) * sigmoidf_fast(v0[2]); o[3] = bfhi(yv.y) * sigmoidf_fast(v0[3]);
                    o[4] = bflo(yv.z) * sigmoidf_fast(v1[0]); o[5] = bfhi(yv.z) * sigmoidf_fast(v1[1]); o[6] = bflo(yv.w) * sigmoidf_fast(v1[2]); o[7] = bfhi(yv.w) * sigmoidf_fast(v1[3]);
                    typedef unsigned u32x2v __attribute__((ext_vector_type(2))); const float os = oscale;
                    u32x2v w; w.x = pk4_fp8(o[0] * os, o[1] * os, o[2] * os, o[3] * os); w.y = pk4_fp8(o[4] * os, o[5] * os, o[6] * os, o[7] * os);
                    *(u32x2v*)(O + row * ldo + c) = w; } }
    }
};
template <bool RES_BF16, bool OUT_BF16 = false> struct EpiRes {
    static constexpr bool PERM = false, AFTER_DRAIN = false;
    const void* res; float* out; int ldc; float alpha; float ascale;
    __device__ __forceinline__ void operator()(const f32x4 (&acc)[2][2][4][2], const Unit& u, int wr, int wc, int fr, int fq) const {
        typedef unsigned u32x2v __attribute__((ext_vector_type(2)));
        const int row0 = u.pm * BM + wr * 64 + fr, col0 = u.pn * BM + wc * 32 + 4 * fq;
#pragma unroll
        for (int ai = 0; ai < 2; ++ai)
#pragma unroll
            for (int m = 0; m < 4; ++m) { const size_t off = (size_t)(row0 + ai * HALF + m * 16) * ldc + col0;
#pragma unroll
                for (int bj = 0; bj < 2; ++bj)
#pragma unroll
                    for (int n = 0; n < 2; ++n) { const size_t o2 = off + bj * HALF + n * 16; f32x4 r;
                        if constexpr (RES_BF16) { const u32x2v w = *(const u32x2v*)((const bf16_t*)res + o2); r = (f32x4){bflo(w.x), bfhi(w.x), bflo(w.y), bfhi(w.y)}; }
                        else r = *(const f32x4*)((const float*)res + o2);
                        const f32x4 o = r * alpha + acc[ai][bj][m][n] * ascale;
                        if constexpr (OUT_BF16) { u32x2v w; w.x = cvt_pk_bf16(o[0], o[1]); w.y = cvt_pk_bf16(o[2], o[3]); *(u32x2v*)((bf16_t*)out + o2) = w; }
                        else *(f32x4*)(out + o2) = o; } }
    }
};
struct EpiDownLN {
    static constexpr bool PERM = false, AFTER_DRAIN = false;
    const bf16_t* r1; bf16_t* out; const f32x2* rstat; const float* gam; const float* bet; int ldc; float alpha, ascale;
    __device__ __forceinline__ void operator()(const f32x4 (&acc)[2][2][4][2], const Unit& u, int wr, int wc, int fr, int fq) const {
        typedef unsigned u32x2v __attribute__((ext_vector_type(2)));
        const int row0 = u.pm * BM + wr * 64 + fr, col0 = u.pn * BM + wc * 32 + 4 * fq;
        f32x4 gv[2][2], bv[2][2];
#pragma unroll
        for (int bj = 0; bj < 2; ++bj)
#pragma unroll
            for (int n = 0; n < 2; ++n) { gv[bj][n] = *(const f32x4*)(gam + col0 + bj * HALF + n * 16) * alpha; bv[bj][n] = *(const f32x4*)(bet + col0 + bj * HALF + n * 16) * alpha; }
#pragma unroll
        for (int ai = 0; ai < 2; ++ai)
#pragma unroll
            for (int m = 0; m < 4; ++m) { const int row = row0 + ai * HALF + m * 16; const f32x2 st = rstat[row]; const size_t off = (size_t)row * ldc + col0;
#pragma unroll
                for (int bj = 0; bj < 2; ++bj)
#pragma unroll
                    for (int n = 0; n < 2; ++n) { const size_t o2 = off + bj * HALF + n * 16; const u32x2v w0 = *(const u32x2v*)(r1 + o2);
                        const f32x4 r = {bflo(w0.x), bfhi(w0.x), bflo(w0.y), bfhi(w0.y)};
                        const f32x4 o = (r - st.x) * st.y * gv[bj][n] + bv[bj][n] + acc[ai][bj][m][n] * ascale;
                        u32x2v w; w.x = cvt_pk_bf16(o[0], o[1]); w.y = cvt_pk_bf16(o[2], o[3]); *(u32x2v*)(out + o2) = w; } }
    }
};
struct EpiFfn {
    static constexpr bool PERM = true, AFTER_DRAIN = false;
    unsigned char* act; float* pend_up; float* pend_gate; float* halo_up; const float* cw; const float* cb; int ldc; float ascale, oscale;
    __device__ __forceinline__ void operator()(const f32x4 (&acc)[2][2][4][2], const Unit& u, int wr, int wc, int fr, int fq) const {
        const int f0 = u.pn * HALF + wc * 32 + 8 * fq;
        float c0[8], c1[8], c2[8], cbv[8];
        { const f32x4 a0 = *(const f32x4*)(cw + f0), a1 = *(const f32x4*)(cw + f0 + 4), b0 = *(const f32x4*)(cw + ldc + f0), b1 = *(const f32x4*)(cw + ldc + f0 + 4);
          const f32x4 d0 = *(const f32x4*)(cw + 2 * ldc + f0), d1 = *(const f32x4*)(cw + 2 * ldc + f0 + 4), e0 = *(const f32x4*)(cb + f0), e1 = *(const f32x4*)(cb + f0 + 4);
#pragma unroll
          for (int j = 0; j < 4; ++j) { c0[j] = a0[j] * ascale; c0[4 + j] = a1[j] * ascale; c1[j] = b0[j] * ascale; c1[4 + j] = b1[j] * ascale; c2[j] = d0[j] * ascale; c2[4 + j] = d1[j] * ascale; cbv[j] = e0[j]; cbv[4 + j] = e1[j]; } }
        const float gs = ascale * oscale;
#pragma unroll
        for (int ai = 0; ai < 2; ++ai) {
            const int rb = u.pm * 4 + ai * 2 + wr;
#pragma unroll
            for (int m = 0; m < 4; ++m) {
                const size_t row = (size_t)(rb * 64 + m * 16 + fr);
                float a[8];
#pragma unroll
                for (int n = 0; n < 2; ++n)
#pragma unroll
                    for (int j = 0; j < 4; ++j) { const int e = 4 * n + j;
                        const float x0 = acc[ai][0][m][n][j];
                        float h1 = dpp_ror1(x0), h2 = dpp_ror2(x0);
                        if (m > 0) { const float xm = acc[ai][0][m - 1][n][j]; const float q1 = dpp_ror1(xm), q2 = dpp_ror2(xm); h1 = fr >= 1 ? h1 : q1; h2 = fr >= 2 ? h2 : q2; }
                        a[e] = cbv[e] + c0[e] * h2 + c1[e] * h1 + c2[e] * x0; }
                const f32x2 g0 = gelu_pk((f32x2){a[0], a[1]}), g1 = gelu_pk((f32x2){a[2], a[3]}), g2 = gelu_pk((f32x2){a[4], a[5]}), g3 = gelu_pk((f32x2){a[6], a[7]});
                const f32x4 gr0 = acc[ai][1][m][0], gr1 = acc[ai][1][m][1];
                const f32x2 o0 = g0 * (f32x2){gr0[0], gr0[1]} * gs, o1 = g1 * (f32x2){gr0[2], gr0[3]} * gs, o2 = g2 * (f32x2){gr1[0], gr1[1]} * gs, o3 = g3 * (f32x2){gr1[2], gr1[3]} * gs;
                typedef unsigned u32x2v __attribute__((ext_vector_type(2)));
                u32x2v w; w.x = pk4_fp8(o0.x, o0.y, o1.x, o1.y); w.y = pk4_fp8(o2.x, o2.y, o3.x, o3.y);
                if (m == 0) {
                    if (fr >= 2) *(u32x2v*)(act + row * ldc + f0) = w;
                    else { float* pu = pend_up + (size_t)(rb * 2 + fr) * ldc + f0; float* pg = pend_gate + (size_t)(rb * 2 + fr) * ldc + f0;
                        *(f32x4*)pu = acc[ai][0][m][0] * ascale; *(f32x4*)(pu + 4) = acc[ai][0][m][1] * ascale; *(f32x4*)pg = gr0 * ascale; *(f32x4*)(pg + 4) = gr1 * ascale; }
                } else {
                    *(u32x2v*)(act + row * ldc + f0) = w;
                    if (m == 3 && fr >= 14) { float* ph = halo_up + (size_t)(rb * 2 + (fr - 14)) * ldc + f0; *(f32x4*)ph = acc[ai][0][m][0] * ascale; *(f32x4*)(ph + 4) = acc[ai][0][m][1] * ascale; }
                }
            }
        }
    }
};
template <class Epi, class Sched, bool ALIGN_EPI = false, bool SP2 = false, bool F8 = false, bool F6 = false>
__device__ __forceinline__ void gemm_phase(PG8_LAS unsigned char* lds, const Gemm g, const Sched& S, const Epi& E) {
    const int tid = threadIdx.x, wid = __builtin_amdgcn_readfirstlane(tid >> 6), lane = tid & 63, wr = wid >> 2, wc = wid & 3, fr = lane & 15, fq = lane >> 4;
    const int K = g.K, nt = K / BK;
    unsigned voffA[2], voffB[2];
#pragma unroll
    for (int i = 0; i < 2; ++i) { int R, C; stage_rc(tid * 16 + i * 8192, R, C); const int Rb = Epi::PERM ? ((R & ~31) + perm32(R & 31)) : R;
        voffA[i] = (unsigned)(R * K + C) * 2u; voffB[i] = (unsigned)(Rb * K + C) * 2u; }
    const size_t kstep = (size_t)(BK * 2);
    const size_t hstep = (size_t)HALF * K * 2;
    const size_t tstep = 2 * hstep;
    const unsigned ldsw = (unsigned)wid * 1024u;
    const int aoff = lds_byte(wr * 64 + fr, fq * 8), boff = lds_byte(wc * 32 + fr, fq * 8);
#define PG8_SA(b, h) (((b) * 2 + (h)) * HTB)
#define PG8_SB(b, h) ((4 + (b) * 2 + (h)) * HTB)
#define PG8_STAGE(bufoff, gbase, voff) do { _Pragma("unroll") for (int _i = 0; _i < 2; ++_i) \
        __builtin_amdgcn_global_load_lds((const unsigned*)((const char*)(gbase) + (voff)[_i]), (PG8_LAS unsigned*)(lds + (bufoff) + ldsw + _i * 8192), 16, 0, 0); } while (0)
#define PG8_LDA(dst, b, h) do { _Pragma("unroll") for (int m = 0; m < 4; ++m) _Pragma("unroll") for (int k = 0; k < 2; ++k) dst[m][k] = *(const PG8_LAS bf16x8*)(lds + PG8_SA(b, h) + aoff + m * 2048 + k * 1024); } while (0)
#define PG8_LDB(dst, b, h) do { _Pragma("unroll") for (int n = 0; n < 2; ++n) _Pragma("unroll") for (int k = 0; k < 2; ++k) dst[n][k] = *(const PG8_LAS bf16x8*)(lds + PG8_SB(b, h) + boff + n * 2048 + k * 1024); } while (0)
#define PG8_CAT(lo, hi) __builtin_bit_cast(v8i32, __builtin_shufflevector(lo, hi, 0, 1, 2, 3, 4, 5, 6, 7, 8, 9, 10, 11, 12, 13, 14, 15))
#define PG8_MMA(ai, bj, At, Bt) do { __builtin_amdgcn_s_setprio(1); _Pragma("unroll") for (int m = 0; m < 4; ++m) _Pragma("unroll") for (int n = 0; n < 2; ++n) { \
        if constexpr (F8 && F6) { const v8i32 cb_ = PG8_CAT(Bt[n][0], Bt[n][1]), ca_ = PG8_CAT(At[m][0], At[m][1]); \
            asm volatile("s_nop 3\n\tv_mfma_scale_f32_16x16x128_f8f6f4 %0, %1, %2, %0, %3, %4 op_sel_hi:[0,0,0] cbsz:2 blgp:2" : "+v"(acc[ai][bj][m][n]) \
                         : "v"(__builtin_shufflevector(cb_, cb_, 0, 1, 2, 3, 4, 5)), "v"(__builtin_shufflevector(ca_, ca_, 0, 1, 2, 3, 4, 5)), "v"(cb_[6]), "v"(ca_[6])); } \
        else if constexpr (F8) asm volatile("v_mfma_scale_f32_16x16x128_f8f6f4 %0, %1, %2, %0, %3, %3 op_sel_hi:[0,0,0]" : "+v"(acc[ai][bj][m][n]) : "v"(PG8_CAT(Bt[n][0], Bt[n][1])), "v"(PG8_CAT(At[m][0], At[m][1])), "v"(f8scale)); \
        else { _Pragma("unroll") for (int k = 0; k < 2; ++k) acc[ai][bj][m][n] = __builtin_amdgcn_mfma_f32_16x16x32_bf16(Bt[n][k], At[m][k], acc[ai][bj][m][n], 0, 0, 0); } } __builtin_amdgcn_s_setprio(0); } while (0)
#define PG8_WAIT_V(n) asm volatile("s_waitcnt vmcnt(" #n ")" ::: "memory")
#define PG8_WAIT_L(n) asm volatile("s_waitcnt lgkmcnt(" #n ")" ::: "memory")
#define PG8_BAR __builtin_amdgcn_s_barrier()
#define PG8_SCHED __builtin_amdgcn_sched_barrier(0)
    Unit cur, nxt; int ui = 0;
    if (!S.next(0, cur)) return;
    const int f8scale = 0x7F7F7F7F;
    f32x4 acc[2][2][4][2];
#pragma unroll
    for (int a = 0; a < 2; ++a)
#pragma unroll
        for (int b = 0; b < 2; ++b)
#pragma unroll
            for (int m = 0; m < 4; ++m)
#pragma unroll
                for (int n = 0; n < 2; ++n) acc[a][b][m][n] = (f32x4){0.f, 0.f, 0.f, 0.f};
    bf16x8 At[4][2], B0[2][2], B1[2][2];
    const char* cA = (const char*)g.A + (size_t)cur.pm * tstep; const char* cB = (const char*)g.Bt + (size_t)cur.pn * tstep;
    S.a_ready(cur);
    if constexpr (SP2) {
        PG8_STAGE(PG8_SB(0, 0), cB, voffB); PG8_STAGE(PG8_SB(0, 1), cB + hstep, voffB); PG8_STAGE(PG8_SA(0, 0), cA, voffA); PG8_STAGE(PG8_SA(0, 1), cA + hstep, voffA);
        if (wr == 1) PG8_BAR;
        PG8_WAIT_V(2); PG8_BAR;
        PG8_STAGE(PG8_SB(1, 0), cB + kstep, voffB); PG8_STAGE(PG8_SA(1, 0), cA + kstep, voffA); PG8_STAGE(PG8_SB(1, 1), cB + hstep + kstep, voffB);
        PG8_WAIT_V(6); PG8_BAR;
    } else {
        PG8_STAGE(PG8_SB(0, 0), cB, voffB); PG8_STAGE(PG8_SA(0, 0), cA, voffA); PG8_STAGE(PG8_SB(0, 1), cB + hstep, voffB); PG8_STAGE(PG8_SA(0, 1), cA + hstep, voffA);
        if (wr == 1) PG8_BAR;
        PG8_WAIT_V(4); PG8_BAR;
        PG8_STAGE(PG8_SB(1, 0), cB + kstep, voffB); PG8_STAGE(PG8_SA(1, 0), cA + kstep, voffA); PG8_STAGE(PG8_SB(1, 1), cB + hstep + kstep, voffB);
        PG8_WAIT_V(6); PG8_BAR;
    }
    for (;;) {
        const bool has_next = S.next(ui + 1, nxt);
        const char* nA = has_next ? (const char*)g.A + (size_t)nxt.pm * tstep : cA; const char* nB = has_next ? (const char*)g.Bt + (size_t)nxt.pn * tstep : cB;
        for (int t = 0; t < nt; t += 2) {
            const bool last = (t == nt - 2);
            const char* a1 = cA + (size_t)(t + 1) * kstep;
            const char* a2 = last ? nA : cA + (size_t)(t + 2) * kstep; const char* b2 = last ? nB : cB + (size_t)(t + 2) * kstep;
            const char* a3 = a2 + kstep; const char* b3 = b2 + kstep;
            if (last && has_next) S.a_ready(nxt);
            if constexpr (SP2) {
            PG8_LDB(B0, 0, 0); PG8_LDB(B1, 0, 1); PG8_SCHED; PG8_LDA(At, 0, 0); PG8_STAGE(PG8_SA(1, 1), a1 + hstep, voffA);
            PG8_WAIT_V(8); PG8_WAIT_L(0); PG8_BAR; PG8_MMA(0, 0, At, B0); PG8_MMA(0, 1, At, B1); PG8_BAR; PG8_SCHED;
            PG8_LDA(At, 0, 1); PG8_STAGE(PG8_SB(0, 0), b2, voffB); PG8_STAGE(PG8_SB(0, 1), b2 + hstep, voffB); PG8_STAGE(PG8_SA(0, 0), a2, voffA);
            PG8_WAIT_V(8); PG8_WAIT_L(0); PG8_BAR; PG8_MMA(1, 0, At, B0); PG8_MMA(1, 1, At, B1); PG8_BAR; PG8_SCHED;
            PG8_LDB(B0, 1, 0); PG8_LDB(B1, 1, 1); PG8_SCHED; PG8_LDA(At, 1, 0); PG8_STAGE(PG8_SA(0, 1), a2 + hstep, voffA);
            PG8_WAIT_V(8); PG8_WAIT_L(0); PG8_BAR; PG8_MMA(0, 0, At, B0); PG8_MMA(0, 1, At, B1); PG8_BAR; PG8_SCHED;
            PG8_LDA(At, 1, 1); PG8_STAGE(PG8_SB(1, 0), b3, voffB); PG8_STAGE(PG8_SB(1, 1), b3 + hstep, voffB); PG8_STAGE(PG8_SA(1, 0), a3, voffA);
            PG8_WAIT_V(8); PG8_WAIT_L(0); PG8_BAR; PG8_MMA(1, 0, At, B0); PG8_MMA(1, 1, At, B1); PG8_BAR; PG8_SCHED;
            } else {
            PG8_LDB(B0, 0, 0); PG8_SCHED; PG8_LDA(At, 0, 0); PG8_STAGE(PG8_SA(1, 1), a1 + hstep, voffA);
            PG8_WAIT_L(8); PG8_BAR; PG8_WAIT_L(0); PG8_MMA(0, 0, At, B0); PG8_BAR; PG8_SCHED;
            PG8_LDB(B1, 0, 1); PG8_STAGE(PG8_SB(0, 0), b2, voffB);
            PG8_BAR; PG8_WAIT_L(0); PG8_MMA(0, 1, At, B1); PG8_BAR;
            PG8_LDA(At, 0, 1); PG8_STAGE(PG8_SA(0, 0), a2, voffA);
            PG8_BAR; PG8_WAIT_L(0); PG8_MMA(1, 0, At, B0); PG8_BAR; PG8_SCHED;
            PG8_STAGE(PG8_SB(0, 1), b2 + hstep, voffB);
            PG8_WAIT_V(6); PG8_BAR; PG8_MMA(1, 1, At, B1); PG8_BAR;
            PG8_LDB(B0, 1, 0); PG8_SCHED; PG8_LDA(At, 1, 0); PG8_STAGE(PG8_SA(0, 1), a2 + hstep, voffA);
            PG8_WAIT_L(8); PG8_BAR; PG8_WAIT_L(0); PG8_MMA(0, 0, At, B0); PG8_BAR; PG8_SCHED;
            PG8_LDB(B1, 1, 1); PG8_STAGE(PG8_SB(1, 0), b3, voffB);
            PG8_BAR; PG8_WAIT_L(0); PG8_MMA(0, 1, At, B1); PG8_BAR;
            PG8_LDA(At, 1, 1); PG8_STAGE(PG8_SA(1, 0), a3, voffA);
            PG8_BAR; PG8_WAIT_L(0); PG8_MMA(1, 0, At, B0); PG8_BAR; PG8_SCHED;
            PG8_STAGE(PG8_SB(1, 1), b3 + hstep, voffB);
            PG8_WAIT_V(6); PG8_BAR; PG8_MMA(1, 1, At, B1); PG8_BAR;
            }
        }
        if constexpr (ALIGN_EPI) { if (wr == 0) PG8_BAR; }
        if constexpr (F8) asm volatile("s_nop 15\n\ts_nop 15" ::: "memory");
        if constexpr (!Epi::AFTER_DRAIN) { E(acc, cur, wr, wc, fr, fq); S.done(cur); }
        if (!has_next) break;
#pragma unroll
        for (int a = 0; a < 2; ++a)
#pragma unroll
            for (int b = 0; b < 2; ++b)
#pragma unroll
                for (int m = 0; m < 4; ++m)
#pragma unroll
                    for (int n = 0; n < 2; ++n) acc[a][b][m][n] = (f32x4){0.f, 0.f, 0.f, 0.f};
        cur = nxt; cA = nA; cB = nB; ++ui;
        if constexpr (ALIGN_EPI) { if (wr == 1) PG8_BAR; }
    }
    PG8_WAIT_V(0);
    if constexpr (!ALIGN_EPI) { if (wr == 0) PG8_BAR; }
    PG8_BAR;
    if constexpr (Epi::AFTER_DRAIN) { E.fused(acc, cur, wr, wc, fr, fq, lds, wid, lane); S.done(cur); }
#undef PG8_SA
#undef PG8_SB
#undef PG8_STAGE
#undef PG8_LDA
#undef PG8_LDB
#undef PG8_MMA
#undef PG8_CAT
#undef PG8_WAIT_V
#undef PG8_WAIT_L
#undef PG8_BAR
#undef PG8_SCHED
}
}

constexpr int NWAVES = 8;
constexpr int NB = 8, SEQ = 2048, DM = 2048, M = NB * SEQ;
constexpr int N_IN = 3664, NPROJ = 3840, NP8 = 2560;
constexpr int U_OFF = 0, Q_OFF = 1024, K_OFF = 2048, V_OFF = 2304, QI_OFF = 2560, KI_OFF = 3584, WI_OFF = 3648;
constexpr int SSMW = 1024, NG = 64, GCH = 16, NST = 64;
constexpr int NH = 8, HD = 128, NKV = 2, NIH = 16, IDIM = 64, TOPK = 256;
constexpr int DFF = 5632, NUG = 2 * DFF;
constexpr float LN_EPS = 1e-5f;
constexpr float DN_ALPHA = 1.189207115002721f;
constexpr float IDX_W_SCALE = 0.03125f;
constexpr float ATT_SCALE = 0.08838834764831845f;
constexpr float SC_H1 = 32.f, SC_WUG = 2048.f, SC_ACT = 8.f, SC_WDN = 4096.f, SC_MIX = 8.f, SC_WOUT = 4096.f, SC_X = 32.f, SC_WIN = 2048.f;

constexpr size_t MiB = 1u << 20;
constexpr size_t WS_CTL = 0, CTL_ZERO_BYTES = 1 * MiB;
constexpr size_t WS_WIN = 2 * MiB, WS_WGLU = 17 * MiB, WS_WOUT = 19 * MiB, WS_WUG = 27 * MiB, WS_WDOWN = 71 * MiB;
constexpr size_t WS_TABA = 93 * MiB, WS_TABB = 93 * MiB + 65536;
constexpr size_t WS_TABINV = 94 * MiB, WS_TABW = 95 * MiB, WS_CA = 96 * MiB, WS_BCAT = 96 * MiB + 524288, WS_TABA32 = 96 * MiB + 786432;
constexpr size_t WS_KIPACK = 97 * MiB;
constexpr size_t WS_MASK = 100 * MiB;
constexpr size_t WS_XB = 104 * MiB;
constexpr size_t WS_MIX = 168 * MiB;
constexpr size_t WS_PROJ = 232 * MiB;
constexpr size_t WS_YG = 352 * MiB;
constexpr size_t WS_ACT = 232 * MiB;
constexpr size_t WS_PEND_UP = 408 * MiB, WS_PEND_G = 420 * MiB, WS_HALO = 432 * MiB, WS_WIN8 = 444 * MiB, WS_RSTAT = 450 * MiB, WS_END = 451 * MiB;
static_assert(WS_WIN + (size_t)NPROJ * DM * 2 <= WS_WGLU && WS_WUG + (size_t)NUG * DM * 2 <= WS_WDOWN && WS_WDOWN + (size_t)DM * DFF * 2 <= WS_TABA, "ws map");
static_assert(WS_PROJ + (size_t)M * NPROJ * 2 <= WS_YG && WS_YG + (size_t)M * SSMW * 2 <= WS_PEND_UP && WS_ACT + (size_t)M * DFF * 2 <= WS_PEND_UP && (size_t)512 * DFF * 4 <= 12 * MiB && WS_WIN8 + (size_t)NP8 * DM <= WS_RSTAT && WS_RSTAT + (size_t)M * 8 <= WS_END, "ws map 2");
constexpr int CW_BAR = 4096;

constexpr int RING_OFF = 0, RING_BYTES = 131072;
constexpr int LDS_BYTES = 163840;
constexpr int LDSCTL_OFF = LDS_BYTES - 1024, MISC_OFF = LDSCTL_OFF + 320;

#define GAS __attribute__((address_space(1)))
#define LAS __attribute__((address_space(3)))
typedef unsigned short bf16;
typedef unsigned v4u __attribute__((ext_vector_type(4)));
typedef unsigned v2u __attribute__((ext_vector_type(2)));
typedef float f32x4 __attribute__((ext_vector_type(4)));
typedef float fl4 __attribute__((ext_vector_type(4)));
#define LDS_WAIT() asm volatile("s_waitcnt lgkmcnt(0)" ::: "memory")
#define VM_WAIT() asm volatile("s_waitcnt vmcnt(0)" ::: "memory")
__device__ __forceinline__ unsigned f2bf(float f) { unsigned u = __builtin_bit_cast(unsigned, f); return (u + 0x7fffu + ((u >> 16) & 1u)) >> 16; }
__device__ __forceinline__ unsigned pk2(float lo, float hi) { return f2bf(lo) | (f2bf(hi) << 16); }
__device__ __forceinline__ float bflo(unsigned w) { return __uint_as_float(w << 16); }
__device__ __forceinline__ float bfhi(unsigned w) { return __uint_as_float(w & 0xffff0000u); }
__device__ __forceinline__ float bf2f(bf16 b) { return __uint_as_float(((unsigned)b) << 16); }
__device__ __forceinline__ unsigned pk4_fp8(float a, float b, float c, float d) {
    int w = 0; w = __builtin_amdgcn_cvt_pk_fp8_f32(__builtin_amdgcn_fmed3f(a, -448.f, 448.f), __builtin_amdgcn_fmed3f(b, -448.f, 448.f), w, false);
    w = __builtin_amdgcn_cvt_pk_fp8_f32(__builtin_amdgcn_fmed3f(c, -448.f, 448.f), __builtin_amdgcn_fmed3f(d, -448.f, 448.f), w, true); return (unsigned)w; }
#define XB_TMO      128
#define XB_XCNT(j)  (256  + 64 * (j))
#define XB_XSUB(j)  (1280 + 64 * (j))
#define XB_XGEN(j)  (2304 + 64 * (j))
#define XB_TOP      3328
#define XB_TOPGEN   3392
#define XCD_BAR_WORDS 3456
#define XB_SPIN_CAP (1u << 18)

__device__ __forceinline__ unsigned xb_ld(unsigned* p)              { return __hip_atomic_load(p, __ATOMIC_RELAXED, __HIP_MEMORY_SCOPE_AGENT); }
__device__ __forceinline__ unsigned xb_add(unsigned* p, unsigned v) { return __hip_atomic_fetch_add(p, v, __ATOMIC_RELAXED, __HIP_MEMORY_SCOPE_AGENT); }
__device__ __forceinline__ unsigned xb_xcc_id() { return (unsigned)__builtin_amdgcn_s_getreg((3 << 11) | 20) & 0xFu; }
#define XB_SPIN(cond, bar) do { unsigned _sp = 0; while (cond) { __builtin_amdgcn_s_sleep(1); \
    if ((++_sp & 255u) == 0u) { if (xb_ld(&(bar)[XB_TMO])) break; if (_sp > XB_SPIN_CAP) { atomicAdd(&(bar)[XB_TMO], 1u); break; } } } } while (0)

struct XcdBarrier {
    unsigned* bar; unsigned x;
    volatile LAS unsigned* st;
};

__device__ __forceinline__ XcdBarrier xcd_barrier_post(unsigned* bar, volatile LAS unsigned* st) {
    XcdBarrier b; b.bar = bar; b.x = xb_xcc_id(); b.st = st;
    if (threadIdx.x == 0) (void)xb_add(&bar[XB_XCNT(b.x)], 1u);
    return b;
}
__device__ __forceinline__ void xcd_barrier_complete(unsigned* bar, unsigned x, unsigned& nloc, unsigned& nx) {
    const unsigned G = gridDim.x * gridDim.y * gridDim.z;
    unsigned sum, cnt, mine, sp = 0u;
    for (;;) {
        sum = 0u; cnt = 0u; mine = 0u;
#pragma unroll
        for (unsigned j = 0; j < 16; ++j) { const unsigned c = xb_ld(&bar[XB_XCNT(j)]); sum += c; cnt += (c > 0u) ? 1u : 0u; mine = (j == x) ? c : mine; }
        if (sum == G) break;
        __builtin_amdgcn_s_sleep(1);
        if ((++sp & 255u) == 0u) { if (xb_ld(&bar[XB_TMO])) break; if (sp > XB_SPIN_CAP) { atomicAdd(&bar[XB_TMO], 1u); break; } }
    }
    nloc = mine > 0u ? mine : 1u; nx = cnt > 0u ? cnt : 1u;
}

__device__ __forceinline__ void xcd_barrier(const XcdBarrier& b) {
    asm volatile("s_waitcnt vmcnt(0)" ::: "memory");
    __syncthreads();
    if (threadIdx.x == 0) {
        unsigned* bar = b.bar;
        __builtin_amdgcn_s_waitcnt(0);
        unsigned nloc = b.st[0], nx = b.st[1];
        if (nloc == 0u) { xcd_barrier_complete(bar, b.x, nloc, nx); b.st[0] = nloc; b.st[1] = nx; }
        const unsigned old = xb_add(&bar[XB_XSUB(b.x)], 1u);
        const unsigned gen = old / nloc;
        if (old + 1u == (gen + 1u) * nloc) {
            __builtin_amdgcn_fence(__ATOMIC_RELEASE, "agent");
            asm volatile("s_waitcnt vmcnt(0)" ::: "memory");
            const unsigned og = xb_add(&bar[XB_TOP], 1u);
            const unsigned tg = og / nx;
            if (og + 1u == (tg + 1u) * nx) xb_add(&bar[XB_TOPGEN], 1u);
            else XB_SPIN(xb_ld(&bar[XB_TOPGEN]) == tg, bar);
            __builtin_amdgcn_fence(__ATOMIC_ACQUIRE, "agent");
            xb_add(&bar[XB_XGEN(b.x)], 1u);
            asm volatile("s_waitcnt vmcnt(0)" ::: "memory");
        } else {
            XB_SPIN(xb_ld(&bar[XB_XGEN(b.x)]) == gen, bar);
            __builtin_amdgcn_fence(__ATOMIC_ACQUIRE, "agent");
            asm volatile("s_waitcnt vmcnt(0)" ::: "memory");
        }
    }
    __syncthreads();
}

struct Frame {
    LAS unsigned char* lds;
    volatile LAS unsigned* MISC;
    unsigned* ctl;
    int tid, lane, wave, vcu, G;
    const float* in[22]; float* out; unsigned char* ws;
};
enum { I_X = 0, I_WIN, I_ARE, I_AIM, I_LOGDT, I_BRE, I_BIM, I_CRE, I_CIM, I_D, I_WGLU, I_BGLU, I_WOUT, I_LN1G, I_LN1B, I_WUP, I_WGATE, I_CONVW, I_CONVB, I_WDOWN, I_LN2G, I_LN2B };

__device__ __forceinline__ float wave_sum(float v) {
#pragma unroll
    for (int o = 1; o < 64; o <<= 1) v += __shfl_xor(v, o);
    return v;
}

typedef float v16f32 __attribute__((ext_vector_type(16)));
typedef unsigned v6u32 __attribute__((ext_vector_type(6)));
__device__ __forceinline__ void mx6_store_block(unsigned char* row, int b, v16f32 x, v16f32 y, float amax) {
    unsigned E = __float_as_uint(amax) >> 23; E = E < 3u ? 3u : E;
    const unsigned sb = E - 2u; const float inv = __uint_as_float((254u - sb) << 23);
    const v6u32 r = __builtin_amdgcn_cvt_scalef32_2xpk16_fp6_f32(x * inv, y * inv, 1.0f);
    unsigned char* p = row + (b >> 2) * 128 + (b & 3) * 16;
    *(v4u*)p = (v4u){r[0], r[1], r[2], r[3]}; *(v4u*)(p + 64) = (v4u){r[4], r[5], sb, 0u};
}
#define MX6_AMAX(x, y, am) do { am = 0.f; _Pragma("unroll") for (int i_ = 0; i_ < 16; ++i_) am = __builtin_fmaxf(__builtin_fmaxf(__builtin_fabsf(x[i_]), __builtin_fabsf(y[i_])), am); } while (0)
template <int MODE>
__device__ __forceinline__ void p2_mx6_item(const float* W, int K, int N, void* WT, int item, int lane, int ncols = 0) {
    const int nblk = (ncols ? ncols : N) / 256, kb = item / nblk, nb = item % nblk, k0 = 32 * kb;
#pragma unroll 1
    for (int sub = 0; sub < 4; ++sub) { const int nn = nb * 256 + sub * 64 + lane; const float* wp = W + (size_t)k0 * N + nn;
        v16f32 x, y;
#pragma unroll
        for (int i = 0; i < 16; ++i) { x[i] = wp[(size_t)i * N]; y[i] = wp[(size_t)(16 + i) * N]; }
        float am; MX6_AMAX(x, y, am);
        const int R = MODE == 0 ? nn : (256 * (nn >> 7) + (nn & 127) + (MODE == 2 ? 128 : 0));
        mx6_store_block((unsigned char*)WT + (size_t)R * K, kb, x, y, am); }
}
template <int MODE, bool F8OUT>
__device__ __forceinline__ void p0_tr_item(const float* W, int K, int N, int noff, int nend, void* WT, int item, int lane, float sc) {
    const int nblk = (nend - noff) / 256, kb = item / nblk, nb = item % nblk, k0 = 32 * kb, n = noff + nb * 256 + lane * 4;
    constexpr int KS = F8OUT ? 16 : 8;
    const bool inb = n < N;
#pragma unroll
    for (int kk = 0; kk < 32; kk += KS) {
        f32x4 v[KS];
#pragma unroll
        for (int i = 0; i < KS; ++i) v[i] = inb ? *(const f32x4*)(W + (size_t)(k0 + kk + i) * N + n) : (f32x4){0.f, 0.f, 0.f, 0.f};
#pragma unroll
        for (int c = 0; c < 4; ++c) { const int nn = n + c; const int R = MODE == 0 ? nn : (256 * (nn >> 7) + (nn & 127) + (MODE == 2 ? 128 : 0));
            v4u o;
            if constexpr (F8OUT) { o.x = pk4_fp8(v[0][c] * sc, v[1][c] * sc, v[2][c] * sc, v[3][c] * sc); o.y = pk4_fp8(v[4][c] * sc, v[5][c] * sc, v[6][c] * sc, v[7][c] * sc);
                o.z = pk4_fp8(v[8][c] * sc, v[9][c] * sc, v[10][c] * sc, v[11][c] * sc); o.w = pk4_fp8(v[12][c] * sc, v[13][c] * sc, v[14][c] * sc, v[15][c] * sc);
                *(v4u*)((unsigned char*)WT + (size_t)R * K + k0 + kk) = o; }
            else { o.x = pk2(v[0][c], v[1][c]); o.y = pk2(v[2][c], v[3][c]); o.z = pk2(v[4][c], v[5][c]); o.w = pk2(v[6][c], v[7][c]);
                *(v4u*)((bf16*)WT + (size_t)R * K + k0 + kk) = o; } }
    }
}
__device__ __forceinline__ void p0_prologue(Frame& F) {
    LAS float* scr = (LAS float*)(F.lds + RING_OFF + F.wave * 16384);
    const int gw = F.vcu * NWAVES + F.wave, NGW = F.G * NWAVES;
    bf16* win_t = (bf16*)(F.ws + WS_WIN); bf16* wglu_t = (bf16*)(F.ws + WS_WGLU); bf16* wout_t = (bf16*)(F.ws + WS_WOUT); bf16* wug_t = (bf16*)(F.ws + WS_WUG); bf16* wdown_t = (bf16*)(F.ws + WS_WDOWN);
    constexpr int I_IN8 = (DM / 32) * (NP8 / 256), I_IN = (DM / 32) * ((NPROJ - NP8) / 256);
    for (int it = gw; it < I_IN8 + I_IN; it += NGW) {
        int r = it;
        if (r < I_IN8) { p2_mx6_item<0>(F.in[I_WIN], DM, N_IN, F.ws + WS_WIN8, r, F.lane, NP8); continue; } r -= I_IN8;
        p0_tr_item<0, false>(F.in[I_WIN], DM, N_IN, NP8, NPROJ, win_t, r, F.lane, 1.f);
    }
    { const size_t nb32 = (size_t)M * DM / 32; const f32x4* xs = (const f32x4*)F.in[I_X]; v4u* xd = (v4u*)(F.ws + WS_XB); unsigned char* x6 = F.ws + WS_MIX + 32 * MiB;
#pragma unroll 2
      for (size_t i = (size_t)F.vcu * 512 + F.tid; i < nb32; i += (size_t)F.G * 512) { v16f32 x, y;
#pragma unroll
          for (int j = 0; j < 4; ++j) { const f32x4 a = xs[8 * i + j], b = xs[8 * i + 4 + j];
#pragma unroll
              for (int e = 0; e < 4; ++e) { x[4 * j + e] = a[e]; y[4 * j + e] = b[e]; } }
#pragma unroll
          for (int j = 0; j < 2; ++j) { v4u o; o.x = pk2(x[8 * j], x[8 * j + 1]); o.y = pk2(x[8 * j + 2], x[8 * j + 3]); o.z = pk2(x[8 * j + 4], x[8 * j + 5]); o.w = pk2(x[8 * j + 6], x[8 * j + 7]); xd[4 * i + j] = o;
              v4u p; p.x = pk2(y[8 * j], y[8 * j + 1]); p.y = pk2(y[8 * j + 2], y[8 * j + 3]); p.z = pk2(y[8 * j + 4], y[8 * j + 5]); p.w = pk2(y[8 * j + 6], y[8 * j + 7]); xd[4 * i + 2 + j] = p; }
          float am; MX6_AMAX(x, y, am);
          mx6_store_block(x6 + (i >> 6) * DM, (int)(i & 63), x, y, am); } }
    { const int gi = F.vcu * 512 + F.tid;
      if (gi < NG * NST) { const int g = gi >> 6;
          const double dt = exp((double)F.in[I_LOGDT][g]); const double are = (double)F.in[I_ARE][gi], aim = (double)F.in[I_AIM][gi];
          const double mag = exp(dt * are), ang = dt * aim; const double abr = mag * cos(ang), abi = mag * sin(ang);
          const double nr = abr - 1.0, ni = abi, den = are * are + aim * aim;
          const double fre = (nr * are + ni * aim) / den, fim = (ni * are - nr * aim) / den;
          float2* ta = (float2*)(F.ws + WS_TABA); float2* tb = (float2*)(F.ws + WS_TABB);
          ta[gi] = make_float2((float)abr, (float)abi);
#pragma unroll
          for (int h = 0; h < GCH; ++h) { const double br = (double)F.in[I_BRE][gi * GCH + h], bi = (double)F.in[I_BIM][gi * GCH + h];
              const float bbr = (float)(fre * br - fim * bi), bbi = (float)(fre * bi + fim * br);
              tb[gi * GCH + h] = make_float2(bbr, bbi);
              const int p = gi & 63; bf16* bcat = (bf16*)(F.ws + WS_BCAT);
              bcat[(size_t)(g * 128 + p) * 16 + h] = (bf16)f2bf(bbr); bcat[(size_t)(g * 128 + 64 + p) * 16 + h] = (bf16)f2bf(bbi); }
          { const double m32 = exp(32.0 * dt * are), a32 = 32.0 * dt * aim; ((float2*)(F.ws + WS_TABA32))[gi] = make_float2((float)(m32 * cos(a32)), (float)(m32 * sin(a32))); } } }
    for (int e = F.vcu * 512 + F.tid; e < NG * 2 * 8 * 64; e += F.G * 512) {
        const int ln = e & 63, rp = (e >> 6) & 7, pt = (e >> 9) & 1, g = e >> 10, hw = ln >> 5, jl = ln & 31;
        const double dt = exp((double)F.in[I_LOGDT][g]); float vi[4], vw[4];
#pragma unroll
        for (int k = 0; k < 2; ++k) { const int r = 2 * rp + k, cr = (r & 3) + 8 * (r >> 2) + 4 * hw;
            { const int p = pt * 32 + jl; const double are = (double)F.in[I_ARE][g * 64 + p], aim = (double)F.in[I_AIM][g * 64 + p], kk = -(double)cr; const double mg = exp(kk * dt * are), an = kk * dt * aim;
              vi[k] = (float)(mg * cos(an)); vi[2 + k] = (float)(mg * sin(an)); }
            { const int p = pt * 32 + cr; const double are = (double)F.in[I_ARE][g * 64 + p], aim = (double)F.in[I_AIM][g * 64 + p], kk = (double)jl; const double mg = exp(kk * dt * are), an = kk * dt * aim;
              vw[k] = (float)(mg * cos(an)); vw[2 + k] = (float)(mg * sin(an)); } }
        ((fl4*)(F.ws + WS_TABINV))[e] = (fl4){vi[0], vi[1], vi[2], vi[3]}; ((fl4*)(F.ws + WS_TABW))[e] = (fl4){vw[0], vw[1], vw[2], vw[3]};
    }
    for (int e = F.vcu * 512 + F.tid; e < NG * 4 * 2 * 64; e += F.G * 512) {
        const int ln = e & 63, s = (e >> 6) & 1, q = (e >> 7) & 3, g = e >> 9, ch = ln & 31, hw = ln >> 5; unsigned hv[8];
#pragma unroll
        for (int ee = 0; ee < 8; ++ee) { const int p = (q & 1) * 32 + 8 * (2 * s + (ee >> 2)) + 4 * hw + (ee & 3); float v = 0.f;
            if (ch < 16) v = (q < 2) ? F.in[I_CRE][(size_t)(g * 16 + ch) * 64 + p] : -F.in[I_CIM][(size_t)(g * 16 + ch) * 64 + p];
            hv[ee] = f2bf(v); }
        v4u w; w.x = hv[0] | (hv[1] << 16); w.y = hv[2] | (hv[3] << 16); w.z = hv[4] | (hv[5] << 16); w.w = hv[6] | (hv[7] << 16);
        ((v4u*)(F.ws + WS_CA))[e] = w; }
}

constexpr int P2W_GLU = (SSMW / 32) * (SSMW / 256), P2W_OUT = (DM / 32) * (DM / 256), P2W_UP = (DM / 32) * (DFF / 256), P2W_DOWN = (DFF / 32) * (DM / 256);
constexpr int P2W_ITEMS = P2W_GLU + P2W_OUT + 2 * P2W_UP + P2W_DOWN;
__device__ __forceinline__ void p2_weight_item(Frame& F, int it) {
    int r = it;
    if (r < P2W_GLU) { p0_tr_item<0, false>(F.in[I_WGLU], SSMW, SSMW, 0, SSMW, F.ws + WS_WGLU, r, F.lane, 1.f); return; } r -= P2W_GLU;
    if (r < P2W_OUT) { p0_tr_item<0, true>(F.in[I_WOUT], DM, DM, 0, DM, F.ws + WS_WOUT, r, F.lane, SC_WOUT); return; } r -= P2W_OUT;
    if (r < P2W_UP) { p2_mx6_item<1>(F.in[I_WUP], DM, DFF, F.ws + WS_WUG, r, F.lane); return; } r -= P2W_UP;
    if (r < P2W_UP) { p2_mx6_item<2>(F.in[I_WGATE], DM, DFF, F.ws + WS_WUG, r, F.lane); return; } r -= P2W_UP;
    p0_tr_item<0, true>(F.in[I_WDOWN], DFF, DM, 0, DM, F.ws + WS_WDOWN, r, F.lane, SC_WDN);
}

typedef short bf16x8_t __attribute__((ext_vector_type(8)));
typedef float f32x16_t __attribute__((ext_vector_type(16)));
typedef float fl2 __attribute__((ext_vector_type(2)));
constexpr int IDX_NLDS = 30;
__device__ __forceinline__ void idx_mfma_pair(Frame& F, int b, int ti, unsigned* maskout, const LAS bf16* kl) {
    const int lane = F.lane, j = lane & 31, hw = lane >> 5, t0 = 2 * ti, th = t0 + hw;
    const bf16* proj = (const bf16*)(F.ws + WS_PROJ);
    const bf16* pb = proj + (size_t)(b * SEQ) * NPROJ;
    bf16x8_t qa[4];
    { const int q = (j >> 2) & 1, head = (j >> 3) * 4 + (j & 3); const bf16* qp = pb + (size_t)(t0 + q) * NPROJ + QI_OFF + head * IDIM + 8 * hw;
#pragma unroll
      for (int s = 0; s < 4; ++s) qa[s] = *(const bf16x8_t*)(qp + 16 * s); }
    float w[16];
    { const bf16* wp = pb + (size_t)th * NPROJ + WI_OFF; const v4u a = *(const v4u*)wp, c = *(const v4u*)(wp + 8);
      w[0] = bflo(a.x); w[1] = bfhi(a.x); w[2] = bflo(a.y); w[3] = bfhi(a.y); w[4] = bflo(a.z); w[5] = bfhi(a.z); w[6] = bflo(a.w); w[7] = bfhi(a.w);
      w[8] = bflo(c.x); w[9] = bfhi(c.x); w[10] = bflo(c.y); w[11] = bfhi(c.y); w[12] = bflo(c.z); w[13] = bfhi(c.z); w[14] = bflo(c.w); w[15] = bfhi(c.w);
#pragma unroll
      for (int r = 0; r < 16; ++r) w[r] *= IDX_W_SCALE; }
    const int kbnd = t0 >> 5;
    const float pen = (j > th - 32 * kbnd) ? -__builtin_inff() : 0.f;
    const int nkt = (t0 + 1) / 32 + 1;
    const float NEG = -__builtin_inff();
    float sc[64];
    const bf16* kp = (const bf16*)(F.ws + WS_KIPACK) + (size_t)(b * 64) * 4 * 64 * 8 + (size_t)lane * 8;
    typedef float f32x2_t __attribute__((ext_vector_type(2)));
    f32x2_t w2[8];
#pragma unroll
    for (int r = 0; r < 8; ++r) w2[r] = (f32x2_t){0.5f * w[2 * r], 0.5f * w[2 * r + 1]};
    bf16x8_t kA[2][4], kB[2][4];
#pragma unroll
    for (int t2 = 0; t2 < 2; ++t2)
#pragma unroll
        for (int s = 0; s < 4; ++s) kA[t2][s] = *(const LAS bf16x8_t*)(kl + (t2 * 4 + s) * 512);
    unsigned kl2a = (unsigned)(size_t)kl + 16 * 4096; asm volatile("" : "+v"(kl2a));
    const LAS bf16* kl2 = (const LAS bf16*)(size_t)kl2a;
#pragma unroll
    for (int kp2 = 0; kp2 < 32; ++kp2) {
        if (2 * kp2 < nkt) {
            if (2 * (kp2 + 1) < nkt) {
#pragma unroll
                for (int t2 = 0; t2 < 2; ++t2)
#pragma unroll
                    for (int s = 0; s < 4; ++s) { const bf16x8_t v = (2 * kp2 + 2 < 16) ? *(const LAS bf16x8_t*)(kl + ((2 * kp2 + 2 + t2) * 4 + s) * 512) : (2 * kp2 + 2 < IDX_NLDS) ? *(const LAS bf16x8_t*)(kl2 + ((2 * kp2 + 2 - 16 + t2) * 4 + s) * 512) : *(const bf16x8_t*)(kp + (size_t)((2 * kp2 + 2 + t2) * 4 + s) * 512);
                        if (kp2 & 1) kA[t2][s] = v; else kB[t2][s] = v; } }
            f32x16_t acc0 = {}, acc1 = {};
#pragma unroll
            for (int s = 0; s < 4; ++s) { acc0 = __builtin_amdgcn_mfma_f32_32x32x16_bf16(qa[s], (kp2 & 1) ? kB[0][s] : kA[0][s], acc0, 0, 0, 0);
                acc1 = __builtin_amdgcn_mfma_f32_32x32x16_bf16(qa[s], (kp2 & 1) ? kB[1][s] : kA[1][s], acc1, 0, 0, 0); }
            f32x2_t s0 = {0.f, 0.f}, s1 = {0.f, 0.f}; float a0 = 0.f, b0 = 0.f, a1 = 0.f, b1 = 0.f;
#pragma unroll
            for (int r = 0; r < 8; ++r) { const f32x2_t x0 = {acc0[2 * r], acc0[2 * r + 1]}, x1 = {acc1[2 * r], acc1[2 * r + 1]};
                s0 = x0 * w2[r] + s0; s1 = x1 * w2[r] + s1;
                a0 = fmaf(w2[r].x, fabsf(x0.x), a0); b0 = fmaf(w2[r].y, fabsf(x0.y), b0); a1 = fmaf(w2[r].x, fabsf(x1.x), a1); b1 = fmaf(w2[r].y, fabsf(x1.y), b1); }
            float v0 = (s0.x + s0.y) + (a0 + b0), v1 = (s1.x + s1.y) + (a1 + b1);
            if (2 * kp2 == kbnd) { v0 += pen; v1 = NEG; } else if (2 * kp2 + 1 == kbnd) v1 += pen;
            sc[2 * kp2] = v0; sc[2 * kp2 + 1] = v1;
        } else { sc[2 * kp2] = NEG; sc[2 * kp2 + 1] = NEG; }
    }
    float thr = -3.0e38f, tieval = 0.f; bool tie = false; int need = 0;
    bool act = th >= TOPK;
    if (__any(act)) {
        float mn = sc[0], mx = sc[0];
#pragma unroll
        for (int kt = 1; kt < 8; ++kt) mn = __builtin_amdgcn_fmed3f(mn, sc[kt], NEG);
#pragma unroll
        for (int kt = 1; kt < 64; ++kt) mx = __builtin_amdgcn_fmed3f(mx, sc[kt], __builtin_inff());
#define IDX_DPP_F(v, ctrl) __builtin_bit_cast(float, __builtin_amdgcn_update_dpp(0, __builtin_bit_cast(int, v), ctrl, 0xf, 0xf, false))
        mn = fminf(mn, IDX_DPP_F(mn, 0x128)); mn = fminf(mn, IDX_DPP_F(mn, 0x124)); mn = fminf(mn, IDX_DPP_F(mn, 0x122)); mn = fminf(mn, IDX_DPP_F(mn, 0x121));
        mx = fmaxf(mx, IDX_DPP_F(mx, 0x128)); mx = fmaxf(mx, IDX_DPP_F(mx, 0x124)); mx = fmaxf(mx, IDX_DPP_F(mx, 0x122)); mx = fmaxf(mx, IDX_DPP_F(mx, 0x121));
#undef IDX_DPP_F
        { const float a0 = __builtin_bit_cast(float, __builtin_amdgcn_readlane(__builtin_bit_cast(int, mn), 0)), a1 = __builtin_bit_cast(float, __builtin_amdgcn_readlane(__builtin_bit_cast(int, mn), 16));
          const float a2 = __builtin_bit_cast(float, __builtin_amdgcn_readlane(__builtin_bit_cast(int, mn), 32)), a3 = __builtin_bit_cast(float, __builtin_amdgcn_readlane(__builtin_bit_cast(int, mn), 48));
          const float b0 = __builtin_bit_cast(float, __builtin_amdgcn_readlane(__builtin_bit_cast(int, mx), 0)), b1 = __builtin_bit_cast(float, __builtin_amdgcn_readlane(__builtin_bit_cast(int, mx), 16));
          const float b2 = __builtin_bit_cast(float, __builtin_amdgcn_readlane(__builtin_bit_cast(int, mx), 32)), b3 = __builtin_bit_cast(float, __builtin_amdgcn_readlane(__builtin_bit_cast(int, mx), 48));
          mn = hw ? fminf(a2, a3) : fminf(a0, a1); mx = hw ? fmaxf(b2, b3) : fmaxf(b0, b1); }
        float lo = mn, hi = mx + fabsf(mx) * 1e-6f + 1e-30f;
        int chi = 0;
        float glo = (float)(th + 1) - ((float)TOPK - 0.5f), ghi = -((float)TOPK - 0.5f); int side = 0;
        const int ngrp = (nkt + 7) >> 3;
        for (int it = 0; it < 200; ++it) {
            if (!__any(act)) break;
            float mid = hi - ghi * (hi - lo) * __builtin_amdgcn_rcpf(ghi - glo);
            if (!(mid > lo && mid < hi)) mid = 0.5f * (lo + hi);
            const bool conv = !(mid > lo && mid < hi);
            unsigned ba = 0u, bb = 0u;
#pragma unroll
            for (int g8 = 0; g8 < 4; ++g8) if (g8 < ngrp) {
#pragma unroll
                for (int kt = 8 * g8; kt < 8 * g8 + 8; ++kt) ba = __builtin_amdgcn_alignbit(ba, __builtin_bit_cast(unsigned, sc[kt] - mid), 31); }
#pragma unroll
            for (int g8 = 4; g8 < 8; ++g8) if (g8 < ngrp) {
#pragma unroll
                for (int kt = 8 * g8; kt < 8 * g8 + 8; ++kt) bb = __builtin_amdgcn_alignbit(bb, __builtin_bit_cast(unsigned, sc[kt] - mid), 31); }
            int cl = 8 * ngrp - (__builtin_popcount(ba) + __builtin_popcount(bb));
            cl += __builtin_amdgcn_update_dpp(0, cl, 0x128, 0xf, 0xf, false);
            cl += __builtin_amdgcn_update_dpp(0, cl, 0x124, 0xf, 0xf, false);
            cl += __builtin_amdgcn_update_dpp(0, cl, 0x122, 0xf, 0xf, false);
            cl += __builtin_amdgcn_update_dpp(0, cl, 0x121, 0xf, 0xf, false);
            const int c0 = __builtin_amdgcn_readlane(cl, 0) + __builtin_amdgcn_readlane(cl, 16), c1 = __builtin_amdgcn_readlane(cl, 32) + __builtin_amdgcn_readlane(cl, 48);
            const int c = hw ? c1 : c0;
            if (act) {
                if (conv) { act = false; tie = true; tieval = lo; thr = hi; need = TOPK - chi; }
                else if (c == TOPK) { act = false; thr = mid; }
                else if (c > TOPK) { lo = mid; glo = (float)c - ((float)TOPK - 0.5f); if (side == 1) ghi *= 0.5f; side = 1; }
                else { hi = mid; chi = c; ghi = (float)c - ((float)TOPK - 0.5f); if (side == -1) glo *= 0.5f; side = -1; }
            }
        }
        if (act) { thr = hi; }
    }
    unsigned w0v = 0u, w1v = 0u;
    const bool anytie = __any(tie);
    int need0 = __builtin_amdgcn_readlane(need, 0), need1 = __builtin_amdgcn_readlane(need, 32);
    if (!anytie) {
#define IDX_WL(KT) if ((KT) < nkt) { const unsigned long long bal_ = __ballot(sc[KT] >= thr); const unsigned x0_ = (unsigned)bal_, x1_ = (unsigned)(bal_ >> 32); \
        asm volatile("s_nop 1\n\tv_writelane_b32 %0, %2, " #KT "\n\tv_writelane_b32 %1, %3, " #KT : "+v"(w0v), "+v"(w1v) : "s"(x0_), "s"(x1_)); }
        IDX_WL(0) IDX_WL(1) IDX_WL(2) IDX_WL(3) IDX_WL(4) IDX_WL(5) IDX_WL(6) IDX_WL(7) IDX_WL(8) IDX_WL(9) IDX_WL(10) IDX_WL(11) IDX_WL(12) IDX_WL(13) IDX_WL(14) IDX_WL(15) IDX_WL(16) IDX_WL(17) IDX_WL(18) IDX_WL(19) IDX_WL(20) IDX_WL(21) IDX_WL(22) IDX_WL(23) IDX_WL(24) IDX_WL(25) IDX_WL(26) IDX_WL(27) IDX_WL(28) IDX_WL(29) IDX_WL(30) IDX_WL(31) IDX_WL(32) IDX_WL(33) IDX_WL(34) IDX_WL(35) IDX_WL(36) IDX_WL(37) IDX_WL(38) IDX_WL(39) IDX_WL(40) IDX_WL(41) IDX_WL(42) IDX_WL(43) IDX_WL(44) IDX_WL(45) IDX_WL(46) IDX_WL(47) IDX_WL(48) IDX_WL(49) IDX_WL(50) IDX_WL(51) IDX_WL(52) IDX_WL(53) IDX_WL(54) IDX_WL(55) IDX_WL(56) IDX_WL(57) IDX_WL(58) IDX_WL(59) IDX_WL(60) IDX_WL(61) IDX_WL(62) IDX_WL(63)
#undef IDX_WL
    } else
#pragma unroll
    for (int kt = 0; kt < 64; ++kt) if (kt < nkt) {
        const unsigned long long bal = __ballot(sc[kt] >= thr);
        unsigned x0 = (unsigned)bal, x1 = (unsigned)(bal >> 32);
        if (anytie) {
            const unsigned long long be = __ballot(tie && sc[kt] == tieval);
            unsigned e0 = (unsigned)be, e1 = (unsigned)(be >> 32);
            while (__builtin_popcount(e0) > need0) e0 &= ~(0x80000000u >> __builtin_clz(e0));
            while (__builtin_popcount(e1) > need1) e1 &= ~(0x80000000u >> __builtin_clz(e1));
            need0 -= __builtin_popcount(e0); need1 -= __builtin_popcount(e1);
            x0 |= e0; x1 |= e1;
        }
        w0v = (lane == kt) ? x0 : w0v; w1v = (lane == kt) ? x1 : w1v;
    }
    maskout[(size_t)(b * SEQ + t0) * 64 + lane] = w0v;
    maskout[(size_t)(b * SEQ + t0 + 1) * 64 + lane] = w1v;
}


__device__ __forceinline__ bf16x8_t ssm_pack8(const f32x16_t& v, int base) {
    v4u w; w.x = pg8::cvt_pk_bf16(v[base + 0], v[base + 1]); w.y = pg8::cvt_pk_bf16(v[base + 2], v[base + 3]); w.z = pg8::cvt_pk_bf16(v[base + 4], v[base + 5]); w.w = pg8::cvt_pk_bf16(v[base + 6], v[base + 7]);
    return __builtin_bit_cast(bf16x8_t, w);
}
__device__ __forceinline__ void ssm_mfma_task(Frame& F, int b, int g, const LAS fl4* tInv, const LAS fl4* tW, bf16* ygo, int c_light, int c_begin, int c_end) {
    const int lane = F.lane, j = lane & 31, hw = lane >> 5;
    const bf16* pu = (const bf16*)(F.ws + WS_PROJ) + (size_t)(b * SEQ) * NPROJ + U_OFF + g * 16;
    bf16x8_t bc[4], ca[4][2], tri[2];
#pragma unroll
    for (int nt = 0; nt < 4; ++nt) bc[nt] = *(const bf16x8_t*)((const bf16*)(F.ws + WS_BCAT) + (size_t)((g * 128 + nt * 32 + j) * 16 + 8 * hw));
#pragma unroll
    for (int q = 0; q < 4; ++q)
#pragma unroll
        for (int s = 0; s < 2; ++s) ca[q][s] = *(const bf16x8_t*)((const bf16*)(F.ws + WS_CA) + (size_t)((((g * 4 + q) * 2 + s) * 64 + lane) * 8));
#pragma unroll
    for (int s = 0; s < 2; ++s) { v4u w;
        unsigned hv[8];
#pragma unroll
        for (int e = 0; e < 8; ++e) { const int i = 8 * (2 * s + (e >> 2)) + 4 * hw + (e & 3); hv[e] = (i <= j) ? 0x3F80u : 0u; }
        w.x = hv[0] | (hv[1] << 16); w.y = hv[2] | (hv[3] << 16); w.z = hv[4] | (hv[5] << 16); w.w = hv[6] | (hv[7] << 16);
        tri[s] = __builtin_bit_cast(bf16x8_t, w); }
    float2 a32[2];
#pragma unroll
    for (int pt = 0; pt < 2; ++pt) a32[pt] = ((const float2*)(F.ws + WS_TABA32))[g * 64 + pt * 32 + j];
    float dv[8];
#pragma unroll
    for (int k = 0; k < 8; ++k) dv[k] = F.in[I_D][g * 16 + (k & 3) + 8 * (k >> 2) + 4 * hw];
    float hcr[2] = {0.f, 0.f}, hci[2] = {0.f, 0.f};
    const bf16* pl = pu + (size_t)j * NPROJ;
    if (c_light < c_begin) {
        bf16x8_t ul = *(const bf16x8_t*)(pl + (size_t)c_light * 32 * NPROJ + 8 * hw);
#pragma unroll 1
        for (int c = c_light; c < c_begin; ++c) {
            const bf16x8_t ulc = ul;
            if (c + 1 < c_begin) ul = *(const bf16x8_t*)(pl + (size_t)(c + 1) * 32 * NPROJ + 8 * hw);
            f32x16_t d[4];
#pragma unroll
            for (int nt = 0; nt < 4; ++nt) { f32x16_t z = {}; d[nt] = __builtin_amdgcn_mfma_f32_32x32x16_bf16(ulc, bc[nt], z, 0, 0, 0); }
#pragma unroll
            for (int pt = 0; pt < 2; ++pt) { float sr = 0.f, si = 0.f;
                fl2 sr2 = {0.f, 0.f}, si2 = {0.f, 0.f};
#pragma unroll
                for (int rp = 0; rp < 8; ++rp) { const fl4 w = tInv[(pt * 8 + rp) * 64 + lane]; const fl2 wre = {w.x, w.y}, wim = {w.z, w.w};
                    const fl2 re = {d[pt][2 * rp], d[pt][2 * rp + 1]}, im = {d[2 + pt][2 * rp], d[2 + pt][2 * rp + 1]}; sr2 += wre * re - wim * im; si2 += wre * im + wim * re; }
                sr = sr2.x + sr2.y; si = si2.x + si2.y;
                sr += __shfl_xor(sr, 32); si += __shfl_xor(si, 32);
                sr += hcr[pt]; si += hci[pt];
                hcr[pt] = a32[pt].x * sr - a32[pt].y * si; hci[pt] = a32[pt].x * si + a32[pt].y * sr; }
        }
    }
    const bf16* pf = pl + (size_t)c_begin * 32 * NPROJ;
    bf16x8_t ua = *(const bf16x8_t*)(pf + 8 * hw);
    v2u ue0 = *(const v2u*)(pf + 4 * hw), ue1 = *(const v2u*)(pf + 8 + 4 * hw);
#pragma unroll 1
    for (int c = c_begin; c < c_end; ++c) {
        const bf16x8_t uac = ua; const v2u uc0 = ue0, uc1 = ue1;
        if (c + 1 < c_end) { const bf16* pn = pl + (size_t)(c + 1) * 32 * NPROJ; ua = *(const bf16x8_t*)(pn + 8 * hw); ue0 = *(const v2u*)(pn + 4 * hw); ue1 = *(const v2u*)(pn + 8 + 4 * hw); }
        f32x16_t d[4];
#pragma unroll
        for (int nt = 0; nt < 4; ++nt) { f32x16_t z = {}; d[nt] = __builtin_amdgcn_mfma_f32_32x32x16_bf16(uac, bc[nt], z, 0, 0, 0); }
#pragma unroll
        for (int pt = 0; pt < 2; ++pt) { float sr = 0.f, si = 0.f;
            fl2 sr2 = {0.f, 0.f}, si2 = {0.f, 0.f};
#pragma unroll
            for (int rp = 0; rp < 8; ++rp) { const fl4 w = tInv[(pt * 8 + rp) * 64 + lane]; const fl2 wre = {w.x, w.y}, wim = {w.z, w.w};
                const fl2 re = {d[pt][2 * rp], d[pt][2 * rp + 1]}, im = {d[2 + pt][2 * rp], d[2 + pt][2 * rp + 1]};
                fl2 xr = wre * re - wim * im, xi = wre * im + wim * re;
                if (rp == 0) { xr.x += (hw == 0) ? hcr[pt] : 0.f; xi.x += (hw == 0) ? hci[pt] : 0.f; }
                d[pt][2 * rp] = xr.x; d[pt][2 * rp + 1] = xr.y; d[2 + pt][2 * rp] = xi.x; d[2 + pt][2 * rp + 1] = xi.y; sr2 += xr; si2 += xi; }
            sr = sr2.x + sr2.y; si = si2.x + si2.y;
            sr += __shfl_xor(sr, 32); si += __shfl_xor(si, 32);
            hcr[pt] = a32[pt].x * sr - a32[pt].y * si; hci[pt] = a32[pt].x * si + a32[pt].y * sr; }
        f32x16_t st[4];
#pragma unroll
        for (int q = 0; q < 4; ++q) { f32x16_t z = {}; st[q] = __builtin_amdgcn_mfma_f32_32x32x16_bf16(ssm_pack8(d[q], 0), tri[0], z, 0, 0, 0);
            st[q] = __builtin_amdgcn_mfma_f32_32x32x16_bf16(ssm_pack8(d[q], 8), tri[1], st[q], 0, 0, 0); }
#pragma unroll
        for (int pt = 0; pt < 2; ++pt)
#pragma unroll
            for (int rp = 0; rp < 8; ++rp) { const fl4 w = tW[(pt * 8 + rp) * 64 + lane]; const fl2 wre = {w.x, w.y}, wim = {w.z, w.w};
                const fl2 sre = {st[pt][2 * rp], st[pt][2 * rp + 1]}, sim = {st[2 + pt][2 * rp], st[2 + pt][2 * rp + 1]};
                const fl2 hr = wre * sre - wim * sim, hi = wre * sim + wim * sre;
                st[pt][2 * rp] = hr.x; st[pt][2 * rp + 1] = hr.y; st[2 + pt][2 * rp] = hi.x; st[2 + pt][2 * rp + 1] = hi.y; }
        f32x16_t y = {};
#pragma unroll
        for (int q = 0; q < 4; ++q) { y = __builtin_amdgcn_mfma_f32_32x32x16_bf16(ca[q][0], ssm_pack8(st[q], 0), y, 0, 0, 0); y = __builtin_amdgcn_mfma_f32_32x32x16_bf16(ca[q][1], ssm_pack8(st[q], 8), y, 0, 0, 0); }
        float o[8];
        o[0] = y[0] + dv[0] * bflo(uc0.x); o[1] = y[1] + dv[1] * bfhi(uc0.x); o[2] = y[2] + dv[2] * bflo(uc0.y); o[3] = y[3] + dv[3] * bfhi(uc0.y);
        o[4] = y[4] + dv[4] * bflo(uc1.x); o[5] = y[5] + dv[5] * bfhi(uc1.x); o[6] = y[6] + dv[6] * bflo(uc1.y); o[7] = y[7] + dv[7] * bfhi(uc1.y);
        const pg8::f32x2 g0 = pg8::gelu_pk((pg8::f32x2){o[0], o[1]}), g1 = pg8::gelu_pk((pg8::f32x2){o[2], o[3]}), g2 = pg8::gelu_pk((pg8::f32x2){o[4], o[5]}), g3 = pg8::gelu_pk((pg8::f32x2){o[6], o[7]});
        bf16* yo = ygo + (size_t)(b * SEQ + c * 32 + j) * SSMW + g * 16 + 4 * hw;
        v2u w0; w0.x = pg8::cvt_pk_bf16(g0.x, g0.y); w0.y = pg8::cvt_pk_bf16(g1.x, g1.y); *(v2u*)yo = w0;
        v2u w1; w1.x = pg8::cvt_pk_bf16(g2.x, g2.y); w1.y = pg8::cvt_pk_bf16(g3.x, g3.y); *(v2u*)(yo + 8) = w1;
    }
}


namespace att {
using bf16x8 = __attribute__((ext_vector_type(8))) short;
using s16x4  = __attribute__((ext_vector_type(4))) short;
using f32x16 = __attribute__((ext_vector_type(16))) float;
using u32x4  = __attribute__((ext_vector_type(4))) unsigned;
constexpr int D = 128, NW = 8, QBLK = 32, KVBLK = 64;
constexpr float SCALE = 0.088388347648318440f;
constexpr float THR = 8.f;
constexpr int LDK = NPROJ;
constexpr int SHM_V = KVBLK * D * 2, SHM_K = KVBLK * D * 2, SHM_ATTN = 2 * SHM_V + 2 * SHM_K + NW * 64 * 4;
#define KSWZ(row, colB) ((row) * 256 + ((colB) ^ (((row) & 7) << 4)))
#define SBAR() __builtin_amdgcn_sched_barrier(0)
__device__ __forceinline__ int crow(int r, int hi) { return (r & 3) + 8 * (r >> 2) + 4 * hi; }
__device__ __forceinline__ unsigned cvtpk(float lo, float hi) { unsigned r; asm volatile("v_cvt_pk_bf16_f32 %0, %1, %2" : "=v"(r) : "v"(lo), "v"(hi)); return r; }

__device__ __forceinline__ void partialSM(f32x16& p0, f32x16& p1, float& m_reg, float& mn, float& alpha, float base) {
  constexpr float C = SCALE * 1.4426950408889634f;
  float pm0 = p0[0], pm1 = p0[1], pm2 = p0[2], pm3 = p0[3];
#define MX3(a, b, c) __builtin_fmaxf(__builtin_fmaxf(a, b), c)
  pm0 = MX3(pm0, p0[4], p0[8]); pm1 = MX3(pm1, p0[5], p0[9]); pm2 = MX3(pm2, p0[6], p0[10]); pm3 = MX3(pm3, p0[7], p0[11]);
  pm0 = MX3(pm0, p0[12], p1[0]); pm1 = MX3(pm1, p0[13], p1[1]); pm2 = MX3(pm2, p0[14], p1[2]); pm3 = MX3(pm3, p0[15], p1[3]);
  pm0 = MX3(pm0, p1[4], p1[8]); pm1 = MX3(pm1, p1[5], p1[9]); pm2 = MX3(pm2, p1[6], p1[10]); pm3 = MX3(pm3, p1[7], p1[11]);
  pm0 = MX3(pm0, p1[12], p1[13]); pm1 = MX3(pm1, p1[14], p1[15]);
  float pmax = MX3(pm0, pm1, pm2); pmax = fmaxf(pmax, pm3);
#undef MX3
  pmax += base;
  { auto rr = __builtin_amdgcn_permlane32_swap(__float_as_uint(pmax), __float_as_uint(pmax), false, false);
    pmax = fmaxf(__uint_as_float(rr[0]), __uint_as_float(rr[1])); }
  if (__builtin_expect(__all(pmax - m_reg <= THR / SCALE), 1)) { mn = m_reg; alpha = 1.f; }
  else { mn = fmaxf(m_reg, pmax); alpha = __builtin_amdgcn_exp2f((m_reg - mn) * C); m_reg = mn; }
  float mnC = (base - mn) * C;
  for (int r = 0; r < 16; ++r) p0[r] = fmaf(p0[r], C, mnC); for (int r = 0; r < 16; ++r) p1[r] = fmaf(p1[r], C, mnC);
  for (int r = 0; r < 16; ++r) p0[r] = __builtin_amdgcn_exp2f(p0[r]);
}
__device__ __forceinline__ void finishSM(f32x16& p0, f32x16& p1, float alpha, float& l_reg, bf16x8& pa0, bf16x8& pa1, bf16x8& pa2, bf16x8& pa3) {
  for (int r = 0; r < 16; ++r) p1[r] = __builtin_amdgcn_exp2f(p1[r]);
  float ps = 0; for (int r = 0; r < 16; ++r) ps += p0[r]; for (int r = 0; r < 16; ++r) ps += p1[r];
  { auto rr = __builtin_amdgcn_permlane32_swap(__float_as_uint(ps), __float_as_uint(ps), false, false);
    ps = __uint_as_float(rr[0]) + __uint_as_float(rr[1]); }
  l_reg = l_reg * alpha + ps;
#define PK4(P, BASE, OUT) do { unsigned a0 = cvtpk(P[BASE + 0], P[BASE + 1]), a1 = cvtpk(P[BASE + 2], P[BASE + 3]);   \
    unsigned b0 = cvtpk(P[BASE + 4], P[BASE + 5]), b1 = cvtpk(P[BASE + 6], P[BASE + 7]);                              \
    auto r0 = __builtin_amdgcn_permlane32_swap(a0, b0, false, false); auto r1 = __builtin_amdgcn_permlane32_swap(a1, b1, false, false); \
    u32x4 w = {r0[0], r1[0], r0[1], r1[1]}; OUT = *reinterpret_cast<bf16x8*>(&w); } while (0)
  PK4(p0, 0, pa0); PK4(p0, 8, pa1); PK4(p1, 0, pa2); PK4(p1, 8, pa3);
#undef PK4
}
__device__ __forceinline__ void qkt(f32x16& p0, f32x16& p1, const bf16* Ks, const bf16x8* qr, int r32, int hi, float slopeS, v2u mw) {
  p0 = f32x16{}; p1 = f32x16{};
  for (int d0 = 0; d0 < 8; ++d0) { int cb = (d0 * 16 + hi * 8) * 2;
    bf16x8 b0 = *reinterpret_cast<const bf16x8*>((const char*)Ks + KSWZ(r32, cb));
    bf16x8 b1 = *reinterpret_cast<const bf16x8*>((const char*)Ks + KSWZ(32 + r32, cb));
    p0 = __builtin_amdgcn_mfma_f32_32x32x16_bf16(b0, qr[d0], p0, 0, 0, 0);
    p1 = __builtin_amdgcn_mfma_f32_32x32x16_bf16(b1, qr[d0], p1, 0, 0, 0); }
  const unsigned s0 = mw.x >> (4 * hi), s1 = mw.y >> (4 * hi); const float NEG = -__builtin_inff();
#pragma unroll
  for (int r = 0; r < 16; ++r) { const int cr = (r & 3) + 8 * (r >> 2);
    const unsigned m0 = (unsigned)(((int)(s0 << (31 - cr))) >> 31), m1 = (unsigned)(((int)(s1 << (31 - cr))) >> 31);
    p0[r] = __uint_as_float((m0 & __float_as_uint(fmaf(slopeS, (float)cr, p0[r]))) | (~m0 & 0xFF800000u));
    p1[r] = __uint_as_float((m1 & __float_as_uint(fmaf(slopeS, (float)(32 + cr), p1[r]))) | (~m1 & 0xFF800000u)); }
  (void)NEG;
}
__device__ __forceinline__ int v_st(int k, int c) { const int kk = (k & ~0xC) | ((k & 4) << 1) | ((k & 8) >> 1); return ((kk >> 3) * 4 + (c >> 5)) * 512 + ((kk & 7) * 32 + (c & 31)) * 2; }
__device__ __forceinline__ int v_rd_base(int lane) { return ((lane & 3) << 3) | (((lane >> 2) & 3) << 6) | (((lane >> 4) & 1) << 5) | (((lane >> 5) & 1) << 8); }
constexpr int v_rd_off(int d0, int ks, int half) { return d0 * 512 + ks * 4096 + half * 2048; }
template <int OFF> __device__ __forceinline__ s16x4 tr_read(int vb) {
  s16x4 r; asm volatile("ds_read_b64_tr_b16 %0, %1 offset:%2" : "=&v"(r) : "v"(vb), "i"(OFF) : "memory"); return r;
}
template <int D0> __device__ __forceinline__ void pv_one(f32x16& od, int vb, bf16x8 pa0, bf16x8 pa1, bf16x8 pa2, bf16x8 pa3) {
  const s16x4 l0 = tr_read<v_rd_off(D0, 0, 0)>(vb), h0 = tr_read<v_rd_off(D0, 0, 1)>(vb), l1 = tr_read<v_rd_off(D0, 1, 0)>(vb), h1 = tr_read<v_rd_off(D0, 1, 1)>(vb);
  const s16x4 l2 = tr_read<v_rd_off(D0, 2, 0)>(vb), h2 = tr_read<v_rd_off(D0, 2, 1)>(vb), l3 = tr_read<v_rd_off(D0, 3, 0)>(vb), h3 = tr_read<v_rd_off(D0, 3, 1)>(vb);
  asm volatile("s_waitcnt lgkmcnt(0)" ::: "memory"); SBAR();
#define PK(L, H) (bf16x8){L[0], L[1], L[2], L[3], H[0], H[1], H[2], H[3]}
  od = __builtin_amdgcn_mfma_f32_32x32x16_bf16(pa0, PK(l0, h0), od, 0, 0, 0);
  od = __builtin_amdgcn_mfma_f32_32x32x16_bf16(pa1, PK(l1, h1), od, 0, 0, 0);
  od = __builtin_amdgcn_mfma_f32_32x32x16_bf16(pa2, PK(l2, h2), od, 0, 0, 0);
  od = __builtin_amdgcn_mfma_f32_32x32x16_bf16(pa3, PK(l3, h3), od, 0, 0, 0);
#undef PK
}
__device__ __forceinline__ void pv_d0(f32x16* o, int vb, bf16x8 pa0, bf16x8 pa1, bf16x8 pa2, bf16x8 pa3) {
  pv_one<0>(o[0], vb, pa0, pa1, pa2, pa3); pv_one<1>(o[1], vb, pa0, pa1, pa2, pa3); pv_one<2>(o[2], vb, pa0, pa1, pa2, pa3); pv_one<3>(o[3], vb, pa0, pa1, pa2, pa3);
}
__device__ __forceinline__ void attn_mask_body(const bf16* __restrict__ Qb, const bf16* __restrict__ Kh, const bf16* __restrict__ Vh, const unsigned* __restrict__ Mb,
                                               unsigned char* __restrict__ Ob, int seq, float slopeS, char* lds) {
  const int tid = threadIdx.x, wid = tid >> 6, lane = tid & 63, r32 = lane & 31, hi = lane >> 5;
  bf16* V_lds = (bf16*)lds; bf16* K_lds = (bf16*)(lds + 2 * SHM_V);
  float* ws = (float*)(lds + 2 * SHM_V + 2 * SHM_K) + wid * 64; float* li_l = ws; float* al_l = ws + 32;
  float m_reg = -1e30f, l_reg = 0; f32x16 o[4] = {}; bf16x8 qr[8];
  const bf16* Qw = Qb + (long)(wid * QBLK + r32) * NPROJ + hi * 8;
#pragma unroll
  for (int d0 = 0; d0 < 8; ++d0) qr[d0] = *reinterpret_cast<const bf16x8*>(Qw + d0 * 16);
  const unsigned mvoff = (unsigned)(wid * QBLK + r32) * 256u;
#define MWLD(j) __builtin_bit_cast(v2u, __builtin_amdgcn_raw_buffer_load_b64(rm, mvoff, (j) * 8, 0))
  const float hb = slopeS * (float)(4 * hi);
  const int sr = tid >> 4, sc = (tid & 15) * 8, vst0 = v_st(sr, sc), vst1 = v_st(32 + sr, sc);
  const int vb0 = (int)(uintptr_t)V_lds + v_rd_base(lane);
  struct { bf16x8 vs0, vs1, ks0, ks1; } sr_[2];
  const unsigned kvoff = (unsigned)(sr * LDK + sc) * 2u;
  const __amdgpu_buffer_rsrc_t rk = __builtin_amdgcn_make_buffer_rsrc((void*)Kh, 0, SEQ * NPROJ * 2, 0x00020000);
  const __amdgpu_buffer_rsrc_t rv = __builtin_amdgcn_make_buffer_rsrc((void*)Vh, 0, SEQ * NPROJ * 2, 0x00020000);
  const __amdgpu_buffer_rsrc_t rm = __builtin_amdgcn_make_buffer_rsrc((void*)Mb, 0, 256 * 256, 0x00020000);
#define BL16(rs, so) __builtin_bit_cast(bf16x8, __builtin_amdgcn_raw_buffer_load_b128(rs, kvoff, (so), 0))
#define SLOAD(i, k0) do { const int so_ = (k0) * (LDK * 2); \
    sr_[i].vs0 = BL16(rv, so_); sr_[i].vs1 = BL16(rv, so_ + 32 * LDK * 2); sr_[i].ks0 = BL16(rk, so_); sr_[i].ks1 = BL16(rk, so_ + 32 * LDK * 2); } while (0)
#define SWRITE(b, i) do { *(bf16x8*)((char*)V_lds + (b) * SHM_V + vst0) = sr_[i].vs0;          \
    *(bf16x8*)((char*)V_lds + (b) * SHM_V + vst1) = sr_[i].vs1; int kc = sc * 2;               \
    *(bf16x8*)((char*)K_lds + (b) * SHM_K + KSWZ(sr, kc)) = sr_[i].ks0;                       \
    *(bf16x8*)((char*)K_lds + (b) * SHM_K + KSWZ(32 + sr, kc)) = sr_[i].ks1; } while (0)
#define SWAIT() asm volatile("s_waitcnt vmcnt(4)" ::: "memory")
#define RESC(a) do { if (__any((a) < 1.f)) { if (hi == 0) al_l[r32] = (a); asm volatile("s_waitcnt lgkmcnt(0)" ::: "memory"); \
    for (int d = 0; d < 4; ++d) for (int r = 0; r < 16; ++r) o[d][r] *= al_l[crow(r, hi)]; } } while (0)
#define TBASE(j) fmaf(slopeS, (float)(64 * (j)), hb)
  f32x16 pA0, pA1, pB0, pB1; float mnA, mnB, alA, alB; bf16x8 pa0, pa1, pa2, pa3; const int NT = seq / KVBLK;
  constexpr int SE = 0, SO = 1;
  v2u mwA = MWLD(0), mwB = MWLD(1);
  SLOAD(SE, 0); asm volatile("s_waitcnt vmcnt(0)" ::: "memory"); SWRITE(0, SE); __syncthreads();
  qkt(pA0, pA1, K_lds, qr, r32, hi, slopeS, mwA); partialSM(pA0, pA1, m_reg, mnA, alA, TBASE(0));
  SLOAD(SO, KVBLK); if (2 < NT) SLOAD(SE, 2 * KVBLK);
  SWAIT(); SWRITE(1, SO); __syncthreads();
  for (int j = 1; j + 1 < NT; j += 2) {
    mwA = MWLD(j + 1);
    SBAR(); qkt(pB0, pB1, (bf16*)((char*)K_lds + SHM_K), qr, r32, hi, slopeS, mwB);
    finishSM(pA0, pA1, alA, l_reg, pa0, pa1, pa2, pa3); SBAR();
    SLOAD(SO, (j + 2) * KVBLK); SBAR();
    pv_d0(o, vb0, pa0, pa1, pa2, pa3); partialSM(pB0, pB1, m_reg, mnB, alB, TBASE(j));
    __syncthreads(); SWAIT(); SWRITE(0, SE);
    RESC(alB); __syncthreads();
    mwB = MWLD(j + 2);
    SBAR(); qkt(pA0, pA1, K_lds, qr, r32, hi, slopeS, mwA);
    finishSM(pB0, pB1, alB, l_reg, pa0, pa1, pa2, pa3); SBAR();
    if (j + 3 < NT) SLOAD(SE, (j + 3) * KVBLK); SBAR();
    pv_d0(o, vb0 + (int)SHM_V, pa0, pa1, pa2, pa3); partialSM(pA0, pA1, m_reg, mnA, alA, TBASE(j + 1));
    __syncthreads(); SWAIT(); SWRITE(1, SO);
    RESC(alA); __syncthreads();
  }
  SBAR(); qkt(pB0, pB1, (bf16*)((char*)K_lds + SHM_K), qr, r32, hi, slopeS, mwB);
  finishSM(pA0, pA1, alA, l_reg, pa0, pa1, pa2, pa3); SBAR();
  pv_d0(o, vb0, pa0, pa1, pa2, pa3); partialSM(pB0, pB1, m_reg, mnB, alB, TBASE(NT - 1));
  __syncthreads(); RESC(alB);
  finishSM(pB0, pB1, alB, l_reg, pa0, pa1, pa2, pa3); SBAR();
  pv_d0(o, vb0 + (int)SHM_V, pa0, pa1, pa2, pa3);
  if (hi == 0) li_l[r32] = l_reg; asm volatile("s_waitcnt lgkmcnt(0)" ::: "memory");
  float rli[16];
#pragma unroll
  for (int r = 0; r < 16; ++r) rli[r] = __builtin_amdgcn_rcpf(li_l[crow(r, hi)]);
  unsigned char* Ow = Ob + (long)(wid * QBLK) * 2048;
#pragma unroll
  for (int r = 0; r < 16; ++r) { int orow = crow(r, hi); const float sc = rli[r] * SC_MIX;
    const unsigned w = pk4_fp8(o[0][r] * sc, o[1][r] * sc, o[2][r] * sc, o[3][r] * sc);
    for (int d0 = 0; d0 < 4; ++d0) Ow[(long)orow * 2048 + d0 * 32 + r32] = (unsigned char)(w >> (8 * d0)); }
#undef SLOAD
#undef SWRITE
#undef SWAIT
#undef RESC
#undef TBASE
#undef MWLD
#undef BL16
}
#undef KSWZ
#undef SBAR
}

template <bool OUT_BF16, bool IN_BF16 = false>
__device__ __forceinline__ void ln_row(const void* xrow, void* orow, const float* gam, const float* bet, int lane, unsigned* q8row = nullptr, float q8scale = 1.f) {
    const f32x4* xr = (const f32x4*)xrow + lane; const v2u* xh = (const v2u*)xrow + lane; const f32x4* gr = (const f32x4*)gam + lane; const f32x4* br = (const f32x4*)bet + lane;
    f32x4 v[8]; float s = 0.f;
#pragma unroll
    for (int j = 0; j < 8; ++j) { if constexpr (IN_BF16) { const v2u w = xh[64 * j]; v[j] = (f32x4){bflo(w.x), bfhi(w.x), bflo(w.y), bfhi(w.y)}; } else v[j] = xr[64 * j];
        s += (v[j][0] + v[j][1]) + (v[j][2] + v[j][3]); }
    const float mean = wave_sum(s) * (1.f / DM); float s2 = 0.f;
#pragma unroll
    for (int j = 0; j < 8; ++j) { v[j] = v[j] - mean; s2 += (v[j][0] * v[j][0] + v[j][1] * v[j][1]) + (v[j][2] * v[j][2] + v[j][3] * v[j][3]); }
    const float rstd = 1.f / sqrtf(wave_sum(s2) * (1.f / DM) + LN_EPS);
#pragma unroll
    for (int j = 0; j < 8; ++j) { const f32x4 o = v[j] * rstd * gr[64 * j] + br[64 * j];
        if constexpr (OUT_BF16) { v2u w; w.x = pk2(o[0], o[1]); w.y = pk2(o[2], o[3]); ((v2u*)orow)[lane + 64 * j] = w;
            if (q8row) q8row[lane + 64 * j] = pk4_fp8(o[0] * q8scale, o[1] * q8scale, o[2] * q8scale, o[3] * q8scale); }
        else ((f32x4*)orow)[lane + 64 * j] = o; }
}
template <bool OUT_BF16, bool IN_BF16 = false>
__device__ __forceinline__ void ln_row2(const void* xa, const void* xb_, void* oa, void* ob, const float* gam, const float* bet, int lane, unsigned* qa = nullptr, unsigned* qb = nullptr, float q8scale = 1.f, float2* sa = nullptr, float2* sb = nullptr) {
    const f32x4* gr = (const f32x4*)gam + lane; const f32x4* br = (const f32x4*)bet + lane;
    f32x4 v[2][8]; float s[2] = {0.f, 0.f};
#pragma unroll
    for (int r = 0; r < 2; ++r) { const void* xrow = r ? xb_ : xa; const f32x4* xr = (const f32x4*)xrow + lane; const v2u* xh = (const v2u*)xrow + lane;
#pragma unroll
        for (int j = 0; j < 8; ++j) { if constexpr (IN_BF16) { const v2u w = xh[64 * j]; v[r][j] = (f32x4){bflo(w.x), bfhi(w.x), bflo(w.y), bfhi(w.y)}; } else v[r][j] = xr[64 * j]; } }
#pragma unroll
    for (int r = 0; r < 2; ++r)
#pragma unroll
        for (int j = 0; j < 8; ++j) s[r] += (v[r][j][0] + v[r][j][1]) + (v[r][j][2] + v[r][j][3]);
    const float mean0 = wave_sum(s[0]) * (1.f / DM), mean1 = wave_sum(s[1]) * (1.f / DM); float s2[2] = {0.f, 0.f};
#pragma unroll
    for (int r = 0; r < 2; ++r) { const float mean = r ? mean1 : mean0;
#pragma unroll
        for (int j = 0; j < 8; ++j) { v[r][j] = v[r][j] - mean; s2[r] += (v[r][j][0] * v[r][j][0] + v[r][j][1] * v[r][j][1]) + (v[r][j][2] * v[r][j][2] + v[r][j][3] * v[r][j][3]); } }
    const float rstd0 = 1.f / sqrtf(wave_sum(s2[0]) * (1.f / DM) + LN_EPS), rstd1 = 1.f / sqrtf(wave_sum(s2[1]) * (1.f / DM) + LN_EPS);
    if (sa && lane == 0) { *sa = make_float2(mean0, rstd0); *sb = make_float2(mean1, rstd1); }
#pragma unroll
    for (int j = 0; j < 8; ++j) { const f32x4 g = gr[64 * j], b = br[64 * j];
#pragma unroll
        for (int r = 0; r < 2; ++r) { const f32x4 o = v[r][j] * (r ? rstd1 : rstd0) * g + b; void* orow = r ? ob : oa; unsigned* q8row = r ? qb : qa;
            if constexpr (OUT_BF16) { if (orow) { v2u w; w.x = pk2(o[0], o[1]); w.y = pk2(o[2], o[3]); ((v2u*)orow)[lane + 64 * j] = w; }
                if (q8row) q8row[lane + 64 * j] = pk4_fp8(o[0] * q8scale, o[1] * q8scale, o[2] * q8scale, o[3] * q8scale); }
            else ((f32x4*)orow)[lane + 64 * j] = o; } }
}
__device__ __forceinline__ float gelu_erf(float v) { return 0.5f * v * (1.0f + erff(v * 0.70710678118654752f)); }

__device__ __forceinline__ void ln_row2_mx6(const bf16* ra, const bf16* rb, const f32x4 (&g8)[8], const f32x4 (&b8)[8], int lane, unsigned char* qa, unsigned char* qb, float2* sa, float2* sb) {
    float v[2][32];
#pragma unroll
    for (int q = 0; q < 2; ++q) { const v4u* rp = (const v4u*)((q ? rb : ra) + 32 * lane);
#pragma unroll
        for (int j = 0; j < 4; ++j) { const v4u w = rp[j]; v[q][8 * j] = bflo(w.x); v[q][8 * j + 1] = bfhi(w.x); v[q][8 * j + 2] = bflo(w.y); v[q][8 * j + 3] = bfhi(w.y);
            v[q][8 * j + 4] = bflo(w.z); v[q][8 * j + 5] = bfhi(w.z); v[q][8 * j + 6] = bflo(w.w); v[q][8 * j + 7] = bfhi(w.w); } }
    float s0 = 0.f, s1 = 0.f;
#pragma unroll
    for (int i = 0; i < 32; ++i) { s0 += v[0][i]; s1 += v[1][i]; }
    const float mean0 = wave_sum(s0) * (1.f / DM), mean1 = wave_sum(s1) * (1.f / DM);
    float t0 = 0.f, t1 = 0.f;
#pragma unroll
    for (int i = 0; i < 32; ++i) { const float d0 = v[0][i] - mean0, d1 = v[1][i] - mean1; t0 = fmaf(d0, d0, t0); t1 = fmaf(d1, d1, t1); }
    const float rstd0 = 1.f / sqrtf(wave_sum(t0) * (1.f / DM) + LN_EPS), rstd1 = 1.f / sqrtf(wave_sum(t1) * (1.f / DM) + LN_EPS);
    if (lane == 0) { *sa = make_float2(mean0, rstd0); *sb = make_float2(mean1, rstd1); }
    v16f32 x0, y0, x1, y1;
#pragma unroll
    for (int j = 0; j < 8; ++j) { const f32x4 g = g8[j], b = b8[j];
#pragma unroll
        for (int e = 0; e < 4; ++e) { const int i = 4 * j + e; const float o0 = (v[0][i] - mean0) * rstd0 * g[e] + b[e], o1 = (v[1][i] - mean1) * rstd1 * g[e] + b[e];
            if (i < 16) { x0[i] = o0; x1[i] = o1; } else { y0[i - 16] = o0; y1[i - 16] = o1; } } }
    float a0, a1; MX6_AMAX(x0, y0, a0); MX6_AMAX(x1, y1, a1);
    mx6_store_block(qa, lane, x0, y0, a0); mx6_store_block(qb, lane, x1, y1, a1);
}

struct Args { const float* in[22]; float* out; unsigned char* ws; int ph_lo, ph_hi; };
constexpr int N_PHASES = 11;
__global__ void __launch_bounds__(NWAVES * 64, 2) mk_fwd(Args args) {
    extern __shared__ __attribute__((aligned(16))) unsigned char lds[];
    Frame F;
    F.lds = (LAS unsigned char*)lds;
    F.MISC = (volatile LAS unsigned*)(F.lds + MISC_OFF);
    F.tid = threadIdx.x; F.lane = F.tid & 63; F.wave = __builtin_amdgcn_readfirstlane(F.tid >> 6);
    F.G = gridDim.x; { const int bx = blockIdx.x; F.vcu = (F.G % 8 == 0) ? (bx % 8) * (F.G / 8) + bx / 8 : bx; }
    F.ws = args.ws; F.out = args.out; F.ctl = (unsigned*)(args.ws + WS_CTL);
#pragma unroll
    for (int i = 0; i < 22; ++i) F.in[i] = args.in[i];
    for (int u = F.tid; u < (LDS_BYTES - LDSCTL_OFF) / 4; u += NWAVES * 64) ((LAS unsigned*)(F.lds + LDSCTL_OFF))[u] = 0u;
    __syncthreads();
    const int lo = args.ph_lo, hi = args.ph_hi;
    XcdBarrier bar; bar.bar = F.ctl + CW_BAR; bar.x = 0; bar.st = nullptr;
    if (hi - lo > 1) bar = xcd_barrier_post(F.ctl + CW_BAR, F.MISC + 8);
#define IN(k) (lo <= (k) && (k) < hi)
#define SEAM(k) do { if (IN(k) && IN((k) + 1)) xcd_barrier(bar); } while (0)
    const int gw = F.vcu * NWAVES + F.wave, NGW = F.G * NWAVES;
    bf16* xb = (bf16*)(F.ws + WS_XB); bf16* proj = (bf16*)(F.ws + WS_PROJ); bf16* ygb = (bf16*)(F.ws + WS_YG); unsigned char* mix8 = (unsigned char*)(F.ws + WS_MIX);   unsigned char* act8 = (unsigned char*)(F.ws + WS_ACT);

    if (IN(0)) { p0_prologue(F); } SEAM(0);
    if (IN(1)) {
        const int c = (int)blockIdx.x; const bool g256 = (F.G == 256);
        pg8::ListOrder Sb, Sf;
        if (g256) { Sb.init(M, NPROJ - NP8, c, 256, c < 64 ? 2 : 1); Sf.init(M, NP8, c, 192, c < 64 ? 1 : 3); }
        else { Sb.init(M, NPROJ - NP8, c, F.G, 1 << 20); Sf.init(M, NP8, c, F.G, 1 << 20); }
        { pg8::Gemm g{xb, (const bf16*)(F.ws + WS_WIN) + (size_t)NP8 * DM, M, NPROJ - NP8, DM};
          pg8::EpiProj E{proj, NPROJ, (bf16*)(F.ws + WS_KIPACK), KI_OFF, SEQ, NP8, 1.f};
          pg8::gemm_phase<pg8::EpiProj, pg8::ListOrder, true, true, false>(F.lds + RING_OFF, g, Sb, E); }
        { pg8::Gemm g{(const bf16*)(F.ws + WS_MIX + 32 * MiB), (const bf16*)(F.ws + WS_WIN8), M, NP8, DM / 2};
          pg8::EpiProj E{proj, NPROJ, (bf16*)(F.ws + WS_KIPACK), KI_OFF, SEQ, 0, 1.f};
          pg8::gemm_phase<pg8::EpiProj, pg8::ListOrder, true, true, true, true>(F.lds + RING_OFF, g, Sf, E); }
    } SEAM(1);
    if (IN(2)) {
        { const int g = (F.vcu >> 2) & (NG - 1); LAS fl4* tInv = (LAS fl4*)(F.lds + RING_OFF); LAS fl4* tW = tInv + 2 * 8 * 64;
          for (int i = F.tid; i < 1024; i += NWAVES * 64) { tInv[i] = ((const fl4*)(F.ws + WS_TABINV))[g * 1024 + i]; tW[i] = ((const fl4*)(F.ws + WS_TABW))[g * 1024 + i]; }
          const int ib = F.vcu & 7;
          { const v4u* ksrc = (const v4u*)(F.ws + WS_KIPACK + (size_t)ib * 64 * 4096); LAS v4u* kdst = (LAS v4u*)(F.lds + RING_OFF + 32768);
#pragma unroll 4
            for (int i = F.tid; i < IDX_NLDS * 256; i += NWAVES * 64) kdst[i] = ksrc[i]; }
          LDS_WAIT(); __syncthreads();
          if ((F.wave & 2) == 0) { const int bb = 2 * (F.vcu & 3) + (F.wave & 1), half = F.wave >> 2;
              if (F.vcu < 4 * NG) ssm_mfma_task(F, bb, g, tInv, tW, ygb, 0, half ? SEQ / 64 : 0, half ? SEQ / 32 : SEQ / 64); }
          { LAS unsigned* ctr = (LAS unsigned*)(F.lds + MISC_OFF + 64); LAS unsigned* ctr2 = (LAS unsigned*)(F.lds + MISC_OFF + 68); const int ic = F.vcu >> 3, inb = (F.G - ib + 7) >> 3, npb = (SEQ / 2 + inb - 1) / inb;
            const LAS bf16* kl = (const LAS bf16*)(F.lds + RING_OFF + 32768) + F.lane * 8;
#pragma unroll 1
            for (int pass = 0; pass < 3; ++pass) {
                if (pass == 1) {
                    for (;;) { unsigned m = 0; if (F.lane == 0) m = __hip_atomic_fetch_add(ctr, 1u, __ATOMIC_RELAXED, __HIP_MEMORY_SCOPE_WORKGROUP);
                        m = __builtin_amdgcn_readfirstlane(m); if ((int)m >= npb) break;
                        const int k = (int)m * inb + ((m & 1u) ? inb - 1 - ic : ic); if (k >= SEQ / 2) continue;
                        int ibo; asm volatile("s_mov_b32 %0, %1" : "=s"(ibo) : "s"(ib));
                        idx_mfma_pair(F, ibo, 1023 - k, (unsigned*)(F.ws + WS_MASK), kl); }
                } else if (pass == 2 || F.wave == 7) {
                    for (;;) { unsigned m = 0; if (F.lane == 0) m = __hip_atomic_fetch_add(ctr2, 1u, __ATOMIC_RELAXED, __HIP_MEMORY_SCOPE_WORKGROUP);
                        m = __builtin_amdgcn_readfirstlane(m); const int it = (int)m * F.G + F.vcu; if (it >= P2W_ITEMS) break;
                        p2_weight_item(F, it); } }
            } } }
    } SEAM(2);
    if (IN(3)) {
        const unsigned* maskw = (const unsigned*)(F.ws + WS_MASK);
#pragma unroll 1
        for (int pi = F.vcu; pi < 256; pi += F.G) { const int b = pi >> 5, h = (pi >> 2) & 7, qp = pi & 3, c = h >> 2;
#pragma unroll 1
            for (int half = 0; half < 2; ++half) { const int qb = half ? qp : 7 - qp; const size_t row0 = (size_t)b * SEQ + qb * 256;
                att::attn_mask_body(proj + row0 * NPROJ + Q_OFF + h * HD, proj + (size_t)b * SEQ * NPROJ + K_OFF + c * HD, proj + (size_t)b * SEQ * NPROJ + V_OFF + c * HD,
                                    maskw + row0 * 64, mix8 + row0 * 2048 + 1024 + h * HD, 256 * (qb + 1), exp2f(-(float)(h + 1)) / att::SCALE, (char*)lds + RING_OFF);
                __syncthreads(); } }
    }
    if (IN(4)) { pg8::Gemm g{ygb, (const bf16*)(F.ws + WS_WGLU), M, SSMW, SSMW}; pg8::StaticOrder S; S.init(M, SSMW, F.G, (int)blockIdx.x);
        pg8::EpiGlu E{ygb, mix8, SSMW, 2048, F.in[I_BGLU], SC_MIX};
        pg8::gemm_phase<pg8::EpiGlu, pg8::StaticOrder, true, true>(F.lds + RING_OFF, g, S, E); } SEAM(4);
    if (IN(5)) { pg8::Gemm g{(const bf16*)mix8, (const bf16*)(F.ws + WS_WOUT), M, DM, 2048 / 2}; pg8::StaticOrder S; S.init(M, DM, F.G, (int)blockIdx.x);
        pg8::EpiRes<true, true> E{xb, F.out, DM, DN_ALPHA, 1.f / (SC_MIX * SC_WOUT)};
        pg8::gemm_phase<pg8::EpiRes<true, true>, pg8::StaticOrder, true, true, true>(F.lds + RING_OFF, g, S, E); } SEAM(5);
    if (IN(6)) { unsigned* q8 = (unsigned*)(F.ws + WS_MIX + 32 * MiB); const bf16* r1b = (const bf16*)F.out;
        f32x4 g8[8], b8[8];
#pragma unroll
        for (int j = 0; j < 8; ++j) { g8[j] = ((const f32x4*)(F.in[I_LN1G] + 32 * F.lane))[j]; b8[j] = ((const f32x4*)(F.in[I_LN1B] + 32 * F.lane))[j]; }
        for (int m = gw; m < M; m += 2 * NGW) { const int m2 = (m + NGW < M) ? m + NGW : m;
            ln_row2_mx6(r1b + (size_t)m * DM, r1b + (size_t)m2 * DM, g8, b8, F.lane, (unsigned char*)q8 + (size_t)m * DM, (unsigned char*)q8 + (size_t)m2 * DM,
                        (float2*)(F.ws + WS_RSTAT) + m, (float2*)(F.ws + WS_RSTAT) + m2); } } SEAM(6);
    if (IN(7)) { pg8::Gemm g{(const bf16*)(F.ws + WS_MIX + 32 * MiB), (const bf16*)(F.ws + WS_WUG), M, NUG, DM / 2}; pg8::StaticOrder S; S.init(M, NUG, F.G, (int)blockIdx.x);
        pg8::EpiFfn E{act8, (float*)(F.ws + WS_PEND_UP), (float*)(F.ws + WS_PEND_G), (float*)(F.ws + WS_HALO), F.in[I_CONVW], F.in[I_CONVB], DFF, 1.f, SC_ACT};
        pg8::gemm_phase<pg8::EpiFfn, pg8::StaticOrder, true, true, true, true>(F.lds + RING_OFF, g, S, E); } SEAM(7);
    if (IN(8)) { const float* pu = (const float*)(F.ws + WS_PEND_UP); const float* pg = (const float*)(F.ws + WS_PEND_G); const float* ph = (const float*)(F.ws + WS_HALO);
        const float* cw = F.in[I_CONVW]; const float* cb = F.in[I_CONVB];
        for (int idx = F.vcu * 512 + F.tid; idx < 512 * (DFF / 4); idx += F.G * 512) { const int r2 = idx / (DFF / 4), f = (idx % (DFF / 4)) * 4, rb = r2 >> 1, rho = r2 & 1; const bool first = (rb & 31) == 0;
            const f32x4 x0 = *(const f32x4*)(pu + (size_t)r2 * DFF + f), gt = *(const f32x4*)(pg + (size_t)r2 * DFF + f); const f32x4 z = {0.f, 0.f, 0.f, 0.f};
            f32x4 h1, h2;
            if (rho == 0) { h1 = first ? z : *(const f32x4*)(ph + (size_t)((rb - 1) * 2 + 1) * DFF + f); h2 = first ? z : *(const f32x4*)(ph + (size_t)((rb - 1) * 2) * DFF + f); }
            else { h1 = *(const f32x4*)(pu + (size_t)(rb * 2) * DFF + f); h2 = first ? z : *(const f32x4*)(ph + (size_t)((rb - 1) * 2 + 1) * DFF + f); }
            const f32x4 hc = *(const f32x4*)(cb + f) + *(const f32x4*)(cw + f) * h2 + *(const f32x4*)(cw + DFF + f) * h1 + *(const f32x4*)(cw + 2 * DFF + f) * x0;
            *(unsigned*)(act8 + (size_t)(rb * 64 + rho) * DFF + f) = pk4_fp8(gelu_erf(hc[0]) * gt[0] * SC_ACT, gelu_erf(hc[1]) * gt[1] * SC_ACT, gelu_erf(hc[2]) * gt[2] * SC_ACT, gelu_erf(hc[3]) * gt[3] * SC_ACT); } } SEAM(8);
    if (IN(9)) { pg8::Gemm g{(const bf16*)act8, (const bf16*)(F.ws + WS_WDOWN), M, DM, DFF / 2}; pg8::StaticOrder S; S.init(M, DM, F.G, (int)blockIdx.x);
        pg8::EpiDownLN E{(const bf16*)F.out, (bf16*)(F.ws + WS_MIX), (const pg8::f32x2*)(F.ws + WS_RSTAT), F.in[I_LN1G], F.in[I_LN1B], DM, DN_ALPHA, 1.f / (SC_ACT * SC_WDN)};
        pg8::gemm_phase<pg8::EpiDownLN, pg8::StaticOrder, true, true, true>(F.lds + RING_OFF, g, S, E); } SEAM(9);
    if (IN(10)) { const bf16* r2b = (const bf16*)(F.ws + WS_MIX);
        for (int m = gw; m < M; m += 2 * NGW) { const int m2 = (m + NGW < M) ? m + NGW : m;
            ln_row2<false, true>(r2b + (size_t)m * DM, r2b + (size_t)m2 * DM, F.out + (size_t)m * DM, F.out + (size_t)m2 * DM, F.in[I_LN2G], F.in[I_LN2B], F.lane); }
    }
#undef IN
#undef SEAM
}

#ifndef MK_ONE_LAUNCH
#define MK_ONE_LAUNCH 1
#endif
extern "C" void kernel_launch(void* const* d_in, const int* in_sizes, int n_in, void* d_out, int out_size, void* d_ws, size_t ws_size, hipStream_t stream) {
    static int grid = 0;
    if (grid == 0) {
        if (n_in != 22 || in_sizes[0] != M * DM || out_size != M * DM || ws_size < WS_END) { fprintf(stderr, "kernel_launch: shape/workspace mismatch (n_in %d, in0 %d, out %d, ws %zu, need %zu)\n", n_in, n_in > 0 ? in_sizes[0] : -1, out_size, ws_size, (size_t)WS_END); grid = -1; return; }
        int dev = 0, cus = 0, per_cu = 0;
        if (hipGetDevice(&dev) != hipSuccess || hipDeviceGetAttribute(&cus, hipDeviceAttributeMultiprocessorCount, dev) != hipSuccess) { grid = -1; return; }
        if (hipFuncSetAttribute((const void*)mk_fwd, hipFuncAttributeMaxDynamicSharedMemorySize, LDS_BYTES) != hipSuccess) { fprintf(stderr, "kernel_launch: hipFuncSetAttribute failed\n"); grid = -1; return; }
        if (hipOccupancyMaxActiveBlocksPerMultiprocessor(&per_cu, (const void*)mk_fwd, NWAVES * 64, LDS_BYTES) != hipSuccess || per_cu < 1) fprintf(stderr, "kernel_launch: occupancy query reports %d\n", per_cu);
        (void)hipGetLastError();
        grid = cus;
    }
    if (grid < 0) return;
    if (hipMemsetAsync((char*)d_ws + WS_CTL, 0, CTL_ZERO_BYTES, stream) != hipSuccess) return;
    Args a{};
    for (int i = 0; i < 22; ++i) a.in[i] = (const float*)d_in[i];
    a.out = (float*)d_out; a.ws = (unsigned char*)d_ws;
#if MK_ONE_LAUNCH
    a.ph_lo = 0; a.ph_hi = N_PHASES;
    hipLaunchKernelGGL(mk_fwd, dim3(grid), dim3(NWAVES * 64), LDS_BYTES, stream, a);
#else
    for (int p = 0; p < N_PHASES; ++p) { a.ph_lo = p; a.ph_hi = p + 1; hipLaunchKernelGGL(mk_fwd, dim3(grid), dim3(NWAVES * 64), LDS_BYTES, stream, a); }
#endif
}
```

```cpp
#include <hip/hip_runtime.h>
#include <cstdio>
#include <cstdint>
namespace pg8 {
#define PG8_LAS __attribute__((address_space(3)))
typedef unsigned short bf16_t;
typedef short bf16x8 __attribute__((ext_vector_type(8)));
typedef float f32x4 __attribute__((ext_vector_type(4)));
typedef unsigned u32x4 __attribute__((ext_vector_type(4)));
typedef int v8i32 __attribute__((ext_vector_type(8)));
constexpr int BM = 256, BK = 64, HALF = 128, HTB = HALF * BK * 2  , STAGE_BYTES = 8 * HTB, NXCD = 8, WGM = 8;

__host__ __device__ __forceinline__ int lds_byte(int r, int c) { const int st = (r >> 4) * 2 + (c >> 5), rr = r & 15, cc = c & 31, ob = rr * 64 + cc * 2; return st * 1024 + (ob ^ (((ob >> 9) & 1) << 5)); }
__host__ __device__ __forceinline__ void stage_rc(int b, int& R, int& C) { const int st = b / 1024, sb = b % 1024, swz = sb ^ (((sb >> 9) & 1) << 5); R = (st >> 1) * 16 + swz / 64; C = (st & 1) * 32 + (swz % 64) / 2; }
__host__ __device__ __forceinline__ int perm32(int rho) { const int n = rho >> 4, i = rho & 15; return 8 * (i >> 2) + 4 * n + (i & 3); }

struct Unit { int pm, pn; };
struct Gemm { const bf16_t* A; const bf16_t* Bt; int M, N, K; };

struct StaticOrder {
    int nM, nN, nwg, G, c;
    __host__ __device__ void init(int M, int N, int G_, int c_) { nM = M / BM; nN = N / BM; nwg = nM * nN; G = G_; c = c_; }
    __host__ __device__ bool next(int i, Unit& u) const {
        const long L = (long)i * G + c; if (L >= nwg) return false;
        int wgid = (int)L; { const int q = nwg / NXCD, r = nwg % NXCD, xcd = wgid % NXCD, off = wgid / NXCD; wgid = (xcd < r ? xcd * (q + 1) : r * (q + 1) + (xcd - r) * q) + off; }
        const int nig = WGM * nN, gid = wgid / nig, fm = gid * WGM, gsz = (nM - fm) < WGM ? (nM - fm) : WGM;
        u.pm = fm + ((wgid % nig) % gsz); u.pn = (wgid % nig) / gsz; return true;
    }
    __device__ __forceinline__ void a_ready(const Unit&) const {}
    __device__ __forceinline__ void done(const Unit&) const {}
};

struct ListOrder {
    int nM, nN, nwg, L0, dL, cnt;
    __host__ __device__ void init(int M, int N, int L0_, int dL_, int cnt_) { nM = M / BM; nN = N / BM; nwg = nM * nN; L0 = L0_; dL = dL_; cnt = cnt_; }
    __host__ __device__ bool next(int i, Unit& u) const {
        if (i >= cnt) return false; const int L = L0 + i * dL; if (L >= nwg) return false;
        int wgid = L; { const int q = nwg / NXCD, r = nwg % NXCD, xcd = wgid % NXCD, off = wgid / NXCD; wgid = (xcd < r ? xcd * (q + 1) : r * (q + 1) + (xcd - r) * q) + off; }
        const int nig = WGM * nN, gid = wgid / nig, fm = gid * WGM, gsz = (nM - fm) < WGM ? (nM - fm) : WGM;
        u.pm = fm + ((wgid % nig) % gsz); u.pn = (wgid % nig) / gsz; return true;
    }
    __device__ __forceinline__ void a_ready(const Unit&) const {}
    __device__ __forceinline__ void done(const Unit&) const {}
};

__device__ __forceinline__ unsigned cvt_pk_bf16(float lo, float hi) { unsigned r; asm volatile("v_cvt_pk_bf16_f32 %0, %1, %2" : "=v"(r) : "v"(lo), "v"(hi)); return r; }
typedef float f32x2 __attribute__((ext_vector_type(2)));
__device__ __forceinline__ f32x2 gelu_pk(f32x2 v) {
    f32x2 vc; vc.x = __builtin_amdgcn_fmed3f(v.x, -4.6f, 4.6f); vc.y = __builtin_amdgcn_fmed3f(v.y, -4.6f, 4.6f);
    const f32x2 w = vc * vc;
    f32x2 r = w * 7.3846917937e-14f + (-9.6073152826e-12f);
    r = r * w + 5.6255834838e-10f; r = r * w + (-1.9781858177e-08f); r = r * w + 4.7227388803e-07f; r = r * w + (-8.2408235147e-06f); r = r * w + 1.1056416036e-04f;
    r = r * w + (-1.1755027258e-03f); r = r * w + 9.9585457053e-03f; r = r * w + (-6.6482846440e-02f); r = r * w + 3.9894164923e-01f;
    return v * (vc * r + 0.5f);
}

template <int ACT  > struct EpiBf16 {
    static constexpr bool PERM = true, AFTER_DRAIN = false; static_assert(ACT == 0 || ACT == 1, "EpiBf16: ACT is 0 (none) or 1 (gelu_pk)");
    bf16_t* O; int ldc; const float* bias; int split_cols; size_t split_stride; float scale0;
    __device__ __forceinline__ void operator()(const f32x4 (&acc)[2][2][4][2], const Unit& u, int wr, int wc, int fr, int fq) const {
        const int row0 = u.pm * BM + wr * 64 + fr; int colt = u.pn * BM; bf16_t* base = O;
        float sc = 1.f; if (split_cols) { const int t = colt / split_cols; base += (size_t)t * split_stride; colt -= t * split_cols; if (t == 0) sc = scale0; }
        const int col0 = colt + wc * 32 + 8 * fq, bcol0 = u.pn * BM + wc * 32 + 8 * fq;
        f32x4 bv[2][2];
#pragma unroll
        for (int bj = 0; bj < 2; ++bj)
#pragma unroll
            for (int n = 0; n < 2; ++n) bv[bj][n] = bias ? *(const f32x4*)(bias + bcol0 + bj * HALF + 4 * n) : (f32x4){0.f, 0.f, 0.f, 0.f};
#pragma unroll
        for (int ai = 0; ai < 2; ++ai)
#pragma unroll
            for (int m = 0; m < 4; ++m) { bf16_t* rowp = base + (size_t)(row0 + ai * HALF + m * 16) * ldc + col0;
#pragma unroll
                for (int bj = 0; bj < 2; ++bj) { f32x4 v0 = acc[ai][bj][m][0] + bv[bj][0], v1 = acc[ai][bj][m][1] + bv[bj][1];
                    if (ACT == 1) { f32x2 a = gelu_pk((f32x2){v0[0], v0[1]}), b = gelu_pk((f32x2){v0[2], v0[3]}), c = gelu_pk((f32x2){v1[0], v1[1]}), d = gelu_pk((f32x2){v1[2], v1[3]});
                        v0 = (f32x4){a.x, a.y, b.x, b.y}; v1 = (f32x4){c.x, c.y, d.x, d.y}; }
                    v0 = v0 * sc; v1 = v1 * sc; u32x4 w; w.x = cvt_pk_bf16(v0[0], v0[1]); w.y = cvt_pk_bf16(v0[2], v0[3]); w.z = cvt_pk_bf16(v1[0], v1[1]); w.w = cvt_pk_bf16(v1[2], v1[3]);
                    *(u32x4*)(rowp + bj * HALF) = w; } }
    }
};

__device__ __forceinline__ float bf2f(unsigned short b) { return __uint_as_float(((unsigned)b) << 16); }
__device__ __forceinline__ float bflo(unsigned w) { return __uint_as_float(w << 16); }
__device__ __forceinline__ float bfhi(unsigned w) { return __uint_as_float(w & 0xffff0000u); }
__device__ __forceinline__ float dpp_ror1(float x) { return __builtin_bit_cast(float, __builtin_amdgcn_update_dpp(0, __builtin_bit_cast(int, x), 0x121, 0xf, 0xf, false)); }
__device__ __forceinline__ float dpp_ror2(float x) { return __builtin_bit_cast(float, __builtin_amdgcn_update_dpp(0, __builtin_bit_cast(int, x), 0x122, 0xf, 0xf, false)); }
__device__ __forceinline__ float clamp448(float v) { return __builtin_amdgcn_fmed3f(v, -448.f, 448.f); }
__device__ __forceinline__ unsigned pk4_fp8(float a, float b, float c, float d) {
    int w = 0; w = __builtin_amdgcn_cvt_pk_fp8_f32(clamp448(a), clamp448(b), w, false); w = __builtin_amdgcn_cvt_pk_fp8_f32(clamp448(c), clamp448(d), w, true); return (unsigned)w; }
__device__ __forceinline__ float sigmoidf_fast(float v) { return __builtin_amdgcn_rcpf(1.0f + __builtin_amdgcn_exp2f(-1.4426950408889634f * v)); }

struct EpiProj {
    static constexpr bool PERM = true, AFTER_DRAIN = false;
    bf16_t* O; int ldc; bf16_t* kipack; int kcol0; int seq; int col_off; float ascale;
    __device__ __forceinline__ void operator()(const f32x4 (&acc)[2][2][4][2], const Unit& u, int wr, int wc, int fr, int fq) const {
        const int row0 = u.pm * BM + wr * 64 + fr, col0 = col_off + u.pn * BM + wc * 32 + 8 * fq;
        const bool kt_tile = (col_off + u.pn * BM == kcol0) && (wc < 2);
#pragma unroll
        for (int ai = 0; ai < 2; ++ai)
#pragma unroll
            for (int m = 0; m < 4; ++m) { const int row = row0 + ai * HALF + m * 16; bf16_t* rowp = O + (size_t)row * ldc + col0;
#pragma unroll
                for (int bj = 0; bj < 2; ++bj) { const f32x4 v0 = acc[ai][bj][m][0] * ascale, v1 = acc[ai][bj][m][1] * ascale;
                    u32x4 w; w.x = cvt_pk_bf16(v0[0], v0[1]); w.y = cvt_pk_bf16(v0[2], v0[3]); w.z = cvt_pk_bf16(v1[0], v1[1]); w.w = cvt_pk_bf16(v1[2], v1[3]);
                    *(u32x4*)(rowp + bj * HALF) = w;
                    if (bj == 0 && kt_tile) { const int b = row / seq, t = row % seq, d0 = wc * 32 + 8 * fq;
                        *(u32x4*)(kipack + ((size_t)((b * (seq / 32) + (t >> 5)) * 4 + (d0 >> 4)) * 64 + (t & 31) + 32 * ((d0 >> 3) & 1)) * 8) = w; } } }
    }
};
struct EpiGlu {
    static constexpr bool PERM = true, AFTER_DRAIN = false;
    const bf16_t* yg; unsigned char* O; int ldy, ldo; const float* bias; float oscale;
    __device__ __forceinline__ void operator()(const f32x4 (&acc)[2][2][4][2], const Unit& u, int wr, int wc, int fr, int fq) const {
        const int row0 = u.pm * BM + wr * 64 + fr, col0 = u.pn * BM + wc * 32 + 8 * fq;
        f32x4 bv[2][2];
#pragma unroll
        for (int bj = 0; bj < 2; ++bj)
#pragma unroll
            for (int n = 0; n < 2; ++n) bv[bj][n] = *(const f32x4*)(bias + col0 + bj * HALF + 4 * n);
#pragma unroll
        for (int ai = 0; ai < 2; ++ai)
#pragma unroll
            for (int m = 0; m < 4; ++m) { const size_t row = (size_t)(row0 + ai * HALF + m * 16);
#pragma unroll
                for (int bj = 0; bj < 2; ++bj) { const int c = col0 + bj * HALF;
                    const u32x4 yv = *(const u32x4*)(yg + row * ldy + c);
                    const f32x4 v0 = acc[ai][bj][m][0] + bv[bj][0], v1 = acc[ai][bj][m][1] + bv[bj][1];
                    float o[8];
                    o[0] = bflo(yv.x) * sigmoidf_fast(v0[0]); o[1] = bfhi(yv.x) * sigmoidf_fast(v0[1]); o[2] = bflo(yv.y) * sigmoidf_fast(v0[2]); o[3] = bfhi(yv.y) * sigmoidf_fast(v0[3]);
                    o[4] = bflo(yv.z) * sigmoidf_fast(v1[0]); o[5] = bfhi(yv.z) * sigmoidf_fast(v1[1]); o[6] = bflo(yv.w) * sigmoidf_fast(v1[2]); o[7] = bfhi(yv.w) * sigmoidf_fast(v1[3]);
                    typedef unsigned u32x2v __attribute__((ext_vector_type(2))); const float os = oscale;
                    u32x2v w; w.x = pk4_fp8(o[0] * os, o[1] * os, o[2] * os, o[3] * os); w.y = pk4_fp8(o[4] * os, o[5] * os, o[6] * os, o[7] * os);
                    *(u32x2v*)(O + row * ldo + c) = w; } }
    }
};
template <bool RES_BF16, bool OUT_BF16 = false> struct EpiRes {
    static constexpr bool PERM = false, AFTER_DRAIN = false;
    const void* res; float* out; int ldc; float alpha; float ascale;
    __device__ __forceinline__ void operator()(const f32x4 (&acc)[2][2][4][2], const Unit& u, int wr, int wc, int fr, int fq) const {
        typedef unsigned u32x2v __attribute__((ext_vector_type(2)));
        const int row0 = u.pm * BM + wr * 64 + fr, col0 = u.pn * BM + wc * 32 + 4 * fq;
#pragma unroll
        for (int ai = 0; ai < 2; ++ai)
#pragma unroll
            for (int m = 0; m < 4; ++m) { const size_t off = (size_t)(row0 + ai * HALF + m * 16) * ldc + col0;
#pragma unroll
                for (int bj = 0; bj < 2; ++bj)
#pragma unroll
                    for (int n = 0; n < 2; ++n) { const size_t o2 = off + bj * HALF + n * 16; f32x4 r;
                        if constexpr (RES_BF16) { const u32x2v w = *(const u32x2v*)((const bf16_t*)res + o2); r = (f32x4){bflo(w.x), bfhi(w.x), bflo(w.y), bfhi(w.y)}; }
                        else r = *(const f32x4*)((const float*)res + o2);
                        const f32x4 o = r * alpha + acc[ai][bj][m][n] * ascale;
                        if constexpr (OUT_BF16) { u32x2v w; w.x = cvt_pk_bf16(o[0], o[1]); w.y = cvt_pk_bf16(o[2], o[3]); *(u32x2v*)((bf16_t*)out + o2) = w; }
                        else *(f32x4*)(out + o2) = o; } }
    }
};
struct EpiDownLN {
    static constexpr bool PERM = false, AFTER_DRAIN = false;
    const bf16_t* r1; bf16_t* out; const f32x2* rstat; const float* gam; const float* bet; int ldc; float alpha, ascale;
    __device__ __forceinline__ void operator()(const f32x4 (&acc)[2][2][4][2], const Unit& u, int wr, int wc, int fr, int fq) const {
        typedef unsigned u32x2v __attribute__((ext_vector_type(2)));
        const int row0 = u.pm * BM + wr * 64 + fr, col0 = u.pn * BM + wc * 32 + 4 * fq;
        f32x4 gv[2][2], bv[2][2];
#pragma unroll
        for (int bj = 0; bj < 2; ++bj)
#pragma unroll
            for (int n = 0; n < 2; ++n) { gv[bj][n] = *(const f32x4*)(gam + col0 + bj * HALF + n * 16) * alpha; bv[bj][n] = *(const f32x4*)(bet + col0 + bj * HALF + n * 16) * alpha; }
#pragma unroll
        for (int ai = 0; ai < 2; ++ai)
#pragma unroll
            for (int m = 0; m < 4; ++m) { const int row = row0 + ai * HALF + m * 16; const f32x2 st = rstat[row]; const size_t off = (size_t)row * ldc + col0;
#pragma unroll
                for (int bj = 0; bj < 2; ++bj)
#pragma unroll
                    for (int n = 0; n < 2; ++n) { const size_t o2 = off + bj * HALF + n * 16; const u32x2v w0 = *(const u32x2v*)(r1 + o2);
                        const f32x4 r = {bflo(w0.x), bfhi(w0.x), bflo(w0.y), bfhi(w0.y)};
                        const f32x4 o = (r - st.x) * st.y * gv[bj][n] + bv[bj][n] + acc[ai][bj][m][n] * ascale;
                        u32x2v w; w.x = cvt_pk_bf16(o[0], o[1]); w.y = cvt_pk_bf16(o[2], o[3]); *(u32x2v*)(out + o2) = w; } }
    }
};
struct EpiFfn {
    static constexpr bool PERM = true, AFTER_DRAIN = false;
    unsigned char* act; float* pend_up; float* pend_gate; float* halo_up; const float* cw; const float* cb; int ldc; float ascale, oscale;
    __device__ __forceinline__ void operator()(const f32x4 (&acc)[2][2][4][2], const Unit& u, int wr, int wc, int fr, int fq) const {
        const int f0 = u.pn * HALF + wc * 32 + 8 * fq;
        float c0[8], c1[8], c2[8], cbv[8];
        { const f32x4 a0 = *(const f32x4*)(cw + f0), a1 = *(const f32x4*)(cw + f0 + 4), b0 = *(const f32x4*)(cw + ldc + f0), b1 = *(const f32x4*)(cw + ldc + f0 + 4);
          const f32x4 d0 = *(const f32x4*)(cw + 2 * ldc + f0), d1 = *(const f32x4*)(cw + 2 * ldc + f0 + 4), e0 = *(const f32x4*)(cb + f0), e1 = *(const f32x4*)(cb + f0 + 4);
#pragma unroll
          for (int j = 0; j < 4; ++j) { c0[j] = a0[j] * ascale; c0[4 + j] = a1[j] * ascale; c1[j] = b0[j] * ascale; c1[4 + j] = b1[j] * ascale; c2[j] = d0[j] * ascale; c2[4 + j] = d1[j] * ascale; cbv[j] = e0[j]; cbv[4 + j] = e1[j]; } }
        const float gs = ascale * oscale;
#pragma unroll
        for (int ai = 0; ai < 2; ++ai) {
            const int rb = u.pm * 4 + ai * 2 + wr;
#pragma unroll
            for (int m = 0; m < 4; ++m) {
                const size_t row = (size_t)(rb * 64 + m * 16 + fr);
                float a[8];
#pragma unroll
                for (int n = 0; n < 2; ++n)
#pragma unroll
                    for (int j = 0; j < 4; ++j) { const int e = 4 * n + j;
                        const float x0 = acc[ai][0][m][n][j];
                        float h1 = dpp_ror1(x0), h2 = dpp_ror2(x0);
                        if (m > 0) { const float xm = acc[ai][0][m - 1][n][j]; const float q1 = dpp_ror1(xm), q2 = dpp_ror2(xm); h1 = fr >= 1 ? h1 : q1; h2 = fr >= 2 ? h2 : q2; }
                        a[e] = cbv[e] + c0[e] * h2 + c1[e] * h1 + c2[e] * x0; }
                const f32x2 g0 = gelu_pk((f32x2){a[0], a[1]}), g1 = gelu_pk((f32x2){a[2], a[3]}), g2 = gelu_pk((f32x2){a[4], a[5]}), g3 = gelu_pk((f32x2){a[6], a[7]});
                const f32x4 gr0 = acc[ai][1][m][0], gr1 = acc[ai][1][m][1];
                const f32x2 o0 = g0 * (f32x2){gr0[0], gr0[1]} * gs, o1 = g1 * (f32x2){gr0[2], gr0[3]} * gs, o2 = g2 * (f32x2){gr1[0], gr1[1]} * gs, o3 = g3 * (f32x2){gr1[2], gr1[3]} * gs;
                typedef unsigned u32x2v __attribute__((ext_vector_type(2)));
                u32x2v w; w.x = pk4_fp8(o0.x, o0.y, o1.x, o1.y); w.y = pk4_fp8(o2.x, o2.y, o3.x, o3.y);
                if (m == 0) {
                    if (fr >= 2) *(u32x2v*)(act + row * ldc + f0) = w;
                    else { float* pu = pend_up + (size_t)(rb * 2 + fr) * ldc + f0; float* pg = pend_gate + (size_t)(rb * 2 + fr) * ldc + f0;
                        *(f32x4*)pu = acc[ai][0][m][0] * ascale; *(f32x4*)(pu + 4) = acc[ai][0][m][1] * ascale; *(f32x4*)pg = gr0 * ascale; *(f32x4*)(pg + 4) = gr1 * ascale; }
                } else {
                    *(u32x2v*)(act + row * ldc + f0) = w;
                    if (m == 3 && fr >= 14) { float* ph = halo_up + (size_t)(rb * 2 + (fr - 14)) * ldc + f0; *(f32x4*)ph = acc[ai][0][m][0] * ascale; *(f32x4*)(ph + 4) = acc[ai][0][m][1] * ascale; }
                }
            }
        }
    }
};
template <class Epi, class Sched, bool ALIGN_EPI = false, bool SP2 = false, bool F8 = false, bool F6 = false>
__device__ __forceinline__ void gemm_phase(PG8_LAS unsigned char* lds, const Gemm g, const Sched& S, const Epi& E) {
    const int tid = threadIdx.x, wid = __builtin_amdgcn_readfirstlane(tid >> 6), lane = tid & 63, wr = wid >> 2, wc = wid & 3, fr = lane & 15, fq = lane >> 4;
    const int K = g.K, nt = K / BK;
    unsigned voffA[2], voffB[2];
#pragma unroll
    for (int i = 0; i < 2; ++i) { int R, C; stage_rc(tid * 16 + i * 8192, R, C); const int Rb = Epi::PERM ? ((R & ~31) + perm32(R & 31)) : R;
        voffA[i] = (unsigned)(R * K + C) * 2u; voffB[i] = (unsigned)(Rb * K + C) * 2u; }
    const size_t kstep = (size_t)(BK * 2);
    const size_t hstep = (size_t)HALF * K * 2;
    const size_t tstep = 2 * hstep;
    const unsigned ldsw = (unsigned)wid * 1024u;
    const int aoff = lds_byte(wr * 64 + fr, fq * 8), boff = lds_byte(wc * 32 + fr, fq * 8);
#define PG8_SA(b, h) (((b) * 2 + (h)) * HTB)
#define PG8_SB(b, h) ((4 + (b) * 2 + (h)) * HTB)
#define PG8_STAGE(bufoff, gbase, voff) do { _Pragma("unroll") for (int _i = 0; _i < 2; ++_i) \
        __builtin_amdgcn_global_load_lds((const unsigned*)((const char*)(gbase) + (voff)[_i]), (PG8_LAS unsigned*)(lds + (bufoff) + ldsw + _i * 8192), 16, 0, 0); } while (0)
#define PG8_LDA(dst, b, h) do { _Pragma("unroll") for (int m = 0; m < 4; ++m) _Pragma("unroll") for (int k = 0; k < 2; ++k) dst[m][k] = *(const PG8_LAS bf16x8*)(lds + PG8_SA(b, h) + aoff + m * 2048 + k * 1024); } while (0)
#define PG8_LDB(dst, b, h) do { _Pragma("unroll") for (int n = 0; n < 2; ++n) _Pragma("unroll") for (int k = 0; k < 2; ++k) dst[n][k] = *(const PG8_LAS bf16x8*)(lds + PG8_SB(b, h) + boff + n * 2048 + k * 1024); } while (0)
#define PG8_CAT(lo, hi) __builtin_bit_cast(v8i32, __builtin_shufflevector(lo, hi, 0, 1, 2, 3, 4, 5, 6, 7, 8, 9, 10, 11, 12, 13, 14, 15))
#define PG8_MMA(ai, bj, At, Bt) do { __builtin_amdgcn_s_setprio(1); _Pragma("unroll") for (int m = 0; m < 4; ++m) _Pragma("unroll") for (int n = 0; n < 2; ++n) { \
        if constexpr (F8 && F6) { const v8i32 cb_ = PG8_CAT(Bt[n][0], Bt[n][1]), ca_ = PG8_CAT(At[m][0], At[m][1]); \
            asm volatile("s_nop 3\n\tv_mfma_scale_f32_16x16x128_f8f6f4 %0, %1, %2, %0, %3, %4 op_sel_hi:[0,0,0] cbsz:2 blgp:2" : "+v"(acc[ai][bj][m][n]) \
                         : "v"(__builtin_shufflevector(cb_, cb_, 0, 1, 2, 3, 4, 5)), "v"(__builtin_shufflevector(ca_, ca_, 0, 1, 2, 3, 4, 5)), "v"(cb_[6]), "v"(ca_[6])); } \
        else if constexpr (F8) asm volatile("v_mfma_scale_f32_16x16x128_f8f6f4 %0, %1, %2, %0, %3, %3 op_sel_hi:[0,0,0]" : "+v"(acc[ai][bj][m][n]) : "v"(PG8_CAT(Bt[n][0], Bt[n][1])), "v"(PG8_CAT(At[m][0], At[m][1])), "v"(f8scale)); \
        else { _Pragma("unroll") for (int k = 0; k < 2; ++k) acc[ai][bj][m][n] = __builtin_amdgcn_mfma_f32_16x16x32_bf16(Bt[n][k], At[m][k], acc[ai][bj][m][n], 0, 0, 0); } } __builtin_amdgcn_s_setprio(0); } while (0)
#define PG8_WAIT_V(n) asm volatile("s_waitcnt vmcnt(" #n ")" ::: "memory")
#define PG8_WAIT_L(n) asm volatile("s_waitcnt lgkmcnt(" #n ")" ::: "memory")
#define PG8_BAR __builtin_amdgcn_s_barrier()
#define PG8_SCHED __builtin_amdgcn_sched_barrier(0)
    Unit cur, nxt; int ui = 0;
    if (!S.next(0, cur)) return;
    const int f8scale = 0x7F7F7F7F;
    f32x4 acc[2][2][4][2];
#pragma unroll
    for (int a = 0; a < 2; ++a)
#pragma unroll
        for (int b = 0; b < 2; ++b)
#pragma unroll
            for (int m = 0; m < 4; ++m)
#pragma unroll
                for (int n = 0; n < 2; ++n) acc[a][b][m][n] = (f32x4){0.f, 0.f, 0.f, 0.f};
    bf16x8 At[4][2], B0[2][2], B1[2][2];
    const char* cA = (const char*)g.A + (size_t)cur.pm * tstep; const char* cB = (const char*)g.Bt + (size_t)cur.pn * tstep;
    S.a_ready(cur);
    if constexpr (SP2) {
        PG8_STAGE(PG8_SB(0, 0), cB, voffB); PG8_STAGE(PG8_SB(0, 1), cB + hstep, voffB); PG8_STAGE(PG8_SA(0, 0), cA, voffA); PG8_STAGE(PG8_SA(0, 1), cA + hstep, voffA);
        if (wr == 1) PG8_BAR;
        PG8_WAIT_V(2); PG8_BAR;
        PG8_STAGE(PG8_SB(1, 0), cB + kstep, voffB); PG8_STAGE(PG8_SA(1, 0), cA + kstep, voffA); PG8_STAGE(PG8_SB(1, 1), cB + hstep + kstep, voffB);
        PG8_WAIT_V(6); PG8_BAR;
    } else {
        PG8_STAGE(PG8_SB(0, 0), cB, voffB); PG8_STAGE(PG8_SA(0, 0), cA, voffA); PG8_STAGE(PG8_SB(0, 1), cB + hstep, voffB); PG8_STAGE(PG8_SA(0, 1), cA + hstep, voffA);
        if (wr == 1) PG8_BAR;
        PG8_WAIT_V(4); PG8_BAR;
        PG8_STAGE(PG8_SB(1, 0), cB + kstep, voffB); PG8_STAGE(PG8_SA(1, 0), cA + kstep, voffA); PG8_STAGE(PG8_SB(1, 1), cB + hstep + kstep, voffB);
        PG8_WAIT_V(6); PG8_BAR;
    }
    for (;;) {
        const bool has_next = S.next(ui + 1, nxt);
        const char* nA = has_next ? (const char*)g.A + (size_t)nxt.pm * tstep : cA; const char* nB = has_next ? (const char*)g.Bt + (size_t)nxt.pn * tstep : cB;
        for (int t = 0; t < nt; t += 2) {
            const bool last = (t == nt - 2);
            const char* a1 = cA + (size_t)(t + 1) * kstep;
            const char* a2 = last ? nA : cA + (size_t)(t + 2) * kstep; const char* b2 = last ? nB : cB + (size_t)(t + 2) * kstep;
            const char* a3 = a2 + kstep; const char* b3 = b2 + kstep;
            if (last && has_next) S.a_ready(nxt);
            if constexpr (SP2) {
            PG8_LDB(B0, 0, 0); PG8_LDB(B1, 0, 1); PG8_SCHED; PG8_LDA(At, 0, 0); PG8_STAGE(PG8_SA(1, 1), a1 + hstep, voffA);
            PG8_WAIT_V(8); PG8_WAIT_L(0); PG8_BAR; PG8_MMA(0, 0, At, B0); PG8_MMA(0, 1, At, B1); PG8_BAR; PG8_SCHED;
            PG8_LDA(At, 0, 1); PG8_STAGE(PG8_SB(0, 0), b2, voffB); PG8_STAGE(PG8_SB(0, 1), b2 + hstep, voffB); PG8_STAGE(PG8_SA(0, 0), a2, voffA);
            PG8_WAIT_V(8); PG8_WAIT_L(0); PG8_BAR; PG8_MMA(1, 0, At, B0); PG8_MMA(1, 1, At, B1); PG8_BAR; PG8_SCHED;
            PG8_LDB(B0, 1, 0); PG8_LDB(B1, 1, 1); PG8_SCHED; PG8_LDA(At, 1, 0); PG8_STAGE(PG8_SA(0, 1), a2 + hstep, voffA);
            PG8_WAIT_V(8); PG8_WAIT_L(0); PG8_BAR; PG8_MMA(0, 0, At, B0); PG8_MMA(0, 1, At, B1); PG8_BAR; PG8_SCHED;
            PG8_LDA(At, 1, 1); PG8_STAGE(PG8_SB(1, 0), b3, voffB); PG8_STAGE(PG8_SB(1, 1), b3 + hstep, voffB); PG8_STAGE(PG8_SA(1, 0), a3, voffA);
            PG8_WAIT_V(8); PG8_WAIT_L(0); PG8_BAR; PG8_MMA(1, 0, At, B0); PG8_MMA(1, 1, At, B1); PG8_BAR; PG8_SCHED;
            } else {
            PG8_LDB(B0, 0, 0); PG8_SCHED; PG8_LDA(At, 0, 0); PG8_STAGE(PG8_SA(1, 1), a1 + hstep, voffA);
            PG8_WAIT_L(8); PG8_BAR; PG8_WAIT_L(0); PG8_MMA(0, 0, At, B0); PG8_BAR; PG8_SCHED;
            PG8_LDB(B1, 0, 1); PG8_STAGE(PG8_SB(0, 0), b2, voffB);
            PG8_BAR; PG8_WAIT_L(0); PG8_MMA(0, 1, At, B1); PG8_BAR;
            PG8_LDA(At, 0, 1); PG8_STAGE(PG8_SA(0, 0), a2, voffA);
            PG8_BAR; PG8_WAIT_L(0); PG8_MMA(1, 0, At, B0); PG8_BAR; PG8_SCHED;
            PG8_STAGE(PG8_SB(0, 1), b2 + hstep, voffB);
            PG8_WAIT_V(6); PG8_BAR; PG8_MMA(1, 1, At, B1); PG8_BAR;
            PG8_LDB(B0, 1, 0); PG8_SCHED; PG8_LDA(At, 1, 0); PG8_STAGE(PG8_SA(0, 1), a2 + hstep, voffA);
            PG8_WAIT_L(8); PG8_BAR; PG8_WAIT_L(0); PG8_MMA(0, 0, At, B0); PG8_BAR; PG8_SCHED;
            PG8_LDB(B1, 1, 1); PG8_STAGE(PG8_SB(1, 0), b3, voffB);
            PG8_BAR; PG8_WAIT_L(0); PG8_MMA(0, 1, At, B1); PG8_BAR;
            PG8_LDA(At, 1, 1); PG8_STAGE(PG8_SA(1, 0), a3, voffA);
            PG8_BAR; PG8_WAIT_L(0); PG8_MMA(1, 0, At, B0); PG8_BAR; PG8_SCHED;
            PG8_STAGE(PG8_SB(1, 1), b3 + hstep, voffB);
            PG8_WAIT_V(6); PG8_BAR; PG8_MMA(1, 1, At, B1); PG8_BAR;
            }
        }
        if constexpr (ALIGN_EPI) { if (wr == 0) PG8_BAR; }
        if constexpr (F8) asm volatile("s_nop 15\n\ts_nop 15" ::: "memory");
        if constexpr (!Epi::AFTER_DRAIN) { E(acc, cur, wr, wc, fr, fq); S.done(cur); }
        if (!has_next) break;
#pragma unroll
        for (int a = 0; a < 2; ++a)
#pragma unroll
            for (int b = 0; b < 2; ++b)
#pragma unroll
                for (int m = 0; m < 4; ++m)
#pragma unroll
                    for (int n = 0; n < 2; ++n) acc[a][b][m][n] = (f32x4){0.f, 0.f, 0.f, 0.f};
        cur = nxt; cA = nA; cB = nB; ++ui;
        if constexpr (ALIGN_EPI) { if (wr == 1) PG8_BAR; }
    }
    PG8_WAIT_V(0);
    if constexpr (!ALIGN_EPI) { if (wr == 0) PG8_BAR; }
    PG8_BAR;
    if constexpr (Epi::AFTER_DRAIN) { E.fused(acc, cur, wr, wc, fr, fq, lds, wid, lane); S.done(cur); }
#undef PG8_SA
#undef PG8_SB
#undef PG8_STAGE
#undef PG8_LDA
#undef PG8_LDB
#undef PG8_MMA
#undef PG8_CAT
#undef PG8_WAIT_V
#undef PG8_WAIT_L
#undef PG8_BAR
#undef PG8_SCHED
}
}

constexpr int NWAVES = 8;
constexpr int NB = 8, SEQ = 2048, DM = 2048, M = NB * SEQ;
constexpr int N_IN = 3664, NPROJ = 3840, NP8 = 2560;
constexpr int U_OFF = 0, Q_OFF = 1024, K_OFF = 2048, V_OFF = 2304, QI_OFF = 2560, KI_OFF = 3584, WI_OFF = 3648;
constexpr int SSMW = 1024, NG = 64, GCH = 16, NST = 64;
constexpr int NH = 8, HD = 128, NKV = 2, NIH = 16, IDIM = 64, TOPK = 256;
constexpr int DFF = 5632, NUG = 2 * DFF;
constexpr float LN_EPS = 1e-5f;
constexpr float DN_ALPHA = 1.189207115002721f;
constexpr float IDX_W_SCALE = 0.03125f;
constexpr float ATT_SCALE = 0.08838834764831845f;
constexpr float SC_H1 = 32.f, SC_WUG = 2048.f, SC_ACT = 8.f, SC_WDN = 4096.f, SC_MIX = 8.f, SC_WOUT = 4096.f, SC_X = 32.f, SC_WIN = 2048.f;

constexpr size_t MiB = 1u << 20;
constexpr size_t WS_CTL = 0, CTL_ZERO_BYTES = 1 * MiB;
constexpr size_t WS_WIN = 2 * MiB, WS_WGLU = 17 * MiB, WS_WOUT = 19 * MiB, WS_WUG = 27 * MiB, WS_WDOWN = 71 * MiB;
constexpr size_t WS_TABA = 93 * MiB, WS_TABB = 93 * MiB + 65536;
constexpr size_t WS_TABINV = 94 * MiB, WS_TABW = 95 * MiB, WS_CA = 96 * MiB, WS_BCAT = 96 * MiB + 524288, WS_TABA32 = 96 * MiB + 786432;
constexpr size_t WS_KIPACK = 97 * MiB;
constexpr size_t WS_MASK = 100 * MiB;
constexpr size_t WS_XB = 104 * MiB;
constexpr size_t WS_MIX = 168 * MiB;
constexpr size_t WS_PROJ = 232 * MiB;
constexpr size_t WS_YG = 352 * MiB;
constexpr size_t WS_ACT = 232 * MiB;
constexpr size_t WS_PEND_UP = 408 * MiB, WS_PEND_G = 420 * MiB, WS_HALO = 432 * MiB, WS_WIN8 = 444 * MiB, WS_RSTAT = 450 * MiB, WS_END = 451 * MiB;
static_assert(WS_WIN + (size_t)NPROJ * DM * 2 <= WS_WGLU && WS_WUG + (size_t)NUG * DM * 2 <= WS_WDOWN && WS_WDOWN + (size_t)DM * DFF * 2 <= WS_TABA, "ws map");
static_assert(WS_PROJ + (size_t)M * NPROJ * 2 <= WS_YG && WS_YG + (size_t)M * SSMW * 2 <= WS_PEND_UP && WS_ACT + (size_t)M * DFF * 2 <= WS_PEND_UP && (size_t)512 * DFF * 4 <= 12 * MiB && WS_WIN8 + (size_t)NP8 * DM <= WS_RSTAT && WS_RSTAT + (size_t)M * 8 <= WS_END, "ws map 2");
constexpr int CW_BAR = 4096;

constexpr int RING_OFF = 0, RING_BYTES = 131072;
constexpr int LDS_BYTES = 163840;
constexpr int LDSCTL_OFF = LDS_BYTES - 1024, MISC_OFF = LDSCTL_OFF + 320;

#define GAS __attribute__((address_space(1)))
#define LAS __attribute__((address_space(3)))
typedef unsigned short bf16;
typedef unsigned v4u __attribute__((ext_vector_type(4)));
typedef unsigned v2u __attribute__((ext_vector_type(2)));
typedef float f32x4 __attribute__((ext_vector_type(4)));
typedef float fl4 __attribute__((ext_vector_type(4)));
#define LDS_WAIT() asm volatile("s_waitcnt lgkmcnt(0)" ::: "memory")
#define VM_WAIT() asm volatile("s_waitcnt vmcnt(0)" ::: "memory")
__device__ __forceinline__ unsigned f2bf(float f) { unsigned u = __builtin_bit_cast(unsigned, f); return (u + 0x7fffu + ((u >> 16) & 1u)) >> 16; }
__device__ __forceinline__ unsigned pk2(float lo, float hi) { return f2bf(lo) | (f2bf(hi) << 16); }
__device__ __forceinline__ float bflo(unsigned w) { return __uint_as_float(w << 16); }
__device__ __forceinline__ float bfhi(unsigned w) { return __uint_as_float(w & 0xffff0000u); }
__device__ __forceinline__ float bf2f(bf16 b) { return __uint_as_float(((unsigned)b) << 16); }
__device__ __forceinline__ unsigned pk4_fp8(float a, float b, float c, float d) {
    int w = 0; w = __builtin_amdgcn_cvt_pk_fp8_f32(__builtin_amdgcn_fmed3f(a, -448.f, 448.f), __builtin_amdgcn_fmed3f(b, -448.f, 448.f), w, false);
    w = __builtin_amdgcn_cvt_pk_fp8_f32(__builtin_amdgcn_fmed3f(c, -448.f, 448.f), __builtin_amdgcn_fmed3f(d, -448.f, 448.f), w, true); return (unsigned)w; }
#define XB_TMO      128
#define XB_XCNT(j)  (256  + 64 * (j))
#define XB_XSUB(j)  (1280 + 64 * (j))
#define XB_XGEN(j)  (2304 + 64 * (j))
#define XB_TOP      3328
#define XB_TOPGEN   3392
#define XCD_BAR_WORDS 3456
#define XB_SPIN_CAP (1u << 18)

__device__ __forceinline__ unsigned xb_ld(unsigned* p)              { return __hip_atomic_load(p, __ATOMIC_RELAXED, __HIP_MEMORY_SCOPE_AGENT); }
__device__ __forceinline__ unsigned xb_add(unsigned* p, unsigned v) { return __hip_atomic_fetch_add(p, v, __ATOMIC_RELAXED, __HIP_MEMORY_SCOPE_AGENT); }
__device__ __forceinline__ unsigned xb_xcc_id() { return (unsigned)__builtin_amdgcn_s_getreg((3 << 11) | 20) & 0xFu; }
#define XB_SPIN(cond, bar) do { unsigned _sp = 0; while (cond) { __builtin_amdgcn_s_sleep(1); \
    if ((++_sp & 255u) == 0u) { if (xb_ld(&(bar)[XB_TMO])) break; if (_sp > XB_SPIN_CAP) { atomicAdd(&(bar)[XB_TMO], 1u); break; } } } } while (0)

struct XcdBarrier {
    unsigned* bar; unsigned x;
    volatile LAS unsigned* st;
};

__device__ __forceinline__ XcdBarrier xcd_barrier_post(unsigned* bar, volatile LAS unsigned* st) {
    XcdBarrier b; b.bar = bar; b.x = xb_xcc_id(); b.st = st;
    if (threadIdx.x == 0) (void)xb_add(&bar[XB_XCNT(b.x)], 1u);
    return b;
}
__device__ __forceinline__ void xcd_barrier_complete(unsigned* bar, unsigned x, unsigned& nloc, unsigned& nx) {
    const unsigned G = gridDim.x * gridDim.y * gridDim.z;
    unsigned sum, cnt, mine, sp = 0u;
    for (;;) {
        sum = 0u; cnt = 0u; mine = 0u;
#pragma unroll
        for (unsigned j = 0; j < 16; ++j) { const unsigned c = xb_ld(&bar[XB_XCNT(j)]); sum += c; cnt += (c > 0u) ? 1u : 0u; mine = (j == x) ? c : mine; }
        if (sum == G) break;
        __builtin_amdgcn_s_sleep(1);
        if ((++sp & 255u) == 0u) { if (xb_ld(&bar[XB_TMO])) break; if (sp > XB_SPIN_CAP) { atomicAdd(&bar[XB_TMO], 1u); break; } }
    }
    nloc = mine > 0u ? mine : 1u; nx = cnt > 0u ? cnt : 1u;
}

__device__ __forceinline__ void xcd_barrier(const XcdBarrier& b) {
    asm volatile("s_waitcnt vmcnt(0)" ::: "memory");
    __syncthreads();
    if (threadIdx.x == 0) {
        unsigned* bar = b.bar;
        __builtin_amdgcn_s_waitcnt(0);
        unsigned nloc = b.st[0], nx = b.st[1];
        if (nloc == 0u) { xcd_barrier_complete(bar, b.x, nloc, nx); b.st[0] = nloc; b.st[1] = nx; }
        const unsigned old = xb_add(&bar[XB_XSUB(b.x)], 1u);
        const unsigned gen = old / nloc;
        if (old + 1u == (gen + 1u) * nloc) {
            __builtin_amdgcn_fence(__ATOMIC_RELEASE, "agent");
            asm volatile("s_waitcnt vmcnt(0)" ::: "memory");
            const unsigned og = xb_add(&bar[XB_TOP], 1u);
            const unsigned tg = og / nx;
            if (og + 1u == (tg + 1u) * nx) xb_add(&bar[XB_TOPGEN], 1u);
            else XB_SPIN(xb_ld(&bar[XB_TOPGEN]) == tg, bar);
            __builtin_amdgcn_fence(__ATOMIC_ACQUIRE, "agent");
            xb_add(&bar[XB_XGEN(b.x)], 1u);
            asm volatile("s_waitcnt vmcnt(0)" ::: "memory");
        } else {
            XB_SPIN(xb_ld(&bar[XB_XGEN(b.x)]) == gen, bar);
            __builtin_amdgcn_fence(__ATOMIC_ACQUIRE, "agent");
            asm volatile("s_waitcnt vmcnt(0)" ::: "memory");
        }
    }
    __syncthreads();
}

struct Frame {
    LAS unsigned char* lds;
    volatile LAS unsigned* MISC;
    unsigned* ctl;
    int tid, lane, wave, vcu, G;
    const float* in[22]; float* out; unsigned char* ws;
};
enum { I_X = 0, I_WIN, I_ARE, I_AIM, I_LOGDT, I_BRE, I_BIM, I_CRE, I_CIM, I_D, I_WGLU, I_BGLU, I_WOUT, I_LN1G, I_LN1B, I_WUP, I_WGATE, I_CONVW, I_CONVB, I_WDOWN, I_LN2G, I_LN2B };

__device__ __forceinline__ float wave_sum(float v) {
#pragma unroll
    for (int o = 1; o < 64; o <<= 1) v += __shfl_xor(v, o);
    return v;
}

typedef float v16f32 __attribute__((ext_vector_type(16)));
typedef unsigned v6u32 __attribute__((ext_vector_type(6)));
__device__ __forceinline__ void mx6_store_block(unsigned char* row, int b, v16f32 x, v16f32 y, float amax) {
    unsigned E = __float_as_uint(amax) >> 23; E = E < 3u ? 3u : E;
    const unsigned sb = E - 2u; const float inv = __uint_as_float((254u - sb) << 23);
    const v6u32 r = __builtin_amdgcn_cvt_scalef32_2xpk16_fp6_f32(x * inv, y * inv, 1.0f);
    unsigned char* p = row + (b >> 2) * 128 + (b & 3) * 16;
    *(v4u*)p = (v4u){r[0], r[1], r[2], r[3]}; *(v4u*)(p + 64) = (v4u){r[4], r[5], sb, 0u};
}
#define MX6_AMAX(x, y, am) do { am = 0.f; _Pragma("unroll") for (int i_ = 0; i_ < 16; ++i_) am = __builtin_fmaxf(__builtin_fmaxf(__builtin_fabsf(x[i_]), __builtin_fabsf(y[i_])), am); } while (0)
template <int MODE>
__device__ __forceinline__ void p2_mx6_item(const float* W, int K, int N, void* WT, int item, int lane) {
    const int nblk = N / 256, kb = item / nblk, nb = item % nblk, k0 = 32 * kb;
#pragma unroll 1
    for (int sub = 0; sub < 4; ++sub) { const int nn = nb * 256 + sub * 64 + lane; const float* wp = W + (size_t)k0 * N + nn;
        v16f32 x, y;
#pragma unroll
        for (int i = 0; i < 16; ++i) { x[i] = wp[(size_t)i * N]; y[i] = wp[(size_t)(16 + i) * N]; }
        float am; MX6_AMAX(x, y, am);
        const int R = MODE == 0 ? nn : (256 * (nn >> 7) + (nn & 127) + (MODE == 2 ? 128 : 0));
        mx6_store_block((unsigned char*)WT + (size_t)R * K, kb, x, y, am); }
}
template <int MODE, bool F8OUT>
__device__ __forceinline__ void p0_tr_item(const float* W, int K, int N, int noff, int nend, void* WT, int item, int lane, float sc) {
    const int nblk = (nend - noff) / 256, kb = item / nblk, nb = item % nblk, k0 = 32 * kb, n = noff + nb * 256 + lane * 4;
    constexpr int KS = F8OUT ? 16 : 8;
    const bool inb = n < N;
#pragma unroll
    for (int kk = 0; kk < 32; kk += KS) {
        f32x4 v[KS];
#pragma unroll
        for (int i = 0; i < KS; ++i) v[i] = inb ? *(const f32x4*)(W + (size_t)(k0 + kk + i) * N + n) : (f32x4){0.f, 0.f, 0.f, 0.f};
#pragma unroll
        for (int c = 0; c < 4; ++c) { const int nn = n + c; const int R = MODE == 0 ? nn : (256 * (nn >> 7) + (nn & 127) + (MODE == 2 ? 128 : 0));
            v4u o;
            if constexpr (F8OUT) { o.x = pk4_fp8(v[0][c] * sc, v[1][c] * sc, v[2][c] * sc, v[3][c] * sc); o.y = pk4_fp8(v[4][c] * sc, v[5][c] * sc, v[6][c] * sc, v[7][c] * sc);
                o.z = pk4_fp8(v[8][c] * sc, v[9][c] * sc, v[10][c] * sc, v[11][c] * sc); o.w = pk4_fp8(v[12][c] * sc, v[13][c] * sc, v[14][c] * sc, v[15][c] * sc);
                *(v4u*)((unsigned char*)WT + (size_t)R * K + k0 + kk) = o; }
            else { o.x = pk2(v[0][c], v[1][c]); o.y = pk2(v[2][c], v[3][c]); o.z = pk2(v[4][c], v[5][c]); o.w = pk2(v[6][c], v[7][c]);
                *(v4u*)((bf16*)WT + (size_t)R * K + k0 + kk) = o; } }
    }
}
__device__ __forceinline__ void p0_prologue(Frame& F) {
    LAS float* scr = (LAS float*)(F.lds + RING_OFF + F.wave * 16384);
    const int gw = F.vcu * NWAVES + F.wave, NGW = F.G * NWAVES;
    bf16* win_t = (bf16*)(F.ws + WS_WIN); bf16* wglu_t = (bf16*)(F.ws + WS_WGLU); bf16* wout_t = (bf16*)(F.ws + WS_WOUT); bf16* wug_t = (bf16*)(F.ws + WS_WUG); bf16* wdown_t = (bf16*)(F.ws + WS_WDOWN);
    constexpr int I_IN8 = (DM / 32) * (NP8 / 256), I_IN = (DM / 32) * ((NPROJ - NP8) / 256);
    for (int it = gw; it < I_IN8 + I_IN; it += NGW) {
        int r = it;
        if (r < I_IN8) { p0_tr_item<0, true>(F.in[I_WIN], DM, N_IN, 0, NP8, F.ws + WS_WIN8, r, F.lane, SC_WIN); continue; } r -= I_IN8;
        p0_tr_item<0, false>(F.in[I_WIN], DM, N_IN, NP8, NPROJ, win_t, r, F.lane, 1.f);
    }
    { const size_t n8 = (size_t)M * DM / 8; const f32x4* xs = (const f32x4*)F.in[I_X]; v4u* xd = (v4u*)(F.ws + WS_XB);
#pragma unroll 4
      for (size_t i = (size_t)F.vcu * 512 + F.tid; i < n8; i += (size_t)F.G * 512) { const f32x4 a = xs[2 * i], b = xs[2 * i + 1];
          v4u o; o.x = pk2(a[0], a[1]); o.y = pk2(a[2], a[3]); o.z = pk2(b[0], b[1]); o.w = pk2(b[2], b[3]); xd[i] = o;
          v2u o8; o8.x = pk4_fp8(a[0] * SC_X, a[1] * SC_X, a[2] * SC_X, a[3] * SC_X); o8.y = pk4_fp8(b[0] * SC_X, b[1] * SC_X, b[2] * SC_X, b[3] * SC_X); ((v2u*)(F.ws + WS_MIX + 32 * MiB))[i] = o8; } }
    { const int gi = F.vcu * 512 + F.tid;
      if (gi < NG * NST) { const int g = gi >> 6;
          const double dt = exp((double)F.in[I_LOGDT][g]); const double are = (double)F.in[I_ARE][gi], aim = (double)F.in[I_AIM][gi];
          const double mag = exp(dt * are), ang = dt * aim; const double abr = mag * cos(ang), abi = mag * sin(ang);
          const double nr = abr - 1.0, ni = abi, den = are * are + aim * aim;
          const double fre = (nr * are + ni * aim) / den, fim = (ni * are - nr * aim) / den;
          float2* ta = (float2*)(F.ws + WS_TABA); float2* tb = (float2*)(F.ws + WS_TABB);
          ta[gi] = make_float2((float)abr, (float)abi);
#pragma unroll
          for (int h = 0; h < GCH; ++h) { const double br = (double)F.in[I_BRE][gi * GCH + h], bi = (double)F.in[I_BIM][gi * GCH + h];
              const float bbr = (float)(fre * br - fim * bi), bbi = (float)(fre * bi + fim * br);
              tb[gi * GCH + h] = make_float2(bbr, bbi);
              const int p = gi & 63; bf16* bcat = (bf16*)(F.ws + WS_BCAT);
              bcat[(size_t)(g * 128 + p) * 16 + h] = (bf16)f2bf(bbr); bcat[(size_t)(g * 128 + 64 + p) * 16 + h] = (bf16)f2bf(bbi); }
          { const double m32 = exp(32.0 * dt * are), a32 = 32.0 * dt * aim; ((float2*)(F.ws + WS_TABA32))[gi] = make_float2((float)(m32 * cos(a32)), (float)(m32 * sin(a32))); } } }
    for (int e = F.vcu * 512 + F.tid; e < NG * 2 * 8 * 64; e += F.G * 512) {
        const int ln = e & 63, rp = (e >> 6) & 7, pt = (e >> 9) & 1, g = e >> 10, hw = ln >> 5, jl = ln & 31;
        const double dt = exp((double)F.in[I_LOGDT][g]); float vi[4], vw[4];
#pragma unroll
        for (int k = 0; k < 2; ++k) { const int r = 2 * rp + k, cr = (r & 3) + 8 * (r >> 2) + 4 * hw;
            { const int p = pt * 32 + jl; const double are = (double)F.in[I_ARE][g * 64 + p], aim = (double)F.in[I_AIM][g * 64 + p], kk = -(double)cr; const double mg = exp(kk * dt * are), an = kk * dt * aim;
              vi[k] = (float)(mg * cos(an)); vi[2 + k] = (float)(mg * sin(an)); }
            { const int p = pt * 32 + cr; const double are = (double)F.in[I_ARE][g * 64 + p], aim = (double)F.in[I_AIM][g * 64 + p], kk = (double)jl; const double mg = exp(kk * dt * are), an = kk * dt * aim;
              vw[k] = (float)(mg * cos(an)); vw[2 + k] = (float)(mg * sin(an)); } }
        ((fl4*)(F.ws + WS_TABINV))[e] = (fl4){vi[0], vi[1], vi[2], vi[3]}; ((fl4*)(F.ws + WS_TABW))[e] = (fl4){vw[0], vw[1], vw[2], vw[3]};
    }
    for (int e = F.vcu * 512 + F.tid; e < NG * 4 * 2 * 64; e += F.G * 512) {
        const int ln = e & 63, s = (e >> 6) & 1, q = (e >> 7) & 3, g = e >> 9, ch = ln & 31, hw = ln >> 5; unsigned hv[8];
#pragma unroll
        for (int ee = 0; ee < 8; ++ee) { const int p = (q & 1) * 32 + 8 * (2 * s + (ee >> 2)) + 4 * hw + (ee & 3); float v = 0.f;
            if (ch < 16) v = (q < 2) ? F.in[I_CRE][(size_t)(g * 16 + ch) * 64 + p] : -F.in[I_CIM][(size_t)(g * 16 + ch) * 64 + p];
            hv[ee] = f2bf(v); }
        v4u w; w.x = hv[0] | (hv[1] << 16); w.y = hv[2] | (hv[3] << 16); w.z = hv[4] | (hv[5] << 16); w.w = hv[6] | (hv[7] << 16);
        ((v4u*)(F.ws + WS_CA))[e] = w; }
}

constexpr int P2W_GLU = (SSMW / 32) * (SSMW / 256), P2W_OUT = (DM / 32) * (DM / 256), P2W_UP = (DM / 32) * (DFF / 256), P2W_DOWN = (DFF / 32) * (DM / 256);
constexpr int P2W_ITEMS = P2W_GLU + P2W_OUT + 2 * P2W_UP + P2W_DOWN;
__device__ __forceinline__ void p2_weight_item(Frame& F, int it) {
    int r = it;
    if (r < P2W_GLU) { p0_tr_item<0, false>(F.in[I_WGLU], SSMW, SSMW, 0, SSMW, F.ws + WS_WGLU, r, F.lane, 1.f); return; } r -= P2W_GLU;
    if (r < P2W_OUT) { p0_tr_item<0, true>(F.in[I_WOUT], DM, DM, 0, DM, F.ws + WS_WOUT, r, F.lane, SC_WOUT); return; } r -= P2W_OUT;
    if (r < P2W_UP) { p2_mx6_item<1>(F.in[I_WUP], DM, DFF, F.ws + WS_WUG, r, F.lane); return; } r -= P2W_UP;
    if (r < P2W_UP) { p2_mx6_item<2>(F.in[I_WGATE], DM, DFF, F.ws + WS_WUG, r, F.lane); return; } r -= P2W_UP;
    p0_tr_item<0, true>(F.in[I_WDOWN], DFF, DM, 0, DM, F.ws + WS_WDOWN, r, F.lane, SC_WDN);
}

typedef short bf16x8_t __attribute__((ext_vector_type(8)));
typedef float f32x16_t __attribute__((ext_vector_type(16)));
typedef float fl2 __attribute__((ext_vector_type(2)));
constexpr int IDX_NLDS = 30;
__device__ __forceinline__ void idx_mfma_pair(Frame& F, int b, int ti, unsigned* maskout, const LAS bf16* kl) {
    const int lane = F.lane, j = lane & 31, hw = lane >> 5, t0 = 2 * ti, th = t0 + hw;
    const bf16* proj = (const bf16*)(F.ws + WS_PROJ);
    const bf16* pb = proj + (size_t)(b * SEQ) * NPROJ;
    bf16x8_t qa[4];
    { const int q = (j >> 2) & 1, head = (j >> 3) * 4 + (j & 3); const bf16* qp = pb + (size_t)(t0 + q) * NPROJ + QI_OFF + head * IDIM + 8 * hw;
#pragma unroll
      for (int s = 0; s < 4; ++s) qa[s] = *(const bf16x8_t*)(qp + 16 * s); }
    float w[16];
    { const bf16* wp = pb + (size_t)th * NPROJ + WI_OFF; const v4u a = *(const v4u*)wp, c = *(const v4u*)(wp + 8);
      w[0] = bflo(a.x); w[1] = bfhi(a.x); w[2] = bflo(a.y); w[3] = bfhi(a.y); w[4] = bflo(a.z); w[5] = bfhi(a.z); w[6] = bflo(a.w); w[7] = bfhi(a.w);
      w[8] = bflo(c.x); w[9] = bfhi(c.x); w[10] = bflo(c.y); w[11] = bfhi(c.y); w[12] = bflo(c.z); w[13] = bfhi(c.z); w[14] = bflo(c.w); w[15] = bfhi(c.w);
#pragma unroll
      for (int r = 0; r < 16; ++r) w[r] *= IDX_W_SCALE; }
    const int kbnd = t0 >> 5;
    const float pen = (j > th - 32 * kbnd) ? -__builtin_inff() : 0.f;
    const int nkt = (t0 + 1) / 32 + 1;
    const float NEG = -__builtin_inff();
    float sc[64];
    const bf16* kp = (const bf16*)(F.ws + WS_KIPACK) + (size_t)(b * 64) * 4 * 64 * 8 + (size_t)lane * 8;
    typedef float f32x2_t __attribute__((ext_vector_type(2)));
    f32x2_t w2[8];
#pragma unroll
    for (int r = 0; r < 8; ++r) w2[r] = (f32x2_t){0.5f * w[2 * r], 0.5f * w[2 * r + 1]};
    bf16x8_t kA[2][4], kB[2][4];
#pragma unroll
    for (int t2 = 0; t2 < 2; ++t2)
#pragma unroll
        for (int s = 0; s < 4; ++s) kA[t2][s] = *(const LAS bf16x8_t*)(kl + (t2 * 4 + s) * 512);
    unsigned kl2a = (unsigned)(size_t)kl + 16 * 4096; asm volatile("" : "+v"(kl2a));
    const LAS bf16* kl2 = (const LAS bf16*)(size_t)kl2a;
#pragma unroll
    for (int kp2 = 0; kp2 < 32; ++kp2) {
        if (2 * kp2 < nkt) {
            if (2 * (kp2 + 1) < nkt) {
#pragma unroll
                for (int t2 = 0; t2 < 2; ++t2)
#pragma unroll
                    for (int s = 0; s < 4; ++s) { const bf16x8_t v = (2 * kp2 + 2 < 16) ? *(const LAS bf16x8_t*)(kl + ((2 * kp2 + 2 + t2) * 4 + s) * 512) : (2 * kp2 + 2 < IDX_NLDS) ? *(const LAS bf16x8_t*)(kl2 + ((2 * kp2 + 2 - 16 + t2) * 4 + s) * 512) : *(const bf16x8_t*)(kp + (size_t)((2 * kp2 + 2 + t2) * 4 + s) * 512);
                        if (kp2 & 1) kA[t2][s] = v; else kB[t2][s] = v; } }
            f32x16_t acc0 = {}, acc1 = {};
#pragma unroll
            for (int s = 0; s < 4; ++s) { acc0 = __builtin_amdgcn_mfma_f32_32x32x16_bf16(qa[s], (kp2 & 1) ? kB[0][s] : kA[0][s], acc0, 0, 0, 0);
                acc1 = __builtin_amdgcn_mfma_f32_32x32x16_bf16(qa[s], (kp2 & 1) ? kB[1][s] : kA[1][s], acc1, 0, 0, 0); }
            f32x2_t s0 = {0.f, 0.f}, s1 = {0.f, 0.f}; float a0 = 0.f, b0 = 0.f, a1 = 0.f, b1 = 0.f;
#pragma unroll
            for (int r = 0; r < 8; ++r) { const f32x2_t x0 = {acc0[2 * r], acc0[2 * r + 1]}, x1 = {acc1[2 * r], acc1[2 * r + 1]};
                s0 = x0 * w2[r] + s0; s1 = x1 * w2[r] + s1;
                a0 = fmaf(w2[r].x, fabsf(x0.x), a0); b0 = fmaf(w2[r].y, fabsf(x0.y), b0); a1 = fmaf(w2[r].x, fabsf(x1.x), a1); b1 = fmaf(w2[r].y, fabsf(x1.y), b1); }
            float v0 = (s0.x + s0.y) + (a0 + b0), v1 = (s1.x + s1.y) + (a1 + b1);
            if (2 * kp2 == kbnd) { v0 += pen; v1 = NEG; } else if (2 * kp2 + 1 == kbnd) v1 += pen;
            sc[2 * kp2] = v0; sc[2 * kp2 + 1] = v1;
        } else { sc[2 * kp2] = NEG; sc[2 * kp2 + 1] = NEG; }
    }
    float thr = -3.0e38f, tieval = 0.f; bool tie = false; int need = 0;
    bool act = th >= TOPK;
    if (__any(act)) {
        float mn = sc[0], mx = sc[0];
#pragma unroll
        for (int kt = 1; kt < 8; ++kt) mn = __builtin_amdgcn_fmed3f(mn, sc[kt], NEG);
#pragma unroll
        for (int kt = 1; kt < 64; ++kt) mx = __builtin_amdgcn_fmed3f(mx, sc[kt], __builtin_inff());
#define IDX_DPP_F(v, ctrl) __builtin_bit_cast(float, __builtin_amdgcn_update_dpp(0, __builtin_bit_cast(int, v), ctrl, 0xf, 0xf, false))
        mn = fminf(mn, IDX_DPP_F(mn, 0x128)); mn = fminf(mn, IDX_DPP_F(mn, 0x124)); mn = fminf(mn, IDX_DPP_F(mn, 0x122)); mn = fminf(mn, IDX_DPP_F(mn, 0x121));
        mx = fmaxf(mx, IDX_DPP_F(mx, 0x128)); mx = fmaxf(mx, IDX_DPP_F(mx, 0x124)); mx = fmaxf(mx, IDX_DPP_F(mx, 0x122)); mx = fmaxf(mx, IDX_DPP_F(mx, 0x121));
#undef IDX_DPP_F
        { const float a0 = __builtin_bit_cast(float, __builtin_amdgcn_readlane(__builtin_bit_cast(int, mn), 0)), a1 = __builtin_bit_cast(float, __builtin_amdgcn_readlane(__builtin_bit_cast(int, mn), 16));
          const float a2 = __builtin_bit_cast(float, __builtin_amdgcn_readlane(__builtin_bit_cast(int, mn), 32)), a3 = __builtin_bit_cast(float, __builtin_amdgcn_readlane(__builtin_bit_cast(int, mn), 48));
          const float b0 = __builtin_bit_cast(float, __builtin_amdgcn_readlane(__builtin_bit_cast(int, mx), 0)), b1 = __builtin_bit_cast(float, __builtin_amdgcn_readlane(__builtin_bit_cast(int, mx), 16));
          const float b2 = __builtin_bit_cast(float, __builtin_amdgcn_readlane(__builtin_bit_cast(int, mx), 32)), b3 = __builtin_bit_cast(float, __builtin_amdgcn_readlane(__builtin_bit_cast(int, mx), 48));
          mn = hw ? fminf(a2, a3) : fminf(a0, a1); mx = hw ? fmaxf(b2, b3) : fmaxf(b0, b1); }
        float lo = mn, hi = mx + fabsf(mx) * 1e-6f + 1e-30f;
        int chi = 0;
        float glo = (float)(th + 1) - ((float)TOPK - 0.5f), ghi = -((float)TOPK - 0.5f); int side = 0;
        const int ngrp = (nkt + 7) >> 3;
        for (int it = 0; it < 200; ++it) {
            if (!__any(act)) break;
            float mid = hi - ghi * (hi - lo) * __builtin_amdgcn_rcpf(ghi - glo);
            if (!(mid > lo && mid < hi)) mid = 0.5f * (lo + hi);
            const bool conv = !(mid > lo && mid < hi);
            unsigned ba = 0u, bb = 0u;
#pragma unroll
            for (int g8 = 0; g8 < 4; ++g8) if (g8 < ngrp) {
#pragma unroll
                for (int kt = 8 * g8; kt < 8 * g8 + 8; ++kt) ba = __builtin_amdgcn_alignbit(ba, __builtin_bit_cast(unsigned, sc[kt] - mid), 31); }
#pragma unroll
            for (int g8 = 4; g8 < 8; ++g8) if (g8 < ngrp) {
#pragma unroll
                for (int kt = 8 * g8; kt < 8 * g8 + 8; ++kt) bb = __builtin_amdgcn_alignbit(bb, __builtin_bit_cast(unsigned, sc[kt] - mid), 31); }
            int cl = 8 * ngrp - (__builtin_popcount(ba) + __builtin_popcount(bb));
            cl += __builtin_amdgcn_update_dpp(0, cl, 0x128, 0xf, 0xf, false);
            cl += __builtin_amdgcn_update_dpp(0, cl, 0x124, 0xf, 0xf, false);
            cl += __builtin_amdgcn_update_dpp(0, cl, 0x122, 0xf, 0xf, false);
            cl += __builtin_amdgcn_update_dpp(0, cl, 0x121, 0xf, 0xf, false);
            const int c0 = __builtin_amdgcn_readlane(cl, 0) + __builtin_amdgcn_readlane(cl, 16), c1 = __builtin_amdgcn_readlane(cl, 32) + __builtin_amdgcn_readlane(cl, 48);
            const int c = hw ? c1 : c0;
            if (act) {
                if (conv) { act = false; tie = true; tieval = lo; thr = hi; need = TOPK - chi; }
                else if (c == TOPK) { act = false; thr = mid; }
                else if (c > TOPK) { lo = mid; glo = (float)c - ((float)TOPK - 0.5f); if (side == 1) ghi *= 0.5f; side = 1; }
                else { hi = mid; chi = c; ghi = (float)c - ((float)TOPK - 0.5f); if (side == -1) glo *= 0.5f; side = -1; }
            }
        }
        if (act) { thr = hi; }
    }
    unsigned w0v = 0u, w1v = 0u;
    const bool anytie = __any(tie);
    int need0 = __builtin_amdgcn_readlane(need, 0), need1 = __builtin_amdgcn_readlane(need, 32);
    if (!anytie) {
#define IDX_WL(KT) if ((KT) < nkt) { const unsigned long long bal_ = __ballot(sc[KT] >= thr); const unsigned x0_ = (unsigned)bal_, x1_ = (unsigned)(bal_ >> 32); \
        asm volatile("s_nop 1\n\tv_writelane_b32 %0, %2, " #KT "\n\tv_writelane_b32 %1, %3, " #KT : "+v"(w0v), "+v"(w1v) : "s"(x0_), "s"(x1_)); }
        IDX_WL(0) IDX_WL(1) IDX_WL(2) IDX_WL(3) IDX_WL(4) IDX_WL(5) IDX_WL(6) IDX_WL(7) IDX_WL(8) IDX_WL(9) IDX_WL(10) IDX_WL(11) IDX_WL(12) IDX_WL(13) IDX_WL(14) IDX_WL(15) IDX_WL(16) IDX_WL(17) IDX_WL(18) IDX_WL(19) IDX_WL(20) IDX_WL(21) IDX_WL(22) IDX_WL(23) IDX_WL(24) IDX_WL(25) IDX_WL(26) IDX_WL(27) IDX_WL(28) IDX_WL(29) IDX_WL(30) IDX_WL(31) IDX_WL(32) IDX_WL(33) IDX_WL(34) IDX_WL(35) IDX_WL(36) IDX_WL(37) IDX_WL(38) IDX_WL(39) IDX_WL(40) IDX_WL(41) IDX_WL(42) IDX_WL(43) IDX_WL(44) IDX_WL(45) IDX_WL(46) IDX_WL(47) IDX_WL(48) IDX_WL(49) IDX_WL(50) IDX_WL(51) IDX_WL(52) IDX_WL(53) IDX_WL(54) IDX_WL(55) IDX_WL(56) IDX_WL(57) IDX_WL(58) IDX_WL(59) IDX_WL(60) IDX_WL(61) IDX_WL(62) IDX_WL(63)
#undef IDX_WL
    } else
#pragma unroll
    for (int kt = 0; kt < 64; ++kt) if (kt < nkt) {
        const unsigned long long bal = __ballot(sc[kt] >= thr);
        unsigned x0 = (unsigned)bal, x1 = (unsigned)(bal >> 32);
        if (anytie) {
            const unsigned long long be = __ballot(tie && sc[kt] == tieval);
            unsigned e0 = (unsigned)be, e1 = (unsigned)(be >> 32);
            while (__builtin_popcount(e0) > need0) e0 &= ~(0x80000000u >> __builtin_clz(e0));
            while (__builtin_popcount(e1) > need1) e1 &= ~(0x80000000u >> __builtin_clz(e1));
            need0 -= __builtin_popcount(e0); need1 -= __builtin_popcount(e1);
            x0 |= e0; x1 |= e1;
        }
        w0v = (lane == kt) ? x0 : w0v; w1v = (lane == kt) ? x1 : w1v;
    }
    maskout[(size_t)(b * SEQ + t0) * 64 + lane] = w0v;
    maskout[(size_t)(b * SEQ + t0 + 1) * 64 + lane] = w1v;
}


__device__ __forceinline__ bf16x8_t ssm_pack8(const f32x16_t& v, int base) {
    v4u w; w.x = pg8::cvt_pk_bf16(v[base + 0], v[base + 1]); w.y = pg8::cvt_pk_bf16(v[base + 2], v[base + 3]); w.z = pg8::cvt_pk_bf16(v[base + 4], v[base + 5]); w.w = pg8::cvt_pk_bf16(v[base + 6], v[base + 7]);
    return __builtin_bit_cast(bf16x8_t, w);
}
__device__ __forceinline__ void ssm_mfma_task(Frame& F, int b, int g, const LAS fl4* tInv, const LAS fl4* tW, bf16* ygo, int c_light, int c_begin, int c_end) {
    const int lane = F.lane, j = lane & 31, hw = lane >> 5;
    const bf16* pu = (const bf16*)(F.ws + WS_PROJ) + (size_t)(b * SEQ) * NPROJ + U_OFF + g * 16;
    bf16x8_t bc[4], ca[4][2], tri[2];
#pragma unroll
    for (int nt = 0; nt < 4; ++nt) bc[nt] = *(const bf16x8_t*)((const bf16*)(F.ws + WS_BCAT) + (size_t)((g * 128 + nt * 32 + j) * 16 + 8 * hw));
#pragma unroll
    for (int q = 0; q < 4; ++q)
#pragma unroll
        for (int s = 0; s < 2; ++s) ca[q][s] = *(const bf16x8_t*)((const bf16*)(F.ws + WS_CA) + (size_t)((((g * 4 + q) * 2 + s) * 64 + lane) * 8));
#pragma unroll
    for (int s = 0; s < 2; ++s) { v4u w;
        unsigned hv[8];
#pragma unroll
        for (int e = 0; e < 8; ++e) { const int i = 8 * (2 * s + (e >> 2)) + 4 * hw + (e & 3); hv[e] = (i <= j) ? 0x3F80u : 0u; }
        w.x = hv[0] | (hv[1] << 16); w.y = hv[2] | (hv[3] << 16); w.z = hv[4] | (hv[5] << 16); w.w = hv[6] | (hv[7] << 16);
        tri[s] = __builtin_bit_cast(bf16x8_t, w); }
    float2 a32[2];
#pragma unroll
    for (int pt = 0; pt < 2; ++pt) a32[pt] = ((const float2*)(F.ws + WS_TABA32))[g * 64 + pt * 32 + j];
    float dv[8];
#pragma unroll
    for (int k = 0; k < 8; ++k) dv[k] = F.in[I_D][g * 16 + (k & 3) + 8 * (k >> 2) + 4 * hw];
    float hcr[2] = {0.f, 0.f}, hci[2] = {0.f, 0.f};
    const bf16* pl = pu + (size_t)j * NPROJ;
    if (c_light < c_begin) {
        bf16x8_t ul = *(const bf16x8_t*)(pl + (size_t)c_light * 32 * NPROJ + 8 * hw);
#pragma unroll 1
        for (int c = c_light; c < c_begin; ++c) {
            const bf16x8_t ulc = ul;
            if (c + 1 < c_begin) ul = *(const bf16x8_t*)(pl + (size_t)(c + 1) * 32 * NPROJ + 8 * hw);
            f32x16_t d[4];
#pragma unroll
            for (int nt = 0; nt < 4; ++nt) { f32x16_t z = {}; d[nt] = __builtin_amdgcn_mfma_f32_32x32x16_bf16(ulc, bc[nt], z, 0, 0, 0); }
#pragma unroll
            for (int pt = 0; pt < 2; ++pt) { float sr = 0.f, si = 0.f;
                fl2 sr2 = {0.f, 0.f}, si2 = {0.f, 0.f};
#pragma unroll
                for (int rp = 0; rp < 8; ++rp) { const fl4 w = tInv[(pt * 8 + rp) * 64 + lane]; const fl2 wre = {w.x, w.y}, wim = {w.z, w.w};
                    const fl2 re = {d[pt][2 * rp], d[pt][2 * rp + 1]}, im = {d[2 + pt][2 * rp], d[2 + pt][2 * rp + 1]}; sr2 += wre * re - wim * im; si2 += wre * im + wim * re; }
                sr = sr2.x + sr2.y; si = si2.x + si2.y;
                sr += __shfl_xor(sr, 32); si += __shfl_xor(si, 32);
                sr += hcr[pt]; si += hci[pt];
                hcr[pt] = a32[pt].x * sr - a32[pt].y * si; hci[pt] = a32[pt].x * si + a32[pt].y * sr; }
        }
    }
    const bf16* pf = pl + (size_t)c_begin * 32 * NPROJ;
    bf16x8_t ua = *(const bf16x8_t*)(pf + 8 * hw);
    v2u ue0 = *(const v2u*)(pf + 4 * hw), ue1 = *(const v2u*)(pf + 8 + 4 * hw);
#pragma unroll 1
    for (int c = c_begin; c < c_end; ++c) {
        const bf16x8_t uac = ua; const v2u uc0 = ue0, uc1 = ue1;
        if (c + 1 < c_end) { const bf16* pn = pl + (size_t)(c + 1) * 32 * NPROJ; ua = *(const bf16x8_t*)(pn + 8 * hw); ue0 = *(const v2u*)(pn + 4 * hw); ue1 = *(const v2u*)(pn + 8 + 4 * hw); }
        f32x16_t d[4];
#pragma unroll
        for (int nt = 0; nt < 4; ++nt) { f32x16_t z = {}; d[nt] = __builtin_amdgcn_mfma_f32_32x32x16_bf16(uac, bc[nt], z, 0, 0, 0); }
#pragma unroll
        for (int pt = 0; pt < 2; ++pt) { float sr = 0.f, si = 0.f;
            fl2 sr2 = {0.f, 0.f}, si2 = {0.f, 0.f};
#pragma unroll
            for (int rp = 0; rp < 8; ++rp) { const fl4 w = tInv[(pt * 8 + rp) * 64 + lane]; const fl2 wre = {w.x, w.y}, wim = {w.z, w.w};
                const fl2 re = {d[pt][2 * rp], d[pt][2 * rp + 1]}, im = {d[2 + pt][2 * rp], d[2 + pt][2 * rp + 1]};
                fl2 xr = wre * re - wim * im, xi = wre * im + wim * re;
                if (rp == 0) { xr.x += (hw == 0) ? hcr[pt] : 0.f; xi.x += (hw == 0) ? hci[pt] : 0.f; }
                d[pt][2 * rp] = xr.x; d[pt][2 * rp + 1] = xr.y; d[2 + pt][2 * rp] = xi.x; d[2 + pt][2 * rp + 1] = xi.y; sr2 += xr; si2 += xi; }
            sr = sr2.x + sr2.y; si = si2.x + si2.y;
            sr += __shfl_xor(sr, 32); si += __shfl_xor(si, 32);
            hcr[pt] = a32[pt].x * sr - a32[pt].y * si; hci[pt] = a32[pt].x * si + a32[pt].y * sr; }
        f32x16_t st[4];
#pragma unroll
        for (int q = 0; q < 4; ++q) { f32x16_t z = {}; st[q] = __builtin_amdgcn_mfma_f32_32x32x16_bf16(ssm_pack8(d[q], 0), tri[0], z, 0, 0, 0);
            st[q] = __builtin_amdgcn_mfma_f32_32x32x16_bf16(ssm_pack8(d[q], 8), tri[1], st[q], 0, 0, 0); }
#pragma unroll
        for (int pt = 0; pt < 2; ++pt)
#pragma unroll
            for (int rp = 0; rp < 8; ++rp) { const fl4 w = tW[(pt * 8 + rp) * 64 + lane]; const fl2 wre = {w.x, w.y}, wim = {w.z, w.w};
                const fl2 sre = {st[pt][2 * rp], st[pt][2 * rp + 1]}, sim = {st[2 + pt][2 * rp], st[2 + pt][2 * rp + 1]};
                const fl2 hr = wre * sre - wim * sim, hi = wre * sim + wim * sre;
                st[pt][2 * rp] = hr.x; st[pt][2 * rp + 1] = hr.y; st[2 + pt][2 * rp] = hi.x; st[2 + pt][2 * rp + 1] = hi.y; }
        f32x16_t y = {};
#pragma unroll
        for (int q = 0; q < 4; ++q) { y = __builtin_amdgcn_mfma_f32_32x32x16_bf16(ca[q][0], ssm_pack8(st[q], 0), y, 0, 0, 0); y = __builtin_amdgcn_mfma_f32_32x32x16_bf16(ca[q][1], ssm_pack8(st[q], 8), y, 0, 0, 0); }
        float o[8];
        o[0] = y[0] + dv[0] * bflo(uc0.x); o[1] = y[1] + dv[1] * bfhi(uc0.x); o[2] = y[2] + dv[2] * bflo(uc0.y); o[3] = y[3] + dv[3] * bfhi(uc0.y);
        o[4] = y[4] + dv[4] * bflo(uc1.x); o[5] = y[5] + dv[5] * bfhi(uc1.x); o[6] = y[6] + dv[6] * bflo(uc1.y); o[7] = y[7] + dv[7] * bfhi(uc1.y);
        const pg8::f32x2 g0 = pg8::gelu_pk((pg8::f32x2){o[0], o[1]}), g1 = pg8::gelu_pk((pg8::f32x2){o[2], o[3]}), g2 = pg8::gelu_pk((pg8::f32x2){o[4], o[5]}), g3 = pg8::gelu_pk((pg8::f32x2){o[6], o[7]});
        bf16* yo = ygo + (size_t)(b * SEQ + c * 32 + j) * SSMW + g * 16 + 4 * hw;
        v2u w0; w0.x = pg8::cvt_pk_bf16(g0.x, g0.y); w0.y = pg8::cvt_pk_bf16(g1.x, g1.y); *(v2u*)yo = w0;
        v2u w1; w1.x = pg8::cvt_pk_bf16(g2.x, g2.y); w1.y = pg8::cvt_pk_bf16(g3.x, g3.y); *(v2u*)(yo + 8) = w1;
    }
}


namespace att {
using bf16x8 = __attribute__((ext_vector_type(8))) short;
using s16x4  = __attribute__((ext_vector_type(4))) short;
using f32x16 = __attribute__((ext_vector_type(16))) float;
using u32x4  = __attribute__((ext_vector_type(4))) unsigned;
constexpr int D = 128, NW = 8, QBLK = 32, KVBLK = 64;
constexpr float SCALE = 0.088388347648318440f;
constexpr float THR = 8.f;
constexpr int LDK = NPROJ;
constexpr int SHM_V = KVBLK * D * 2, SHM_K = KVBLK * D * 2, SHM_ATTN = 3 * SHM_V + 3 * SHM_K + NW * 64 * 4;
#define KSWZ(row, colB) ((row) * 256 + ((colB) ^ (((row) & 7) << 4)))
#define SBAR() __builtin_amdgcn_sched_barrier(0)
__device__ __forceinline__ int crow(int r, int hi) { return (r & 3) + 8 * (r >> 2) + 4 * hi; }
__device__ __forceinline__ unsigned cvtpk(float lo, float hi) { unsigned r; asm volatile("v_cvt_pk_bf16_f32 %0, %1, %2" : "=v"(r) : "v"(lo), "v"(hi)); return r; }

__device__ __forceinline__ void partialSM(f32x16& p0, f32x16& p1, float& m_reg, float& mn, float& alpha, float base) {
  constexpr float C = SCALE * 1.4426950408889634f;
  float pm0 = p0[0], pm1 = p0[1], pm2 = p0[2], pm3 = p0[3];
#define MX3(a, b, c) __builtin_fmaxf(__builtin_fmaxf(a, b), c)
  pm0 = MX3(pm0, p0[4], p0[8]); pm1 = MX3(pm1, p0[5], p0[9]); pm2 = MX3(pm2, p0[6], p0[10]); pm3 = MX3(pm3, p0[7], p0[11]);
  pm0 = MX3(pm0, p0[12], p1[0]); pm1 = MX3(pm1, p0[13], p1[1]); pm2 = MX3(pm2, p0[14], p1[2]); pm3 = MX3(pm3, p0[15], p1[3]);
  pm0 = MX3(pm0, p1[4], p1[8]); pm1 = MX3(pm1, p1[5], p1[9]); pm2 = MX3(pm2, p1[6], p1[10]); pm3 = MX3(pm3, p1[7], p1[11]);
  pm0 = MX3(pm0, p1[12], p1[13]); pm1 = MX3(pm1, p1[14], p1[15]);
  float pmax = MX3(pm0, pm1, pm2); pmax = fmaxf(pmax, pm3);
#undef MX3
  pmax += base;
  { auto rr = __builtin_amdgcn_permlane32_swap(__float_as_uint(pmax), __float_as_uint(pmax), false, false);
    pmax = fmaxf(__uint_as_float(rr[0]), __uint_as_float(rr[1])); }
  if (__builtin_expect(__all(pmax - m_reg <= THR / SCALE), 1)) { mn = m_reg; alpha = 1.f; }
  else { mn = fmaxf(m_reg, pmax); alpha = __builtin_amdgcn_exp2f((m_reg - mn) * C); m_reg = mn; }
  float mnC = (base - mn) * C;
  for (int r = 0; r < 16; ++r) p0[r] = fmaf(p0[r], C, mnC); for (int r = 0; r < 16; ++r) p1[r] = fmaf(p1[r], C, mnC);
  for (int r = 0; r < 16; ++r) p0[r] = __builtin_amdgcn_exp2f(p0[r]);
}
__device__ __forceinline__ void finishSM(f32x16& p0, f32x16& p1, float alpha, float& l_reg, bf16x8& pa0, bf16x8& pa1, bf16x8& pa2, bf16x8& pa3) {
  for (int r = 0; r < 16; ++r) p1[r] = __builtin_amdgcn_exp2f(p1[r]);
  float ps = 0; for (int r = 0; r < 16; ++r) ps += p0[r]; for (int r = 0; r < 16; ++r) ps += p1[r];
  { auto rr = __builtin_amdgcn_permlane32_swap(__float_as_uint(ps), __float_as_uint(ps), false, false);
    ps = __uint_as_float(rr[0]) + __uint_as_float(rr[1]); }
  l_reg = l_reg * alpha + ps;
#define PK4(P, BASE, OUT) do { unsigned a0 = cvtpk(P[BASE + 0], P[BASE + 1]), a1 = cvtpk(P[BASE + 2], P[BASE + 3]);   \
    unsigned b0 = cvtpk(P[BASE + 4], P[BASE + 5]), b1 = cvtpk(P[BASE + 6], P[BASE + 7]);                              \
    auto r0 = __builtin_amdgcn_permlane32_swap(a0, b0, false, false); auto r1 = __builtin_amdgcn_permlane32_swap(a1, b1, false, false); \
    u32x4 w = {r0[0], r1[0], r0[1], r1[1]}; OUT = *reinterpret_cast<bf16x8*>(&w); } while (0)
  PK4(p0, 0, pa0); PK4(p0, 8, pa1); PK4(p1, 0, pa2); PK4(p1, 8, pa3);
#undef PK4
}
__device__ __forceinline__ void qkt(f32x16& p0, f32x16& p1, const bf16* Ks, const bf16x8* qr, int r32, int hi, float slopeS, v2u mw) {
  p0 = f32x16{}; p1 = f32x16{};
  for (int d0 = 0; d0 < 8; ++d0) { int cb = (d0 * 16 + hi * 8) * 2;
    bf16x8 b0 = *reinterpret_cast<const bf16x8*>((const char*)Ks + KSWZ(r32, cb));
    bf16x8 b1 = *reinterpret_cast<const bf16x8*>((const char*)Ks + KSWZ(32 + r32, cb));
    p0 = __builtin_amdgcn_mfma_f32_32x32x16_bf16(b0, qr[d0], p0, 0, 0, 0);
    p1 = __builtin_amdgcn_mfma_f32_32x32x16_bf16(b1, qr[d0], p1, 0, 0, 0); }
  const unsigned s0 = mw.x >> (4 * hi), s1 = mw.y >> (4 * hi); const float NEG = -__builtin_inff();
#pragma unroll
  for (int r = 0; r < 16; ++r) { const int cr = (r & 3) + 8 * (r >> 2);
    const unsigned m0 = (unsigned)(((int)(s0 << (31 - cr))) >> 31), m1 = (unsigned)(((int)(s1 << (31 - cr))) >> 31);
    p0[r] = __uint_as_float((m0 & __float_as_uint(fmaf(slopeS, (float)cr, p0[r]))) | (~m0 & 0xFF800000u));
    p1[r] = __uint_as_float((m1 & __float_as_uint(fmaf(slopeS, (float)(32 + cr), p1[r]))) | (~m1 & 0xFF800000u)); }
  (void)NEG;
}
__device__ __forceinline__ int v_st(int k, int c) { const int kk = (k & ~0xC) | ((k & 4) << 1) | ((k & 8) >> 1); return ((kk >> 3) * 4 + (c >> 5)) * 512 + ((kk & 7) * 32 + (c & 31)) * 2; }
__device__ __forceinline__ int v_rd_base(int lane) { return ((lane & 3) << 3) | (((lane >> 2) & 3) << 6) | (((lane >> 4) & 1) << 5) | (((lane >> 5) & 1) << 8); }
constexpr int v_rd_off(int d0, int ks, int half) { return d0 * 512 + ks * 4096 + half * 2048; }
template <int OFF> __device__ __forceinline__ s16x4 tr_read(int vb) {
  s16x4 r; asm volatile("ds_read_b64_tr_b16 %0, %1 offset:%2" : "=&v"(r) : "v"(vb), "i"(OFF) : "memory"); return r;
}
template <int D0> __device__ __forceinline__ void pv_one(f32x16& od, int vb, bf16x8 pa0, bf16x8 pa1, bf16x8 pa2, bf16x8 pa3) {
  const s16x4 l0 = tr_read<v_rd_off(D0, 0, 0)>(vb), h0 = tr_read<v_rd_off(D0, 0, 1)>(vb), l1 = tr_read<v_rd_off(D0, 1, 0)>(vb), h1 = tr_read<v_rd_off(D0, 1, 1)>(vb);
  const s16x4 l2 = tr_read<v_rd_off(D0, 2, 0)>(vb), h2 = tr_read<v_rd_off(D0, 2, 1)>(vb), l3 = tr_read<v_rd_off(D0, 3, 0)>(vb), h3 = tr_read<v_rd_off(D0, 3, 1)>(vb);
  asm volatile("s_waitcnt lgkmcnt(0)" ::: "memory"); SBAR();
#define PK(L, H) (bf16x8){L[0], L[1], L[2], L[3], H[0], H[1], H[2], H[3]}
  od = __builtin_amdgcn_mfma_f32_32x32x16_bf16(pa0, PK(l0, h0), od, 0, 0, 0);
  od = __builtin_amdgcn_mfma_f32_32x32x16_bf16(pa1, PK(l1, h1), od, 0, 0, 0);
  od = __builtin_amdgcn_mfma_f32_32x32x16_bf16(pa2, PK(l2, h2), od, 0, 0, 0);
  od = __builtin_amdgcn_mfma_f32_32x32x16_bf16(pa3, PK(l3, h3), od, 0, 0, 0);
#undef PK
}
__device__ __forceinline__ void pv_d0(f32x16* o, int vb, bf16x8 pa0, bf16x8 pa1, bf16x8 pa2, bf16x8 pa3) {
  pv_one<0>(o[0], vb, pa0, pa1, pa2, pa3); pv_one<1>(o[1], vb, pa0, pa1, pa2, pa3); pv_one<2>(o[2], vb, pa0, pa1, pa2, pa3); pv_one<3>(o[3], vb, pa0, pa1, pa2, pa3);
}
__device__ __forceinline__ void attn_mask_body(const bf16* __restrict__ Qb, const bf16* __restrict__ Kh, const bf16* __restrict__ Vh, const unsigned* __restrict__ Mb,
                                               unsigned char* __restrict__ Ob, int seq, float slopeS, char* lds) {
  const int tid = threadIdx.x, wid = tid >> 6, lane = tid & 63, r32 = lane & 31, hi = lane >> 5;
  bf16* V_lds = (bf16*)lds; bf16* K_lds = (bf16*)(lds + 3 * SHM_V);
  float* ws = (float*)(lds + 3 * SHM_V + 3 * SHM_K) + wid * 64; float* li_l = ws; float* al_l = ws + 32;
  float m_reg = -1e30f, l_reg = 0; f32x16 o[4] = {}; bf16x8 qr[8];
  const bf16* Qw = Qb + (long)(wid * QBLK + r32) * NPROJ + hi * 8;
#pragma unroll
  for (int d0 = 0; d0 < 8; ++d0) qr[d0] = *reinterpret_cast<const bf16x8*>(Qw + d0 * 16);
  const unsigned mvoff = (unsigned)(wid * QBLK + r32) * 256u;
#define MWLD(j) __builtin_bit_cast(v2u, __builtin_amdgcn_raw_buffer_load_b64(rm, mvoff, (j) * 8, 0))
  const float hb = slopeS * (float)(4 * hi);
  const int sr = tid >> 4, sc = (tid & 15) * 8, vst0 = v_st(sr, sc), vst1 = v_st(32 + sr, sc);
  const int vb0 = (int)(uintptr_t)V_lds + v_rd_base(lane);
  struct { bf16x8 vs0, vs1, ks0, ks1; } sr_[2];
  const unsigned kvoff = (unsigned)(sr * LDK + sc) * 2u;
  const __amdgpu_buffer_rsrc_t rk = __builtin_amdgcn_make_buffer_rsrc((void*)Kh, 0, SEQ * NPROJ * 2, 0x00020000);
  const __amdgpu_buffer_rsrc_t rv = __builtin_amdgcn_make_buffer_rsrc((void*)Vh, 0, SEQ * NPROJ * 2, 0x00020000);
  const __amdgpu_buffer_rsrc_t rm = __builtin_amdgcn_make_buffer_rsrc((void*)Mb, 0, 256 * 256, 0x00020000);
#define BL16(rs, so) __builtin_bit_cast(bf16x8, __builtin_amdgcn_raw_buffer_load_b128(rs, kvoff, (so), 0))
#define SLOAD(i, k0) do { const int so_ = (k0) * (LDK * 2); \
    sr_[i].vs0 = BL16(rv, so_); sr_[i].vs1 = BL16(rv, so_ + 32 * LDK * 2); sr_[i].ks0 = BL16(rk, so_); sr_[i].ks1 = BL16(rk, so_ + 32 * LDK * 2); } while (0)
#define SWRITE(b, i) do { *(bf16x8*)((char*)V_lds + (b) * SHM_V + vst0) = sr_[i].vs0;          \
    *(bf16x8*)((char*)V_lds + (b) * SHM_V + vst1) = sr_[i].vs1; int kc = sc * 2;               \
    *(bf16x8*)((char*)K_lds + (b) * SHM_K + KSWZ(sr, kc)) = sr_[i].ks0;                       \
    *(bf16x8*)((char*)K_lds + (b) * SHM_K + KSWZ(32 + sr, kc)) = sr_[i].ks1; } while (0)
#define SWAIT() asm volatile("s_waitcnt vmcnt(4)" ::: "memory")
#define RESC(a) do { if (__any((a) < 1.f)) { if (hi == 0) al_l[r32] = (a); asm volatile("s_waitcnt lgkmcnt(0)" ::: "memory"); \
    for (int d = 0; d < 4; ++d) for (int r = 0; r < 16; ++r) o[d][r] *= al_l[crow(r, hi)]; } } while (0)
#define TBASE(j) fmaf(slopeS, (float)(64 * (j)), hb)
  f32x16 pA0, pA1, pB0, pB1; float mnA, mnB, alA, alB; bf16x8 pa0, pa1, pa2, pa3; const int NT = seq / KVBLK;
  v2u mwA = MWLD(0), mwB = MWLD(1);
  int sp = 0, sq = 1, sw = 2;
  SLOAD(0, 0); asm volatile("s_waitcnt vmcnt(0)" ::: "memory"); SWRITE(0, 0);
  SLOAD(0, KVBLK); asm volatile("s_waitcnt vmcnt(0)" ::: "memory"); SWRITE(1, 0);
  if (2 < NT) SLOAD(0, 2 * KVBLK);
  __syncthreads();
  qkt(pA0, pA1, K_lds, qr, r32, hi, slopeS, mwA); partialSM(pA0, pA1, m_reg, mnA, alA, TBASE(0));
#define ROT3() do { const int t_ = sp; sp = sq; sq = sw; sw = t_; } while (0)
  for (int j = 1; j + 1 < NT; j += 2) {
    SWRITE(sw, 0);
    mwA = MWLD(j + 1);
    SBAR(); qkt(pB0, pB1, (bf16*)((char*)K_lds + sq * SHM_K), qr, r32, hi, slopeS, mwB);
    finishSM(pA0, pA1, alA, l_reg, pa0, pa1, pa2, pa3); SBAR();
    SLOAD(0, (j + 2) * KVBLK); SBAR();
    pv_d0(o, vb0 + sp * (int)SHM_V, pa0, pa1, pa2, pa3); partialSM(pB0, pB1, m_reg, mnB, alB, TBASE(j));
    RESC(alB); __syncthreads(); ROT3();
    SWRITE(sw, 0);
    mwB = MWLD(j + 2);
    SBAR(); qkt(pA0, pA1, (bf16*)((char*)K_lds + sq * SHM_K), qr, r32, hi, slopeS, mwA);
    finishSM(pB0, pB1, alB, l_reg, pa0, pa1, pa2, pa3); SBAR();
    if (j + 3 < NT) SLOAD(0, (j + 3) * KVBLK); SBAR();
    pv_d0(o, vb0 + sp * (int)SHM_V, pa0, pa1, pa2, pa3); partialSM(pA0, pA1, m_reg, mnA, alA, TBASE(j + 1));
    RESC(alA); __syncthreads(); ROT3();
  }
  SBAR(); qkt(pB0, pB1, (bf16*)((char*)K_lds + sq * SHM_K), qr, r32, hi, slopeS, mwB);
  finishSM(pA0, pA1, alA, l_reg, pa0, pa1, pa2, pa3); SBAR();
  pv_d0(o, vb0 + sp * (int)SHM_V, pa0, pa1, pa2, pa3); partialSM(pB0, pB1, m_reg, mnB, alB, TBASE(NT - 1));
  RESC(alB);
  finishSM(pB0, pB1, alB, l_reg, pa0, pa1, pa2, pa3); SBAR();
  pv_d0(o, vb0 + sq * (int)SHM_V, pa0, pa1, pa2, pa3);
#undef ROT3
  if (hi == 0) li_l[r32] = l_reg; asm volatile("s_waitcnt lgkmcnt(0)" ::: "memory");
  float rli[16];
#pragma unroll
  for (int r = 0; r < 16; ++r) rli[r] = __builtin_amdgcn_rcpf(li_l[crow(r, hi)]);
  unsigned char* Ow = Ob + (long)(wid * QBLK) * 2048;
#pragma unroll
  for (int r = 0; r < 16; ++r) { int orow = crow(r, hi); const float sc = rli[r] * SC_MIX;
    const unsigned w = pk4_fp8(o[0][r] * sc, o[1][r] * sc, o[2][r] * sc, o[3][r] * sc);
    for (int d0 = 0; d0 < 4; ++d0) Ow[(long)orow * 2048 + d0 * 32 + r32] = (unsigned char)(w >> (8 * d0)); }
#undef SLOAD
#undef SWRITE
#undef SWAIT
#undef RESC
#undef TBASE
#undef MWLD
#undef BL16
}
#undef KSWZ
#undef SBAR
}

template <bool OUT_BF16, bool IN_BF16 = false>
__device__ __forceinline__ void ln_row(const void* xrow, void* orow, const float* gam, const float* bet, int lane, unsigned* q8row = nullptr, float q8scale = 1.f) {
    const f32x4* xr = (const f32x4*)xrow + lane; const v2u* xh = (const v2u*)xrow + lane; const f32x4* gr = (const f32x4*)gam + lane; const f32x4* br = (const f32x4*)bet + lane;
    f32x4 v[8]; float s = 0.f;
#pragma unroll
    for (int j = 0; j < 8; ++j) { if constexpr (IN_BF16) { const v2u w = xh[64 * j]; v[j] = (f32x4){bflo(w.x), bfhi(w.x), bflo(w.y), bfhi(w.y)}; } else v[j] = xr[64 * j];
        s += (v[j][0] + v[j][1]) + (v[j][2] + v[j][3]); }
    const float mean = wave_sum(s) * (1.f / DM); float s2 = 0.f;
#pragma unroll
    for (int j = 0; j < 8; ++j) { v[j] = v[j] - mean; s2 += (v[j][0] * v[j][0] + v[j][1] * v[j][1]) + (v[j][2] * v[j][2] + v[j][3] * v[j][3]); }
    const float rstd = 1.f / sqrtf(wave_sum(s2) * (1.f / DM) + LN_EPS);
#pragma unroll
    for (int j = 0; j < 8; ++j) { const f32x4 o = v[j] * rstd * gr[64 * j] + br[64 * j];
        if constexpr (OUT_BF16) { v2u w; w.x = pk2(o[0], o[1]); w.y = pk2(o[2], o[3]); ((v2u*)orow)[lane + 64 * j] = w;
            if (q8row) q8row[lane + 64 * j] = pk4_fp8(o[0] * q8scale, o[1] * q8scale, o[2] * q8scale, o[3] * q8scale); }
        else ((f32x4*)orow)[lane + 64 * j] = o; }
}
template <bool OUT_BF16, bool IN_BF16 = false>
__device__ __forceinline__ void ln_row2(const void* xa, const void* xb_, void* oa, void* ob, const float* gam, const float* bet, int lane, unsigned* qa = nullptr, unsigned* qb = nullptr, float q8scale = 1.f, float2* sa = nullptr, float2* sb = nullptr) {
    const f32x4* gr = (const f32x4*)gam + lane; const f32x4* br = (const f32x4*)bet + lane;
    f32x4 v[2][8]; float s[2] = {0.f, 0.f};
#pragma unroll
    for (int r = 0; r < 2; ++r) { const void* xrow = r ? xb_ : xa; const f32x4* xr = (const f32x4*)xrow + lane; const v2u* xh = (const v2u*)xrow + lane;
#pragma unroll
        for (int j = 0; j < 8; ++j) { if constexpr (IN_BF16) { const v2u w = xh[64 * j]; v[r][j] = (f32x4){bflo(w.x), bfhi(w.x), bflo(w.y), bfhi(w.y)}; } else v[r][j] = xr[64 * j]; } }
#pragma unroll
    for (int r = 0; r < 2; ++r)
#pragma unroll
        for (int j = 0; j < 8; ++j) s[r] += (v[r][j][0] + v[r][j][1]) + (v[r][j][2] + v[r][j][3]);
    const float mean0 = wave_sum(s[0]) * (1.f / DM), mean1 = wave_sum(s[1]) * (1.f / DM); float s2[2] = {0.f, 0.f};
#pragma unroll
    for (int r = 0; r < 2; ++r) { const float mean = r ? mean1 : mean0;
#pragma unroll
        for (int j = 0; j < 8; ++j) { v[r][j] = v[r][j] - mean; s2[r] += (v[r][j][0] * v[r][j][0] + v[r][j][1] * v[r][j][1]) + (v[r][j][2] * v[r][j][2] + v[r][j][3] * v[r][j][3]); } }
    const float rstd0 = 1.f / sqrtf(wave_sum(s2[0]) * (1.f / DM) + LN_EPS), rstd1 = 1.f / sqrtf(wave_sum(s2[1]) * (1.f / DM) + LN_EPS);
    if (sa && lane == 0) { *sa = make_float2(mean0, rstd0); *sb = make_float2(mean1, rstd1); }
#pragma unroll
    for (int j = 0; j < 8; ++j) { const f32x4 g = gr[64 * j], b = br[64 * j];
#pragma unroll
        for (int r = 0; r < 2; ++r) { const f32x4 o = v[r][j] * (r ? rstd1 : rstd0) * g + b; void* orow = r ? ob : oa; unsigned* q8row = r ? qb : qa;
            if constexpr (OUT_BF16) { if (orow) { v2u w; w.x = pk2(o[0], o[1]); w.y = pk2(o[2], o[3]); ((v2u*)orow)[lane + 64 * j] = w; }
                if (q8row) q8row[lane + 64 * j] = pk4_fp8(o[0] * q8scale, o[1] * q8scale, o[2] * q8scale, o[3] * q8scale); }
            else ((f32x4*)orow)[lane + 64 * j] = o; } }
}
__device__ __forceinline__ float gelu_erf(float v) { return 0.5f * v * (1.0f + erff(v * 0.70710678118654752f)); }

__device__ __forceinline__ void ln_row2_mx6(const bf16* ra, const bf16* rb, const f32x4 (&g8)[8], const f32x4 (&b8)[8], int lane, unsigned char* qa, unsigned char* qb, float2* sa, float2* sb) {
    float v[2][32];
#pragma unroll
    for (int q = 0; q < 2; ++q) { const v4u* rp = (const v4u*)((q ? rb : ra) + 32 * lane);
#pragma unroll
        for (int j = 0; j < 4; ++j) { const v4u w = rp[j]; v[q][8 * j] = bflo(w.x); v[q][8 * j + 1] = bfhi(w.x); v[q][8 * j + 2] = bflo(w.y); v[q][8 * j + 3] = bfhi(w.y);
            v[q][8 * j + 4] = bflo(w.z); v[q][8 * j + 5] = bfhi(w.z); v[q][8 * j + 6] = bflo(w.w); v[q][8 * j + 7] = bfhi(w.w); } }
    float s0 = 0.f, s1 = 0.f;
#pragma unroll
    for (int i = 0; i < 32; ++i) { s0 += v[0][i]; s1 += v[1][i]; }
    const float mean0 = wave_sum(s0) * (1.f / DM), mean1 = wave_sum(s1) * (1.f / DM);
    float t0 = 0.f, t1 = 0.f;
#pragma unroll
    for (int i = 0; i < 32; ++i) { const float d0 = v[0][i] - mean0, d1 = v[1][i] - mean1; t0 = fmaf(d0, d0, t0); t1 = fmaf(d1, d1, t1); }
    const float rstd0 = 1.f / sqrtf(wave_sum(t0) * (1.f / DM) + LN_EPS), rstd1 = 1.f / sqrtf(wave_sum(t1) * (1.f / DM) + LN_EPS);
    if (lane == 0) { *sa = make_float2(mean0, rstd0); *sb = make_float2(mean1, rstd1); }
    v16f32 x0, y0, x1, y1;
#pragma unroll
    for (int j = 0; j < 8; ++j) { const f32x4 g = g8[j], b = b8[j];
#pragma unroll
        for (int e = 0; e < 4; ++e) { const int i = 4 * j + e; const float o0 = (v[0][i] - mean0) * rstd0 * g[e] + b[e], o1 = (v[1][i] - mean1) * rstd1 * g[e] + b[e];
            if (i < 16) { x0[i] = o0; x1[i] = o1; } else { y0[i - 16] = o0; y1[i - 16] = o1; } } }
    float a0, a1; MX6_AMAX(x0, y0, a0); MX6_AMAX(x1, y1, a1);
    mx6_store_block(qa, lane, x0, y0, a0); mx6_store_block(qb, lane, x1, y1, a1);
}

struct Args { const float* in[22]; float* out; unsigned char* ws; int ph_lo, ph_hi; };
constexpr int N_PHASES = 11;
__global__ void __launch_bounds__(NWAVES * 64, 2) mk_fwd(Args args) {
    extern __shared__ __attribute__((aligned(16))) unsigned char lds[];
    Frame F;
    F.lds = (LAS unsigned char*)lds;
    F.MISC = (volatile LAS unsigned*)(F.lds + MISC_OFF);
    F.tid = threadIdx.x; F.lane = F.tid & 63; F.wave = __builtin_amdgcn_readfirstlane(F.tid >> 6);
    F.G = gridDim.x; { const int bx = blockIdx.x; F.vcu = (F.G % 8 == 0) ? (bx % 8) * (F.G / 8) + bx / 8 : bx; }
    F.ws = args.ws; F.out = args.out; F.ctl = (unsigned*)(args.ws + WS_CTL);
#pragma unroll
    for (int i = 0; i < 22; ++i) F.in[i] = args.in[i];
    for (int u = F.tid; u < (LDS_BYTES - LDSCTL_OFF) / 4; u += NWAVES * 64) ((LAS unsigned*)(F.lds + LDSCTL_OFF))[u] = 0u;
    __syncthreads();
    const int lo = args.ph_lo, hi = args.ph_hi;
    XcdBarrier bar; bar.bar = F.ctl + CW_BAR; bar.x = 0; bar.st = nullptr;
    if (hi - lo > 1) bar = xcd_barrier_post(F.ctl + CW_BAR, F.MISC + 8);
#define IN(k) (lo <= (k) && (k) < hi)
#define SEAM(k) do { if (IN(k) && IN((k) + 1)) xcd_barrier(bar); } while (0)
    const int gw = F.vcu * NWAVES + F.wave, NGW = F.G * NWAVES;
    bf16* xb = (bf16*)(F.ws + WS_XB); bf16* proj = (bf16*)(F.ws + WS_PROJ); bf16* ygb = (bf16*)(F.ws + WS_YG); unsigned char* mix8 = (unsigned char*)(F.ws + WS_MIX);   unsigned char* act8 = (unsigned char*)(F.ws + WS_ACT);

    if (IN(0)) { p0_prologue(F); } SEAM(0);
    if (IN(1)) {
        const int c = (int)blockIdx.x; const bool g256 = (F.G == 256);
        pg8::ListOrder Sb, Sf;
        if (g256) { Sb.init(M, NPROJ - NP8, c, 256, c < 64 ? 2 : 1); Sf.init(M, NP8, c, 192, c < 64 ? 1 : 3); }
        else { Sb.init(M, NPROJ - NP8, c, F.G, 1 << 20); Sf.init(M, NP8, c, F.G, 1 << 20); }
        { pg8::Gemm g{xb, (const bf16*)(F.ws + WS_WIN) + (size_t)NP8 * DM, M, NPROJ - NP8, DM};
          pg8::EpiProj E{proj, NPROJ, (bf16*)(F.ws + WS_KIPACK), KI_OFF, SEQ, NP8, 1.f};
          pg8::gemm_phase<pg8::EpiProj, pg8::ListOrder, true, true, false>(F.lds + RING_OFF, g, Sb, E); }
        { pg8::Gemm g{(const bf16*)(F.ws + WS_MIX + 32 * MiB), (const bf16*)(F.ws + WS_WIN8), M, NP8, DM / 2};
          pg8::EpiProj E{proj, NPROJ, (bf16*)(F.ws + WS_KIPACK), KI_OFF, SEQ, 0, 1.f / (SC_X * SC_WIN)};
          pg8::gemm_phase<pg8::EpiProj, pg8::ListOrder, true, true, true>(F.lds + RING_OFF, g, Sf, E); }
    } SEAM(1);
    if (IN(2)) {
        { const int g = (F.vcu >> 2) & (NG - 1); LAS fl4* tInv = (LAS fl4*)(F.lds + RING_OFF); LAS fl4* tW = tInv + 2 * 8 * 64;
          for (int i = F.tid; i < 1024; i += NWAVES * 64) { tInv[i] = ((const fl4*)(F.ws + WS_TABINV))[g * 1024 + i]; tW[i] = ((const fl4*)(F.ws + WS_TABW))[g * 1024 + i]; }
          const int ib = F.vcu & 7;
          { const v4u* ksrc = (const v4u*)(F.ws + WS_KIPACK + (size_t)ib * 64 * 4096); LAS v4u* kdst = (LAS v4u*)(F.lds + RING_OFF + 32768);
#pragma unroll 4
            for (int i = F.tid; i < IDX_NLDS * 256; i += NWAVES * 64) kdst[i] = ksrc[i]; }
          LDS_WAIT(); __syncthreads();
          if ((F.wave & 2) == 0) { const int bb = 2 * (F.vcu & 3) + (F.wave & 1), half = F.wave >> 2;
              if (F.vcu < 4 * NG) ssm_mfma_task(F, bb, g, tInv, tW, ygb, 0, half ? SEQ / 64 : 0, half ? SEQ / 32 : SEQ / 64); }
          { LAS unsigned* ctr = (LAS unsigned*)(F.lds + MISC_OFF + 64); LAS unsigned* ctr2 = (LAS unsigned*)(F.lds + MISC_OFF + 68); const int ic = F.vcu >> 3, inb = (F.G - ib + 7) >> 3, npb = (SEQ / 2 + inb - 1) / inb;
            const LAS bf16* kl = (const LAS bf16*)(F.lds + RING_OFF + 32768) + F.lane * 8;
#pragma unroll 1
            for (int pass = 0; pass < 3; ++pass) {
                if (pass == 1) {
                    for (;;) { unsigned m = 0; if (F.lane == 0) m = __hip_atomic_fetch_add(ctr, 1u, __ATOMIC_RELAXED, __HIP_MEMORY_SCOPE_WORKGROUP);
                        m = __builtin_amdgcn_readfirstlane(m); if ((int)m >= npb) break;
                        const int k = (int)m * inb + ((m & 1u) ? inb - 1 - ic : ic); if (k >= SEQ / 2) continue;
                        int ibo; asm volatile("s_mov_b32 %0, %1" : "=s"(ibo) : "s"(ib));
                        idx_mfma_pair(F, ibo, 1023 - k, (unsigned*)(F.ws + WS_MASK), kl); }
                } else if (pass == 2 || F.wave == 7) {
                    for (;;) { unsigned m = 0; if (F.lane == 0) m = __hip_atomic_fetch_add(ctr2, 1u, __ATOMIC_RELAXED, __HIP_MEMORY_SCOPE_WORKGROUP);
                        m = __builtin_amdgcn_readfirstlane(m); const int it = (int)m * F.G + F.vcu; if (it >= P2W_ITEMS) break;
                        p2_weight_item(F, it); } }
            } } }
    } SEAM(2);
    if (IN(3)) {
        const unsigned* maskw = (const unsigned*)(F.ws + WS_MASK);
#pragma unroll 1
        for (int pi = F.vcu; pi < 256; pi += F.G) { const int b = pi >> 5, h = (pi >> 2) & 7, qp = pi & 3, c = h >> 2;
#pragma unroll 1
            for (int half = 0; half < 2; ++half) { const int qb = half ? qp : 7 - qp; const size_t row0 = (size_t)b * SEQ + qb * 256;
                att::attn_mask_body(proj + row0 * NPROJ + Q_OFF + h * HD, proj + (size_t)b * SEQ * NPROJ + K_OFF + c * HD, proj + (size_t)b * SEQ * NPROJ + V_OFF + c * HD,
                                    maskw + row0 * 64, mix8 + row0 * 2048 + 1024 + h * HD, 256 * (qb + 1), exp2f(-(float)(h + 1)) / att::SCALE, (char*)lds + RING_OFF);
                __syncthreads(); } }
    }
    if (IN(4)) { pg8::Gemm g{ygb, (const bf16*)(F.ws + WS_WGLU), M, SSMW, SSMW}; pg8::StaticOrder S; S.init(M, SSMW, F.G, (int)blockIdx.x);
        pg8::EpiGlu E{ygb, mix8, SSMW, 2048, F.in[I_BGLU], SC_MIX};
        pg8::gemm_phase<pg8::EpiGlu, pg8::StaticOrder, true, true>(F.lds + RING_OFF, g, S, E); } SEAM(4);
    if (IN(5)) { pg8::Gemm g{(const bf16*)mix8, (const bf16*)(F.ws + WS_WOUT), M, DM, 2048 / 2}; pg8::StaticOrder S; S.init(M, DM, F.G, (int)blockIdx.x);
        pg8::EpiRes<true, true> E{xb, F.out, DM, DN_ALPHA, 1.f / (SC_MIX * SC_WOUT)};
        pg8::gemm_phase<pg8::EpiRes<true, true>, pg8::StaticOrder, true, true, true>(F.lds + RING_OFF, g, S, E); } SEAM(5);
    if (IN(6)) { unsigned* q8 = (unsigned*)(F.ws + WS_MIX + 32 * MiB); const bf16* r1b = (const bf16*)F.out;
        f32x4 g8[8], b8[8];
#pragma unroll
        for (int j = 0; j < 8; ++j) { g8[j] = ((const f32x4*)(F.in[I_LN1G] + 32 * F.lane))[j]; b8[j] = ((const f32x4*)(F.in[I_LN1B] + 32 * F.lane))[j]; }
        for (int m = gw; m < M; m += 2 * NGW) { const int m2 = (m + NGW < M) ? m + NGW : m;
            ln_row2_mx6(r1b + (size_t)m * DM, r1b + (size_t)m2 * DM, g8, b8, F.lane, (unsigned char*)q8 + (size_t)m * DM, (unsigned char*)q8 + (size_t)m2 * DM,
                        (float2*)(F.ws + WS_RSTAT) + m, (float2*)(F.ws + WS_RSTAT) + m2); } } SEAM(6);
    if (IN(7)) { pg8::Gemm g{(const bf16*)(F.ws + WS_MIX + 32 * MiB), (const bf16*)(F.ws + WS_WUG), M, NUG, DM / 2}; pg8::StaticOrder S; S.init(M, NUG, F.G, (int)blockIdx.x);
        pg8::EpiFfn E{act8, (float*)(F.ws + WS_PEND_UP), (float*)(F.ws + WS_PEND_G), (float*)(F.ws + WS_HALO), F.in[I_CONVW], F.in[I_CONVB], DFF, 1.f, SC_ACT};
        pg8::gemm_phase<pg8::EpiFfn, pg8::StaticOrder, true, true, true, true>(F.lds + RING_OFF, g, S, E); } SEAM(7);
    if (IN(8)) { const float* pu = (const float*)(F.ws + WS_PEND_UP); const float* pg = (const float*)(F.ws + WS_PEND_G); const float* ph = (const float*)(F.ws + WS_HALO);
        const float* cw = F.in[I_CONVW]; const float* cb = F.in[I_CONVB];
        for (int idx = F.vcu * 512 + F.tid; idx < 512 * (DFF / 4); idx += F.G * 512) { const int r2 = idx / (DFF / 4), f = (idx % (DFF / 4)) * 4, rb = r2 >> 1, rho = r2 & 1; const bool first = (rb & 31) == 0;
            const f32x4 x0 = *(const f32x4*)(pu + (size_t)r2 * DFF + f), gt = *(const f32x4*)(pg + (size_t)r2 * DFF + f); const f32x4 z = {0.f, 0.f, 0.f, 0.f};
            f32x4 h1, h2;
            if (rho == 0) { h1 = first ? z : *(const f32x4*)(ph + (size_t)((rb - 1) * 2 + 1) * DFF + f); h2 = first ? z : *(const f32x4*)(ph + (size_t)((rb - 1) * 2) * DFF + f); }
            else { h1 = *(const f32x4*)(pu + (size_t)(rb * 2) * DFF + f); h2 = first ? z : *(const f32x4*)(ph + (size_t)((rb - 1) * 2 + 1) * DFF + f); }
            const f32x4 hc = *(const f32x4*)(cb + f) + *(const f32x4*)(cw + f) * h2 + *(const f32x4*)(cw + DFF + f) * h1 + *(const f32x4*)(cw + 2 * DFF + f) * x0;
            *(unsigned*)(act8 + (size_t)(rb * 64 + rho) * DFF + f) = pk4_fp8(gelu_erf(hc[0]) * gt[0] * SC_ACT, gelu_erf(hc[1]) * gt[1] * SC_ACT, gelu_erf(hc[2]) * gt[2] * SC_ACT, gelu_erf(hc[3]) * gt[3] * SC_ACT); } } SEAM(8);
    if (IN(9)) { pg8::Gemm g{(const bf16*)act8, (const bf16*)(F.ws + WS_WDOWN), M, DM, DFF / 2}; pg8::StaticOrder S; S.init(M, DM, F.G, (int)blockIdx.x);
        pg8::EpiDownLN E{(const bf16*)F.out, (bf16*)(F.ws + WS_MIX), (const pg8::f32x2*)(F.ws + WS_RSTAT), F.in[I_LN1G], F.in[I_LN1B], DM, DN_ALPHA, 1.f / (SC_ACT * SC_WDN)};
        pg8::gemm_phase<pg8::EpiDownLN, pg8::StaticOrder, true, true, true>(F.lds + RING_OFF, g, S, E); } SEAM(9);
    if (IN(10)) { const bf16* r2b = (const bf16*)(F.ws + WS_MIX);
        for (int m = gw; m < M; m += 2 * NGW) { const int m2 = (m + NGW < M) ? m + NGW : m;
            ln_row2<false, true>(r2b + (size_t)m * DM, r2b + (size_t)m2 * DM, F.out + (size_t)m * DM, F.out + (size_t)m2 * DM, F.in[I_LN2G], F.in[I_LN2B], F.lane); }
    }
#undef IN
#undef SEAM
}

#ifndef MK_ONE_LAUNCH
#define MK_ONE_LAUNCH 1
#endif
extern "C" void kernel_launch(void* const* d_in, const int* in_sizes, int n_in, void* d_out, int out_size, void* d_ws, size_t ws_size, hipStream_t stream) {
    static int grid = 0;
    if (grid == 0) {
        if (n_in != 22 || in_sizes[0] != M * DM || out_size != M * DM || ws_size < WS_END) { fprintf(stderr, "kernel_launch: shape/workspace mismatch (n_in %d, in0 %d, out %d, ws %zu, need %zu)\n", n_in, n_in > 0 ? in_sizes[0] : -1, out_size, ws_size, (size_t)WS_END); grid = -1; return; }
        int dev = 0, cus = 0, per_cu = 0;
        if (hipGetDevice(&dev) != hipSuccess || hipDeviceGetAttribute(&cus, hipDeviceAttributeMultiprocessorCount, dev) != hipSuccess) { grid = -1; return; }
        if (hipFuncSetAttribute((const void*)mk_fwd, hipFuncAttributeMaxDynamicSharedMemorySize, LDS_BYTES) != hipSuccess) { fprintf(stderr, "kernel_launch: hipFuncSetAttribute failed\n"); grid = -1; return; }
        if (hipOccupancyMaxActiveBlocksPerMultiprocessor(&per_cu, (const void*)mk_fwd, NWAVES * 64, LDS_BYTES) != hipSuccess || per_cu < 1) fprintf(stderr, "kernel_launch: occupancy query reports %d\n", per_cu);
        (void)hipGetLastError();
        grid = cus;
    }
    if (grid < 0) return;
    if (hipMemsetAsync((char*)d_ws + WS_CTL, 0, CTL_ZERO_BYTES, stream) != hipSuccess) return;
    Args a{};
    for (int i = 0; i < 22; ++i) a.in[i] = (const float*)d_in[i];
    a.out = (float*)d_out; a.ws = (unsigned char*)d_ws;
#if MK_ONE_LAUNCH
    a.ph_lo = 0; a.ph_hi = N_PHASES;
    hipLaunchKernelGGL(mk_fwd, dim3(grid), dim3(NWAVES * 64), LDS_BYTES, stream, a);
#else
    for (int p = 0; p < N_PHASES; ++p) { a.ph_lo = p; a.ph_hi = p + 1; hipLaunchKernelGGL(mk_fwd, dim3(grid), dim3(NWAVES * 64), LDS_BYTES, stream, a); }
#endif
}
```

```cpp
#include <hip/hip_runtime.h>
#include <cstdio>
#include <cstdint>
namespace pg8 {
#define PG8_LAS __attribute__((address_space(3)))
typedef unsigned short bf16_t;
typedef short bf16x8 __attribute__((ext_vector_type(8)));
typedef float f32x4 __attribute__((ext_vector_type(4)));
typedef unsigned u32x4 __attribute__((ext_vector_type(4)));
typedef int v8i32 __attribute__((ext_vector_type(8)));
constexpr int BM = 256, BK = 64, HALF = 128, HTB = HALF * BK * 2  , STAGE_BYTES = 8 * HTB, NXCD = 8, WGM = 8;

__host__ __device__ __forceinline__ int lds_byte(int r, int c) { const int st = (r >> 4) * 2 + (c >> 5), rr = r & 15, cc = c & 31, ob = rr * 64 + cc * 2; return st * 1024 + (ob ^ (((ob >> 9) & 1) << 5)); }
__host__ __device__ __forceinline__ void stage_rc(int b, int& R, int& C) { const int st = b / 1024, sb = b % 1024, swz = sb ^ (((sb >> 9) & 1) << 5); R = (st >> 1) * 16 + swz / 64; C = (st & 1) * 32 + (swz % 64) / 2; }
__host__ __device__ __forceinline__ int perm32(int rho) { const int n = rho >> 4, i = rho & 15; return 8 * (i >> 2) + 4 * n + (i & 3); }

struct Unit { int pm, pn; };
struct Gemm { const bf16_t* A; const bf16_t* Bt; int M, N, K; };

struct StaticOrder {
    int nM, nN, nwg, G, c;
    __host__ __device__ void init(int M, int N, int G_, int c_) { nM = M / BM; nN = N / BM; nwg = nM * nN; G = G_; c = c_; }
    __host__ __device__ bool next(int i, Unit& u) const {
        const long L = (long)i * G + c; if (L >= nwg) return false;
        int wgid = (int)L; { const int q = nwg / NXCD, r = nwg % NXCD, xcd = wgid % NXCD, off = wgid / NXCD; wgid = (xcd < r ? xcd * (q + 1) : r * (q + 1) + (xcd - r) * q) + off; }
        const int nig = WGM * nN, gid = wgid / nig, fm = gid * WGM, gsz = (nM - fm) < WGM ? (nM - fm) : WGM;
        u.pm = fm + ((wgid % nig) % gsz); u.pn = (wgid % nig) / gsz; return true;
    }
    __device__ __forceinline__ void a_ready(const Unit&) const {}
    __device__ __forceinline__ void done(const Unit&) const {}
};

struct ListOrder {
    int nM, nN, nwg, L0, dL, cnt;
    __host__ __device__ void init(int M, int N, int L0_, int dL_, int cnt_) { nM = M / BM; nN = N / BM; nwg = nM * nN; L0 = L0_; dL = dL_; cnt = cnt_; }
    __host__ __device__ bool next(int i, Unit& u) const {
        if (i >= cnt) return false; const int L = L0 + i * dL; if (L >= nwg) return false;
        int wgid = L; { const int q = nwg / NXCD, r = nwg % NXCD, xcd = wgid % NXCD, off = wgid / NXCD; wgid = (xcd < r ? xcd * (q + 1) : r * (q + 1) + (xcd - r) * q) + off; }
        const int nig = WGM * nN, gid = wgid / nig, fm = gid * WGM, gsz = (nM - fm) < WGM ? (nM - fm) : WGM;
        u.pm = fm + ((wgid % nig) % gsz); u.pn = (wgid % nig) / gsz; return true;
    }
    __device__ __forceinline__ void a_ready(const Unit&) const {}
    __device__ __forceinline__ void done(const Unit&) const {}
};

__device__ __forceinline__ unsigned cvt_pk_bf16(float lo, float hi) { unsigned r; asm volatile("v_cvt_pk_bf16_f32 %0, %1, %2" : "=v"(r) : "v"(lo), "v"(hi)); return r; }
typedef float f32x2 __attribute__((ext_vector_type(2)));
__device__ __forceinline__ f32x2 gelu_pk(f32x2 v) {
    f32x2 vc; vc.x = __builtin_amdgcn_fmed3f(v.x, -4.6f, 4.6f); vc.y = __builtin_amdgcn_fmed3f(v.y, -4.6f, 4.6f);
    const f32x2 w = vc * vc;
    f32x2 r = w * 7.3846917937e-14f + (-9.6073152826e-12f);
    r = r * w + 5.6255834838e-10f; r = r * w + (-1.9781858177e-08f); r = r * w + 4.7227388803e-07f; r = r * w + (-8.2408235147e-06f); r = r * w + 1.1056416036e-04f;
    r = r * w + (-1.1755027258e-03f); r = r * w + 9.9585457053e-03f; r = r * w + (-6.6482846440e-02f); r = r * w + 3.9894164923e-01f;
    return v * (vc * r + 0.5f);
}

template <int ACT  > struct EpiBf16 {
    static constexpr bool PERM = true, AFTER_DRAIN = false; static_assert(ACT == 0 || ACT == 1, "EpiBf16: ACT is 0 (none) or 1 (gelu_pk)");
    bf16_t* O; int ldc; const float* bias; int split_cols; size_t split_stride; float scale0;
    __device__ __forceinline__ void operator()(const f32x4 (&acc)[2][2][4][2], const Unit& u, int wr, int wc, int fr, int fq) const {
        const int row0 = u.pm * BM + wr * 64 + fr; int colt = u.pn * BM; bf16_t* base = O;
        float sc = 1.f; if (split_cols) { const int t = colt / split_cols; base += (size_t)t * split_stride; colt -= t * split_cols; if (t == 0) sc = scale0; }
        const int col0 = colt + wc * 32 + 8 * fq, bcol0 = u.pn * BM + wc * 32 + 8 * fq;
        f32x4 bv[2][2];
#pragma unroll
        for (int bj = 0; bj < 2; ++bj)
#pragma unroll
            for (int n = 0; n < 2; ++n) bv[bj][n] = bias ? *(const f32x4*)(bias + bcol0 + bj * HALF + 4 * n) : (f32x4){0.f, 0.f, 0.f, 0.f};
#pragma unroll
        for (int ai = 0; ai < 2; ++ai)
#pragma unroll
            for (int m = 0; m < 4; ++m) { bf16_t* rowp = base + (size_t)(row0 + ai * HALF + m * 16) * ldc + col0;
#pragma unroll
                for (int bj = 0; bj < 2; ++bj) { f32x4 v0 = acc[ai][bj][m][0] + bv[bj][0], v1 = acc[ai][bj][m][1] + bv[bj][1];
                    if (ACT == 1) { f32x2 a = gelu_pk((f32x2){v0[0], v0[1]}), b = gelu_pk((f32x2){v0[2], v0[3]}), c = gelu_pk((f32x2){v1[0], v1[1]}), d = gelu_pk((f32x2){v1[2], v1[3]});
                        v0 = (f32x4){a.x, a.y, b.x, b.y}; v1 = (f32x4){c.x, c.y, d.x, d.y}; }
                    v0 = v0 * sc; v1 = v1 * sc; u32x4 w; w.x = cvt_pk_bf16(v0[0], v0[1]); w.y = cvt_pk_bf16(v0[2], v0[3]); w.z = cvt_pk_bf16(v1[0], v1[1]); w.w = cvt_pk_bf16(v1[2], v1[3]);
                    *(u32x4*)(rowp + bj * HALF) = w; } }
    }
};

__device__ __forceinline__ float bf2f(unsigned short b) { return __uint_as_float(((unsigned)b) << 16); }
__device__ __forceinline__ float bflo(unsigned w) { return __uint_as_float(w << 16); }
__device__ __forceinline__ float bfhi(unsigned w) { return __uint_as_float(w & 0xffff0000u); }
__device__ __forceinline__ float dpp_ror1(float x) { return __builtin_bit_cast(float, __builtin_amdgcn_update_dpp(0, __builtin_bit_cast(int, x), 0x121, 0xf, 0xf, false)); }
__device__ __forceinline__ float dpp_ror2(float x) { return __builtin_bit_cast(float, __builtin_amdgcn_update_dpp(0, __builtin_bit_cast(int, x), 0x122, 0xf, 0xf, false)); }
__device__ __forceinline__ float clamp448(float v) { return __builtin_amdgcn_fmed3f(v, -448.f, 448.f); }
__device__ __forceinline__ unsigned pk4_fp8(float a, float b, float c, float d) {
    int w = 0; w = __builtin_amdgcn_cvt_pk_fp8_f32(clamp448(a), clamp448(b), w, false); w = __builtin_amdgcn_cvt_pk_fp8_f32(clamp448(c), clamp448(d), w, true); return (unsigned)w; }
__device__ __forceinline__ float sigmoidf_fast(float v) { return __builtin_amdgcn_rcpf(1.0f + __builtin_amdgcn_exp2f(-1.4426950408889634f * v)); }

struct EpiProj {
    static constexpr bool PERM = true, AFTER_DRAIN = false;
    bf16_t* O; int ldc; bf16_t* kipack; int kcol0; int seq; int col_off; float ascale;
    __device__ __forceinline__ void operator()(const f32x4 (&acc)[2][2][4][2], const Unit& u, int wr, int wc, int fr, int fq) const {
        const int row0 = u.pm * BM + wr * 64 + fr, col0 = col_off + u.pn * BM + wc * 32 + 8 * fq;
        const bool kt_tile = (col_off + u.pn * BM == kcol0) && (wc < 2);
#pragma unroll
        for (int ai = 0; ai < 2; ++ai)
#pragma unroll
            for (int m = 0; m < 4; ++m) { const int row = row0 + ai * HALF + m * 16; bf16_t* rowp = O + (size_t)row * ldc + col0;
#pragma unroll
                for (int bj = 0; bj < 2; ++bj) { const f32x4 v0 = acc[ai][bj][m][0] * ascale, v1 = acc[ai][bj][m][1] * ascale;
                    u32x4 w; w.x = cvt_pk_bf16(v0[0], v0[1]); w.y = cvt_pk_bf16(v0[2], v0[3]); w.z = cvt_pk_bf16(v1[0], v1[1]); w.w = cvt_pk_bf16(v1[2], v1[3]);
                    *(u32x4*)(rowp + bj * HALF) = w;
                    if (bj == 0 && kt_tile) { const int b = row / seq, t = row % seq, d0 = wc * 32 + 8 * fq;
                        *(u32x4*)(kipack + ((size_t)((b * (seq / 32) + (t >> 5)) * 4 + (d0 >> 4)) * 64 + (t & 31) + 32 * ((d0 >> 3) & 1)) * 8) = w; } } }
    }
};
struct EpiGlu {
    static constexpr bool PERM = true, AFTER_DRAIN = false;
    const bf16_t* yg; unsigned char* O; int ldy, ldo; const float* bias; float oscale;
    __device__ __forceinline__ void operator()(const f32x4 (&acc)[2][2][4][2], const Unit& u, int wr, int wc, int fr, int fq) const {
        const int row0 = u.pm * BM + wr * 64 + fr, col0 = u.pn * BM + wc * 32 + 8 * fq;
        f32x4 bv[2][2];
#pragma unroll
        for (int bj = 0; bj < 2; ++bj)
#pragma unroll
            for (int n = 0; n < 2; ++n) bv[bj][n] = *(const f32x4*)(bias + col0 + bj * HALF + 4 * n);
#pragma unroll
        for (int ai = 0; ai < 2; ++ai)
#pragma unroll
            for (int m = 0; m < 4; ++m) { const size_t row = (size_t)(row0 + ai * HALF + m * 16);
#pragma unroll
                for (int bj = 0; bj < 2; ++bj) { const int c = col0 + bj * HALF;
                    const u32x4 yv = *(const u32x4*)(yg + row * ldy + c);
                    const f32x4 v0 = acc[ai][bj][m][0] + bv[bj][0], v1 = acc[ai][bj][m][1] + bv[bj][1];
                    float o[8];
                    o[0] = bflo(yv.x) * sigmoidf_fast(v0[0]); o[1] = bfhi(yv.x) * sigmoidf_fast(v0[1]); o[2] = bflo(yv.y) * sigmoidf_fast(v0[2]); o[3] = bfhi(yv.y) * sigmoidf_fast(v0[3]);
                    o[4] = bflo(yv.z) * sigmoidf_fast(v1[0]); o[5] = bfhi(yv.z) * sigmoidf_fast(v1[1]); o[6] = bflo(yv.w) * sigmoidf_fast(v1[2]); o[7] = bfhi(yv.w) * sigmoidf_fast(v1[3]);
                    typedef unsigned u32x2v __attribute__((ext_vector_type(2))); const float os = oscale;
                    u32x2v w; w.x = pk4_fp8(o[0] * os, o[1] * os, o[2] * os, o[3] * os); w.y = pk4_fp8(o[4] * os, o[5] * os, o[6] * os, o[7] * os);
                    *(u32x2v*)(O + row * ldo + c) = w; } }
    }
};
template <bool RES_BF16, bool OUT_BF16 = false> struct EpiRes {
    static constexpr bool PERM = false, AFTER_DRAIN = false;
    const void* res; float* out; int ldc; float alpha; float ascale;
    __device__ __forceinline__ void operator()(const f32x4 (&acc)[2][2][4][2], const Unit& u, int wr, int wc, int fr, int fq) const {
        typedef unsigned u32x2v __attribute__((ext_vector_type(2)));
        const int row0 = u.pm * BM + wr * 64 + fr, col0 = u.pn * BM + wc * 32 + 4 * fq;
#pragma unroll
        for (int ai = 0; ai < 2; ++ai)
#pragma unroll
            for (int m = 0; m < 4; ++m) { const size_t off = (size_t)(row0 + ai * HALF + m * 16) * ldc + col0;
#pragma unroll
                for (int bj = 0; bj < 2; ++bj)
#pragma unroll
                    for (int n = 0; n < 2; ++n) { const size_t o2 = off + bj * HALF + n * 16; f32x4 r;
                        if constexpr (RES_BF16) { const u32x2v w = *(const u32x2v*)((const bf16_t*)res + o2); r = (f32x4){bflo(w.x), bfhi(w.x), bflo(w.y), bfhi(w.y)}; }
                        else r = *(const f32x4*)((const float*)res + o2);
                        const f32x4 o = r * alpha + acc[ai][bj][m][n] * ascale;
                        if constexpr (OUT_BF16) { u32x2v w; w.x = cvt_pk_bf16(o[0], o[1]); w.y = cvt_pk_bf16(o[2], o[3]); *(u32x2v*)((bf16_t*)out + o2) = w; }
                        else *(f32x4*)(out + o2) = o; } }
    }
};
struct EpiDownLN {
    static constexpr bool PERM = false, AFTER_DRAIN = false;
    const bf16_t* r1; bf16_t* out; const f32x2* rstat; const float* gam; const float* bet; int ldc; float alpha, ascale;
    __device__ __forceinline__ void operator()(const f32x4 (&acc)[2][2][4][2], const Unit& u, int wr, int wc, int fr, int fq) const {
        typedef unsigned u32x2v __attribute__((ext_vector_type(2)));
        const int row0 = u.pm * BM + wr * 64 + fr, col0 = u.pn * BM + wc * 32 + 4 * fq;
        f32x4 gv[2][2], bv[2][2];
#pragma unroll
        for (int bj = 0; bj < 2; ++bj)
#pragma unroll
            for (int n = 0; n < 2; ++n) { gv[bj][n] = *(const f32x4*)(gam + col0 + bj * HALF + n * 16) * alpha; bv[bj][n] = *(const f32x4*)(bet + col0 + bj * HALF + n * 16) * alpha; }
#pragma unroll
        for (int ai = 0; ai < 2; ++ai)
#pragma unroll
            for (int m = 0; m < 4; ++m) { const int row = row0 + ai * HALF + m * 16; const f32x2 st = rstat[row]; const size_t off = (size_t)row * ldc + col0;
#pragma unroll
                for (int bj = 0; bj < 2; ++bj)
#pragma unroll
                    for (int n = 0; n < 2; ++n) { const size_t o2 = off + bj * HALF + n * 16; const u32x2v w0 = *(const u32x2v*)(r1 + o2);
                        const f32x4 r = {bflo(w0.x), bfhi(w0.x), bflo(w0.y), bfhi(w0.y)};
                        const f32x4 o = (r - st.x) * st.y * gv[bj][n] + bv[bj][n] + acc[ai][bj][m][n] * ascale;
                        u32x2v w; w.x = cvt_pk_bf16(o[0], o[1]); w.y = cvt_pk_bf16(o[2], o[3]); *(u32x2v*)(out + o2) = w; } }
    }
};
struct EpiFfn {
    static constexpr bool PERM = true, AFTER_DRAIN = false;
    unsigned char* act; float* pend_up; float* pend_gate; float* halo_up; const float* cw; const float* cb; int ldc; float ascale, oscale;
    __device__ __forceinline__ void operator()(const f32x4 (&acc)[2][2][4][2], const Unit& u, int wr, int wc, int fr, int fq) const {
        const int f0 = u.pn * HALF + wc * 32 + 8 * fq;
        float c0[8], c1[8], c2[8], cbv[8];
        { const f32x4 a0 = *(const f32x4*)(cw + f0), a1 = *(const f32x4*)(cw + f0 + 4), b0 = *(const f32x4*)(cw + ldc + f0), b1 = *(const f32x4*)(cw + ldc + f0 + 4);
          const f32x4 d0 = *(const f32x4*)(cw + 2 * ldc + f0), d1 = *(const f32x4*)(cw + 2 * ldc + f0 + 4), e0 = *(const f32x4*)(cb + f0), e1 = *(const f32x4*)(cb + f0 + 4);
#pragma unroll
          for (int j = 0; j < 4; ++j) { c0[j] = a0[j] * ascale; c0[4 + j] = a1[j] * ascale; c1[j] = b0[j] * ascale; c1[4 + j] = b1[j] * ascale; c2[j] = d0[j] * ascale; c2[4 + j] = d1[j] * ascale; cbv[j] = e0[j]; cbv[4 + j] = e1[j]; } }
        const float gs = ascale * oscale;
#pragma unroll
        for (int ai = 0; ai < 2; ++ai) {
            const int rb = u.pm * 4 + ai * 2 + wr;
#pragma unroll
            for (int m = 0; m < 4; ++m) {
                const size_t row = (size_t)(rb * 64 + m * 16 + fr);
                float a[8];
#pragma unroll
                for (int n = 0; n < 2; ++n)
#pragma unroll
                    for (int j = 0; j < 4; ++j) { const int e = 4 * n + j;
                        const float x0 = acc[ai][0][m][n][j];
                        float h1 = dpp_ror1(x0), h2 = dpp_ror2(x0);
                        if (m > 0) { const float xm = acc[ai][0][m - 1][n][j]; const float q1 = dpp_ror1(xm), q2 = dpp_ror2(xm); h1 = fr >= 1 ? h1 : q1; h2 = fr >= 2 ? h2 : q2; }
                        a[e] = cbv[e] + c0[e] * h2 + c1[e] * h1 + c2[e] * x0; }
                const f32x2 g0 = gelu_pk((f32x2){a[0], a[1]}), g1 = gelu_pk((f32x2){a[2], a[3]}), g2 = gelu_pk((f32x2){a[4], a[5]}), g3 = gelu_pk((f32x2){a[6], a[7]});
                const f32x4 gr0 = acc[ai][1][m][0], gr1 = acc[ai][1][m][1];
                const f32x2 o0 = g0 * (f32x2){gr0[0], gr0[1]} * gs, o1 = g1 * (f32x2){gr0[2], gr0[3]} * gs, o2 = g2 * (f32x2){gr1[0], gr1[1]} * gs, o3 = g3 * (f32x2){gr1[2], gr1[3]} * gs;
                typedef unsigned u32x2v __attribute__((ext_vector_type(2)));
                u32x2v w; w.x = pk4_fp8(o0.x, o0.y, o1.x, o1.y); w.y = pk4_fp8(o2.x, o2.y, o3.x, o3.y);
                if (m == 0) {
                    if (fr >= 2) *(u32x2v*)(act + row * ldc + f0) = w;
                    else { float* pu = pend_up + (size_t)(rb * 2 + fr) * ldc + f0; float* pg = pend_gate + (size_t)(rb * 2 + fr) * ldc + f0;
                        *(f32x4*)pu = acc[ai][0][m][0] * ascale; *(f32x4*)(pu + 4) = acc[ai][0][m][1] * ascale; *(f32x4*)pg = gr0 * ascale; *(f32x4*)(pg + 4) = gr1 * ascale; }
                } else {
                    *(u32x2v*)(act + row * ldc + f0) = w;
                    if (m == 3 && fr >= 14) { float* ph = halo_up + (size_t)(rb * 2 + (fr - 14)) * ldc + f0; *(f32x4*)ph = acc[ai][0][m][0] * ascale; *(f32x4*)(ph + 4) = acc[ai][0][m][1] * ascale; }
                }
            }
        }
    }
};
template <class Epi, class Sched, bool ALIGN_EPI = false, bool SP2 = false, bool F8 = false, bool F6 = false>
__device__ __forceinline__ void gemm_phase(PG8_LAS unsigned char* lds, const Gemm g, const Sched& S, const Epi& E) {
    const int tid = threadIdx.x, wid = __builtin_amdgcn_readfirstlane(tid >> 6), lane = tid & 63, wr = wid >> 2, wc = wid & 3, fr = lane & 15, fq = lane >> 4;
    const int K = g.K, nt = K / BK;
    unsigned voffA[2], voffB[2];
#pragma unroll
    for (int i = 0; i < 2; ++i) { int R, C; stage_rc(tid * 16 + i * 8192, R, C); const int Rb = Epi::PERM ? ((R & ~31) + perm32(R & 31)) : R;
        voffA[i] = (unsigned)(R * K + C) * 2u; voffB[i] = (unsigned)(Rb * K + C) * 2u; }
    const size_t kstep = (size_t)(BK * 2);
    const size_t hstep = (size_t)HALF * K * 2;
    const size_t tstep = 2 * hstep;
    const unsigned ldsb0 = __builtin_amdgcn_readfirstlane((unsigned)(size_t)lds) + (unsigned)wid * 1024u;
    const unsigned ldsw = (unsigned)wid * 1024u;
    const int aoff = lds_byte(wr * 64 + fr, fq * 8), boff = lds_byte(wc * 32 + fr, fq * 8);
#define PG8_SA(b, h) (((b) * 2 + (h)) * HTB)
#define PG8_SB(b, h) ((4 + (b) * 2 + (h)) * HTB)
#define PG8_STAGE(bufoff, gbase, voff) do { _Pragma("unroll") for (int _i = 0; _i < 2; ++_i) { \
        const unsigned m0_ = ldsb0 + (unsigned)((bufoff) + _i * 8192); const char* gb_ = (const char*)(gbase); \
        asm volatile("s_mov_b32 m0, %2\n\ts_nop 0\n\tglobal_load_lds_dwordx4 %0, %1" :: "v"((voff)[_i]), "s"(gb_), "s"(m0_) : "memory"); } } while (0)
#define PG8_LDA(dst, b, h) do { _Pragma("unroll") for (int m = 0; m < 4; ++m) _Pragma("unroll") for (int k = 0; k < 2; ++k) dst[m][k] = *(const PG8_LAS bf16x8*)(lds + PG8_SA(b, h) + aoff + m * 2048 + k * 1024); } while (0)
#define PG8_LDB(dst, b, h) do { _Pragma("unroll") for (int n = 0; n < 2; ++n) _Pragma("unroll") for (int k = 0; k < 2; ++k) dst[n][k] = *(const PG8_LAS bf16x8*)(lds + PG8_SB(b, h) + boff + n * 2048 + k * 1024); } while (0)
#define PG8_CAT(lo, hi) __builtin_bit_cast(v8i32, __builtin_shufflevector(lo, hi, 0, 1, 2, 3, 4, 5, 6, 7, 8, 9, 10, 11, 12, 13, 14, 15))
#define PG8_MMA(ai, bj, At, Bt) do { __builtin_amdgcn_s_setprio(1); _Pragma("unroll") for (int m = 0; m < 4; ++m) _Pragma("unroll") for (int n = 0; n < 2; ++n) { \
        if constexpr (F8 && F6) { const v8i32 cb_ = PG8_CAT(Bt[n][0], Bt[n][1]), ca_ = PG8_CAT(At[m][0], At[m][1]); \
            asm volatile("s_nop 3\n\tv_mfma_scale_f32_16x16x128_f8f6f4 %0, %1, %2, %0, %3, %4 op_sel_hi:[0,0,0] cbsz:2 blgp:2" : "+v"(acc[ai][bj][m][n]) \
                         : "v"(__builtin_shufflevector(cb_, cb_, 0, 1, 2, 3, 4, 5)), "v"(__builtin_shufflevector(ca_, ca_, 0, 1, 2, 3, 4, 5)), "v"(cb_[6]), "v"(ca_[6])); } \
        else if constexpr (F8) asm volatile("v_mfma_scale_f32_16x16x128_f8f6f4 %0, %1, %2, %0, %3, %3 op_sel_hi:[0,0,0]" : "+v"(acc[ai][bj][m][n]) : "v"(PG8_CAT(Bt[n][0], Bt[n][1])), "v"(PG8_CAT(At[m][0], At[m][1])), "v"(f8scale)); \
        else { _Pragma("unroll") for (int k = 0; k < 2; ++k) acc[ai][bj][m][n] = __builtin_amdgcn_mfma_f32_16x16x32_bf16(Bt[n][k], At[m][k], acc[ai][bj][m][n], 0, 0, 0); } } __builtin_amdgcn_s_setprio(0); } while (0)
#define PG8_WAIT_V(n) asm volatile("s_waitcnt vmcnt(" #n ")" ::: "memory")
#define PG8_WAIT_L(n) asm volatile("s_waitcnt lgkmcnt(" #n ")" ::: "memory")
#define PG8_BAR __builtin_amdgcn_s_barrier()
#define PG8_SCHED __builtin_amdgcn_sched_barrier(0)
    Unit cur, nxt; int ui = 0;
    if (!S.next(0, cur)) return;
    const int f8scale = 0x7F7F7F7F;
    f32x4 acc[2][2][4][2];
#pragma unroll
    for (int a = 0; a < 2; ++a)
#pragma unroll
        for (int b = 0; b < 2; ++b)
#pragma unroll
            for (int m = 0; m < 4; ++m)
#pragma unroll
                for (int n = 0; n < 2; ++n) acc[a][b][m][n] = (f32x4){0.f, 0.f, 0.f, 0.f};
    bf16x8 At[4][2], B0[2][2], B1[2][2];
    const char* cA = (const char*)g.A + (size_t)cur.pm * tstep; const char* cB = (const char*)g.Bt + (size_t)cur.pn * tstep;
    S.a_ready(cur);
    if constexpr (SP2) {
        PG8_STAGE(PG8_SB(0, 0), cB, voffB); PG8_STAGE(PG8_SB(0, 1), cB + hstep, voffB); PG8_STAGE(PG8_SA(0, 0), cA, voffA); PG8_STAGE(PG8_SA(0, 1), cA + hstep, voffA);
        if (wr == 1) PG8_BAR;
        PG8_WAIT_V(2); PG8_BAR;
        PG8_STAGE(PG8_SB(1, 0), cB + kstep, voffB); PG8_STAGE(PG8_SA(1, 0), cA + kstep, voffA); PG8_STAGE(PG8_SB(1, 1), cB + hstep + kstep, voffB);
        PG8_WAIT_V(6); PG8_BAR;
    } else {
        PG8_STAGE(PG8_SB(0, 0), cB, voffB); PG8_STAGE(PG8_SA(0, 0), cA, voffA); PG8_STAGE(PG8_SB(0, 1), cB + hstep, voffB); PG8_STAGE(PG8_SA(0, 1), cA + hstep, voffA);
        if (wr == 1) PG8_BAR;
        PG8_WAIT_V(4); PG8_BAR;
        PG8_STAGE(PG8_SB(1, 0), cB + kstep, voffB); PG8_STAGE(PG8_SA(1, 0), cA + kstep, voffA); PG8_STAGE(PG8_SB(1, 1), cB + hstep + kstep, voffB);
        PG8_WAIT_V(6); PG8_BAR;
    }
    for (;;) {
        const bool has_next = S.next(ui + 1, nxt);
        const char* nA = has_next ? (const char*)g.A + (size_t)nxt.pm * tstep : cA; const char* nB = has_next ? (const char*)g.Bt + (size_t)nxt.pn * tstep : cB;
        for (int t = 0; t < nt; t += 2) {
            const bool last = (t == nt - 2);
            const char* a1 = cA + (size_t)(t + 1) * kstep;
            const char* a2 = last ? nA : cA + (size_t)(t + 2) * kstep; const char* b2 = last ? nB : cB + (size_t)(t + 2) * kstep;
            const char* a3 = a2 + kstep; const char* b3 = b2 + kstep;
            if (last && has_next) S.a_ready(nxt);
            if constexpr (SP2) {
            PG8_LDB(B0, 0, 0); PG8_LDB(B1, 0, 1); PG8_SCHED; PG8_LDA(At, 0, 0); PG8_STAGE(PG8_SA(1, 1), a1 + hstep, voffA);
            PG8_WAIT_V(8); PG8_WAIT_L(0); PG8_BAR; PG8_MMA(0, 0, At, B0); PG8_MMA(0, 1, At, B1); PG8_BAR; PG8_SCHED;
            PG8_LDA(At, 0, 1); PG8_STAGE(PG8_SB(0, 0), b2, voffB); PG8_STAGE(PG8_SB(0, 1), b2 + hstep, voffB); PG8_STAGE(PG8_SA(0, 0), a2, voffA);
            PG8_WAIT_V(8); PG8_WAIT_L(0); PG8_BAR; PG8_MMA(1, 0, At, B0); PG8_MMA(1, 1, At, B1); PG8_BAR; PG8_SCHED;
            PG8_LDB(B0, 1, 0); PG8_LDB(B1, 1, 1); PG8_SCHED; PG8_LDA(At, 1, 0); PG8_STAGE(PG8_SA(0, 1), a2 + hstep, voffA);
            PG8_WAIT_V(8); PG8_WAIT_L(0); PG8_BAR; PG8_MMA(0, 0, At, B0); PG8_MMA(0, 1, At, B1); PG8_BAR; PG8_SCHED;
            PG8_LDA(At, 1, 1); PG8_STAGE(PG8_SB(1, 0), b3, voffB); PG8_STAGE(PG8_SB(1, 1), b3 + hstep, voffB); PG8_STAGE(PG8_SA(1, 0), a3, voffA);
            PG8_WAIT_V(8); PG8_WAIT_L(0); PG8_BAR; PG8_MMA(1, 0, At, B0); PG8_MMA(1, 1, At, B1); PG8_BAR; PG8_SCHED;
            } else {
            PG8_LDB(B0, 0, 0); PG8_SCHED; PG8_LDA(At, 0, 0); PG8_STAGE(PG8_SA(1, 1), a1 + hstep, voffA);
            PG8_WAIT_L(8); PG8_BAR; PG8_WAIT_L(0); PG8_MMA(0, 0, At, B0); PG8_BAR; PG8_SCHED;
            PG8_LDB(B1, 0, 1); PG8_STAGE(PG8_SB(0, 0), b2, voffB);
            PG8_BAR; PG8_WAIT_L(0); PG8_MMA(0, 1, At, B1); PG8_BAR;
            PG8_LDA(At, 0, 1); PG8_STAGE(PG8_SA(0, 0), a2, voffA);
            PG8_BAR; PG8_WAIT_L(0); PG8_MMA(1, 0, At, B0); PG8_BAR; PG8_SCHED;
            PG8_STAGE(PG8_SB(0, 1), b2 + hstep, voffB);
            PG8_WAIT_V(6); PG8_BAR; PG8_MMA(1, 1, At, B1); PG8_BAR;
            PG8_LDB(B0, 1, 0); PG8_SCHED; PG8_LDA(At, 1, 0); PG8_STAGE(PG8_SA(0, 1), a2 + hstep, voffA);
            PG8_WAIT_L(8); PG8_BAR; PG8_WAIT_L(0); PG8_MMA(0, 0, At, B0); PG8_BAR; PG8_SCHED;
            PG8_LDB(B1, 1, 1); PG8_STAGE(PG8_SB(1, 0), b3, voffB);
            PG8_BAR; PG8_WAIT_L(0); PG8_MMA(0, 1, At, B1); PG8_BAR;
            PG8_LDA(At, 1, 1); PG8_STAGE(PG8_SA(1, 0), a3, voffA);
            PG8_BAR; PG8_WAIT_L(0); PG8_MMA(1, 0, At, B0); PG8_BAR; PG8_SCHED;
            PG8_STAGE(PG8_SB(1, 1), b3 + hstep, voffB);
            PG8_WAIT_V(6); PG8_BAR; PG8_MMA(1, 1, At, B1); PG8_BAR;
            }
        }
        if constexpr (ALIGN_EPI) { if (wr == 0) PG8_BAR; }
        if constexpr (F8) asm volatile("s_nop 15\n\ts_nop 15" ::: "memory");
        if constexpr (!Epi::AFTER_DRAIN) { E(acc, cur, wr, wc, fr, fq); S.done(cur); }
        if (!has_next) break;
#pragma unroll
        for (int a = 0; a < 2; ++a)
#pragma unroll
            for (int b = 0; b < 2; ++b)
#pragma unroll
                for (int m = 0; m < 4; ++m)
#pragma unroll
                    for (int n = 0; n < 2; ++n) acc[a][b][m][n] = (f32x4){0.f, 0.f, 0.f, 0.f};
        cur = nxt; cA = nA; cB = nB; ++ui;
        if constexpr (ALIGN_EPI) { if (wr == 1) PG8_BAR; }
    }
    PG8_WAIT_V(0);
    if constexpr (!ALIGN_EPI) { if (wr == 0) PG8_BAR; }
    PG8_BAR;
    if constexpr (Epi::AFTER_DRAIN) { E.fused(acc, cur, wr, wc, fr, fq, lds, wid, lane); S.done(cur); }
#undef PG8_SA
#undef PG8_SB
#undef PG8_STAGE
#undef PG8_LDA
#undef PG8_LDB
#undef PG8_MMA
#undef PG8_CAT
#undef PG8_WAIT_V
#undef PG8_WAIT_L
#undef PG8_BAR
#undef PG8_SCHED
}
}

constexpr int NWAVES = 8;
constexpr int NB = 8, SEQ = 2048, DM = 2048, M = NB * SEQ;
constexpr int N_IN = 3664, NPROJ = 3840, NP8 = 2560;
constexpr int U_OFF = 0, Q_OFF = 1024, K_OFF = 2048, V_OFF = 2304, QI_OFF = 2560, KI_OFF = 3584, WI_OFF = 3648;
constexpr int SSMW = 1024, NG = 64, GCH = 16, NST = 64;
constexpr int NH = 8, HD = 128, NKV = 2, NIH = 16, IDIM = 64, TOPK = 256;
constexpr int DFF = 5632, NUG = 2 * DFF;
constexpr float LN_EPS = 1e-5f;
constexpr float DN_ALPHA = 1.189207115002721f;
constexpr float IDX_W_SCALE = 0.03125f;
constexpr float ATT_SCALE = 0.08838834764831845f;
constexpr float SC_H1 = 32.f, SC_WUG = 2048.f, SC_ACT = 8.f, SC_WDN = 4096.f, SC_MIX = 8.f, SC_WOUT = 4096.f, SC_X = 32.f, SC_WIN = 2048.f;

constexpr size_t MiB = 1u << 20;
constexpr size_t WS_CTL = 0, CTL_ZERO_BYTES = 1 * MiB;
constexpr size_t WS_WIN = 2 * MiB, WS_WGLU = 17 * MiB, WS_WOUT = 19 * MiB, WS_WUG = 27 * MiB, WS_WDOWN = 71 * MiB;
constexpr size_t WS_TABA = 93 * MiB, WS_TABB = 93 * MiB + 65536;
constexpr size_t WS_TABINV = 94 * MiB, WS_TABW = 95 * MiB, WS_CA = 96 * MiB, WS_BCAT = 96 * MiB + 524288, WS_TABA32 = 96 * MiB + 786432;
constexpr size_t WS_KIPACK = 97 * MiB;
constexpr size_t WS_MASK = 100 * MiB;
constexpr size_t WS_XB = 104 * MiB;
constexpr size_t WS_MIX = 168 * MiB;
constexpr size_t WS_PROJ = 232 * MiB;
constexpr size_t WS_YG = 352 * MiB;
constexpr size_t WS_ACT = 232 * MiB;
constexpr size_t WS_PEND_UP = 408 * MiB, WS_PEND_G = 420 * MiB, WS_HALO = 432 * MiB, WS_WIN8 = 444 * MiB, WS_RSTAT = 450 * MiB, WS_END = 451 * MiB;
static_assert(WS_WIN + (size_t)NPROJ * DM * 2 <= WS_WGLU && WS_WUG + (size_t)NUG * DM * 2 <= WS_WDOWN && WS_WDOWN + (size_t)DM * DFF * 2 <= WS_TABA, "ws map");
static_assert(WS_PROJ + (size_t)M * NPROJ * 2 <= WS_YG && WS_YG + (size_t)M * SSMW * 2 <= WS_PEND_UP && WS_ACT + (size_t)M * DFF * 2 <= WS_PEND_UP && (size_t)512 * DFF * 4 <= 12 * MiB && WS_WIN8 + (size_t)NP8 * DM <= WS_RSTAT && WS_RSTAT + (size_t)M * 8 <= WS_END, "ws map 2");
constexpr int CW_BAR = 4096;

constexpr int RING_OFF = 0, RING_BYTES = 131072;
constexpr int LDS_BYTES = 163840;
constexpr int LDSCTL_OFF = LDS_BYTES - 1024, MISC_OFF = LDSCTL_OFF + 320;

#define GAS __attribute__((address_space(1)))
#define LAS __attribute__((address_space(3)))
typedef unsigned short bf16;
typedef unsigned v4u __attribute__((ext_vector_type(4)));
typedef unsigned v2u __attribute__((ext_vector_type(2)));
typedef float f32x4 __attribute__((ext_vector_type(4)));
typedef float fl4 __attribute__((ext_vector_type(4)));
#define LDS_WAIT() asm volatile("s_waitcnt lgkmcnt(0)" ::: "memory")
#define VM_WAIT() asm volatile("s_waitcnt vmcnt(0)" ::: "memory")
__device__ __forceinline__ unsigned f2bf(float f) { unsigned u = __builtin_bit_cast(unsigned, f); return (u + 0x7fffu + ((u >> 16) & 1u)) >> 16; }
__device__ __forceinline__ unsigned pk2(float lo, float hi) { return f2bf(lo) | (f2bf(hi) << 16); }
__device__ __forceinline__ float bflo(unsigned w) { return __uint_as_float(w << 16); }
__device__ __forceinline__ float bfhi(unsigned w) { return __uint_as_float(w & 0xffff0000u); }
__device__ __forceinline__ float bf2f(bf16 b) { return __uint_as_float(((unsigned)b) << 16); }
__device__ __forceinline__ unsigned pk4_fp8(float a, float b, float c, float d) {
    int w = 0; w = __builtin_amdgcn_cvt_pk_fp8_f32(__builtin_amdgcn_fmed3f(a, -448.f, 448.f), __builtin_amdgcn_fmed3f(b, -448.f, 448.f), w, false);
    w = __builtin_amdgcn_cvt_pk_fp8_f32(__builtin_amdgcn_fmed3f(c, -448.f, 448.f), __builtin_amdgcn_fmed3f(d, -448.f, 448.f), w, true); return (unsigned)w; }
#define XB_TMO      128
#define XB_XCNT(j)  (256  + 64 * (j))
#define XB_XSUB(j)  (1280 + 64 * (j))
#define XB_XGEN(j)  (2304 + 64 * (j))
#define XB_TOP      3328
#define XB_TOPGEN   3392
#define XCD_BAR_WORDS 3456
#define XB_SPIN_CAP (1u << 18)

__device__ __forceinline__ unsigned xb_ld(unsigned* p)              { return __hip_atomic_load(p, __ATOMIC_RELAXED, __HIP_MEMORY_SCOPE_AGENT); }
__device__ __forceinline__ unsigned xb_add(unsigned* p, unsigned v) { return __hip_atomic_fetch_add(p, v, __ATOMIC_RELAXED, __HIP_MEMORY_SCOPE_AGENT); }
__device__ __forceinline__ unsigned xb_xcc_id() { return (unsigned)__builtin_amdgcn_s_getreg((3 << 11) | 20) & 0xFu; }
#define XB_SPIN(cond, bar) do { unsigned _sp = 0; while (cond) { __builtin_amdgcn_s_sleep(1); \
    if ((++_sp & 255u) == 0u) { if (xb_ld(&(bar)[XB_TMO])) break; if (_sp > XB_SPIN_CAP) { atomicAdd(&(bar)[XB_TMO], 1u); break; } } } } while (0)

struct XcdBarrier {
    unsigned* bar; unsigned x;
    volatile LAS unsigned* st;
};

__device__ __forceinline__ XcdBarrier xcd_barrier_post(unsigned* bar, volatile LAS unsigned* st) {
    XcdBarrier b; b.bar = bar; b.x = xb_xcc_id(); b.st = st;
    if (threadIdx.x == 0) (void)xb_add(&bar[XB_XCNT(b.x)], 1u);
    return b;
}
__device__ __forceinline__ void xcd_barrier_complete(unsigned* bar, unsigned x, unsigned& nloc, unsigned& nx) {
    const unsigned G = gridDim.x * gridDim.y * gridDim.z;
    unsigned sum, cnt, mine, sp = 0u;
    for (;;) {
        sum = 0u; cnt = 0u; mine = 0u;
#pragma unroll
        for (unsigned j = 0; j < 16; ++j) { const unsigned c = xb_ld(&bar[XB_XCNT(j)]); sum += c; cnt += (c > 0u) ? 1u : 0u; mine = (j == x) ? c : mine; }
        if (sum == G) break;
        __builtin_amdgcn_s_sleep(1);
        if ((++sp & 255u) == 0u) { if (xb_ld(&bar[XB_TMO])) break; if (sp > XB_SPIN_CAP) { atomicAdd(&bar[XB_TMO], 1u); break; } }
    }
    nloc = mine > 0u ? mine : 1u; nx = cnt > 0u ? cnt : 1u;
}

__device__ __forceinline__ void xcd_barrier(const XcdBarrier& b) {
    asm volatile("s_waitcnt vmcnt(0)" ::: "memory");
    __syncthreads();
    if (threadIdx.x == 0) {
        unsigned* bar = b.bar;
        __builtin_amdgcn_s_waitcnt(0);
        unsigned nloc = b.st[0], nx = b.st[1];
        if (nloc == 0u) { xcd_barrier_complete(bar, b.x, nloc, nx); b.st[0] = nloc; b.st[1] = nx; }
        const unsigned old = xb_add(&bar[XB_XSUB(b.x)], 1u);
        const unsigned gen = old / nloc;
        if (old + 1u == (gen + 1u) * nloc) {
            __builtin_amdgcn_fence(__ATOMIC_RELEASE, "agent");
            asm volatile("s_waitcnt vmcnt(0)" ::: "memory");
            const unsigned og = xb_add(&bar[XB_TOP], 1u);
            const unsigned tg = og / nx;
            if (og + 1u == (tg + 1u) * nx) xb_add(&bar[XB_TOPGEN], 1u);
            else XB_SPIN(xb_ld(&bar[XB_TOPGEN]) == tg, bar);
            __builtin_amdgcn_fence(__ATOMIC_ACQUIRE, "agent");
            xb_add(&bar[XB_XGEN(b.x)], 1u);
            asm volatile("s_waitcnt vmcnt(0)" ::: "memory");
        } else {
            XB_SPIN(xb_ld(&bar[XB_XGEN(b.x)]) == gen, bar);
            __builtin_amdgcn_fence(__ATOMIC_ACQUIRE, "agent");
            asm volatile("s_waitcnt vmcnt(0)" ::: "memory");
        }
    }
    __syncthreads();
}

struct Frame {
    LAS unsigned char* lds;
    volatile LAS unsigned* MISC;
    unsigned* ctl;
    int tid, lane, wave, vcu, G;
    const float* in[22]; float* out; unsigned char* ws;
};
enum { I_X = 0, I_WIN, I_ARE, I_AIM, I_LOGDT, I_BRE, I_BIM, I_CRE, I_CIM, I_D, I_WGLU, I_BGLU, I_WOUT, I_LN1G, I_LN1B, I_WUP, I_WGATE, I_CONVW, I_CONVB, I_WDOWN, I_LN2G, I_LN2B };

__device__ __forceinline__ float wave_sum(float v) {
#pragma unroll
    for (int o = 1; o < 64; o <<= 1) v += __shfl_xor(v, o);
    return v;
}

typedef float v16f32 __attribute__((ext_vector_type(16)));
typedef unsigned v6u32 __attribute__((ext_vector_type(6)));
__device__ __forceinline__ void mx6_store_block(unsigned char* row, int b, v16f32 x, v16f32 y, float amax) {
    unsigned E = __float_as_uint(amax) >> 23; E = E < 3u ? 3u : E;
    const unsigned sb = E - 2u; const float inv = __uint_as_float((254u - sb) << 23);
    const v6u32 r = __builtin_amdgcn_cvt_scalef32_2xpk16_fp6_f32(x * inv, y * inv, 1.0f);
    unsigned char* p = row + (b >> 2) * 128 + (b & 3) * 16;
    *(v4u*)p = (v4u){r[0], r[1], r[2], r[3]}; *(v4u*)(p + 64) = (v4u){r[4], r[5], sb, 0u};
}
#define MX6_AMAX(x, y, am) do { am = 0.f; _Pragma("unroll") for (int i_ = 0; i_ < 16; ++i_) am = __builtin_fmaxf(__builtin_fmaxf(__builtin_fabsf(x[i_]), __builtin_fabsf(y[i_])), am); } while (0)
template <int MODE>
__device__ __forceinline__ void p2_mx6_item(const float* W, int K, int N, void* WT, int item, int lane) {
    const int nblk = N / 256, kb = item / nblk, nb = item % nblk, k0 = 32 * kb;
#pragma unroll 1
    for (int sub = 0; sub < 4; ++sub) { const int nn = nb * 256 + sub * 64 + lane; const float* wp = W + (size_t)k0 * N + nn;
        v16f32 x, y;
#pragma unroll
        for (int i = 0; i < 16; ++i) { x[i] = wp[(size_t)i * N]; y[i] = wp[(size_t)(16 + i) * N]; }
        float am; MX6_AMAX(x, y, am);
        const int R = MODE == 0 ? nn : (256 * (nn >> 7) + (nn & 127) + (MODE == 2 ? 128 : 0));
        mx6_store_block((unsigned char*)WT + (size_t)R * K, kb, x, y, am); }
}
template <int MODE, bool F8OUT>
__device__ __forceinline__ void p0_tr_item(const float* W, int K, int N, int noff, int nend, void* WT, int item, int lane, float sc) {
    const int nblk = (nend - noff) / 256, kb = item / nblk, nb = item % nblk, k0 = 32 * kb, n = noff + nb * 256 + lane * 4;
    constexpr int KS = F8OUT ? 16 : 8;
    const bool inb = n < N;
#pragma unroll
    for (int kk = 0; kk < 32; kk += KS) {
        f32x4 v[KS];
#pragma unroll
        for (int i = 0; i < KS; ++i) v[i] = inb ? *(const f32x4*)(W + (size_t)(k0 + kk + i) * N + n) : (f32x4){0.f, 0.f, 0.f, 0.f};
#pragma unroll
        for (int c = 0; c < 4; ++c) { const int nn = n + c; const int R = MODE == 0 ? nn : (256 * (nn >> 7) + (nn & 127) + (MODE == 2 ? 128 : 0));
            v4u o;
            if constexpr (F8OUT) { o.x = pk4_fp8(v[0][c] * sc, v[1][c] * sc, v[2][c] * sc, v[3][c] * sc); o.y = pk4_fp8(v[4][c] * sc, v[5][c] * sc, v[6][c] * sc, v[7][c] * sc);
                o.z = pk4_fp8(v[8][c] * sc, v[9][c] * sc, v[10][c] * sc, v[11][c] * sc); o.w = pk4_fp8(v[12][c] * sc, v[13][c] * sc, v[14][c] * sc, v[15][c] * sc);
                *(v4u*)((unsigned char*)WT + (size_t)R * K + k0 + kk) = o; }
            else { o.x = pk2(v[0][c], v[1][c]); o.y = pk2(v[2][c], v[3][c]); o.z = pk2(v[4][c], v[5][c]); o.w = pk2(v[6][c], v[7][c]);
                *(v4u*)((bf16*)WT + (size_t)R * K + k0 + kk) = o; } }
    }
}
__device__ __forceinline__ void p0_prologue(Frame& F) {
    LAS float* scr = (LAS float*)(F.lds + RING_OFF + F.wave * 16384);
    const int gw = F.vcu * NWAVES + F.wave, NGW = F.G * NWAVES;
    bf16* win_t = (bf16*)(F.ws + WS_WIN); bf16* wglu_t = (bf16*)(F.ws + WS_WGLU); bf16* wout_t = (bf16*)(F.ws + WS_WOUT); bf16* wug_t = (bf16*)(F.ws + WS_WUG); bf16* wdown_t = (bf16*)(F.ws + WS_WDOWN);
    constexpr int I_IN8 = (DM / 32) * (NP8 / 256), I_IN = (DM / 32) * ((NPROJ - NP8) / 256);
    for (int it = gw; it < I_IN8 + I_IN; it += NGW) {
        int r = it;
        if (r < I_IN8) { p0_tr_item<0, true>(F.in[I_WIN], DM, N_IN, 0, NP8, F.ws + WS_WIN8, r, F.lane, SC_WIN); continue; } r -= I_IN8;
        p0_tr_item<0, false>(F.in[I_WIN], DM, N_IN, NP8, NPROJ, win_t, r, F.lane, 1.f);
    }
    { const size_t n8 = (size_t)M * DM / 8; const f32x4* xs = (const f32x4*)F.in[I_X]; v4u* xd = (v4u*)(F.ws + WS_XB);
#pragma unroll 4
      for (size_t i = (size_t)F.vcu * 512 + F.tid; i < n8; i += (size_t)F.G * 512) { const f32x4 a = xs[2 * i], b = xs[2 * i + 1];
          v4u o; o.x = pk2(a[0], a[1]); o.y = pk2(a[2], a[3]); o.z = pk2(b[0], b[1]); o.w = pk2(b[2], b[3]); xd[i] = o;
          v2u o8; o8.x = pk4_fp8(a[0] * SC_X, a[1] * SC_X, a[2] * SC_X, a[3] * SC_X); o8.y = pk4_fp8(b[0] * SC_X, b[1] * SC_X, b[2] * SC_X, b[3] * SC_X); ((v2u*)(F.ws + WS_MIX + 32 * MiB))[i] = o8; } }
    { const int gi = F.vcu * 512 + F.tid;
      if (gi < NG * NST) { const int g = gi >> 6;
          const double dt = exp((double)F.in[I_LOGDT][g]); const double are = (double)F.in[I_ARE][gi], aim = (double)F.in[I_AIM][gi];
          const double mag = exp(dt * are), ang = dt * aim; const double abr = mag * cos(ang), abi = mag * sin(ang);
          const double nr = abr - 1.0, ni = abi, den = are * are + aim * aim;
          const double fre = (nr * are + ni * aim) / den, fim = (ni * are - nr * aim) / den;
          float2* ta = (float2*)(F.ws + WS_TABA); float2* tb = (float2*)(F.ws + WS_TABB);
          ta[gi] = make_float2((float)abr, (float)abi);
#pragma unroll
          for (int h = 0; h < GCH; ++h) { const double br = (double)F.in[I_BRE][gi * GCH + h], bi = (double)F.in[I_BIM][gi * GCH + h];
              const float bbr = (float)(fre * br - fim * bi), bbi = (float)(fre * bi + fim * br);
              tb[gi * GCH + h] = make_float2(bbr, bbi);
              const int p = gi & 63; bf16* bcat = (bf16*)(F.ws + WS_BCAT);
              bcat[(size_t)(g * 128 + p) * 16 + h] = (bf16)f2bf(bbr); bcat[(size_t)(g * 128 + 64 + p) * 16 + h] = (bf16)f2bf(bbi); }
          { const double m32 = exp(32.0 * dt * are), a32 = 32.0 * dt * aim; ((float2*)(F.ws + WS_TABA32))[gi] = make_float2((float)(m32 * cos(a32)), (float)(m32 * sin(a32))); } } }
    for (int e = F.vcu * 512 + F.tid; e < NG * 2 * 8 * 64; e += F.G * 512) {
        const int ln = e & 63, rp = (e >> 6) & 7, pt = (e >> 9) & 1, g = e >> 10, hw = ln >> 5, jl = ln & 31;
        const double dt = exp((double)F.in[I_LOGDT][g]); float vi[4], vw[4];
#pragma unroll
        for (int k = 0; k < 2; ++k) { const int r = 2 * rp + k, cr = (r & 3) + 8 * (r >> 2) + 4 * hw;
            { const int p = pt * 32 + jl; const double are = (double)F.in[I_ARE][g * 64 + p], aim = (double)F.in[I_AIM][g * 64 + p], kk = -(double)cr; const double mg = exp(kk * dt * are), an = kk * dt * aim;
              vi[k] = (float)(mg * cos(an)); vi[2 + k] = (float)(mg * sin(an)); }
            { const int p = pt * 32 + cr; const double are = (double)F.in[I_ARE][g * 64 + p], aim = (double)F.in[I_AIM][g * 64 + p], kk = (double)jl; const double mg = exp(kk * dt * are), an = kk * dt * aim;
              vw[k] = (float)(mg * cos(an)); vw[2 + k] = (float)(mg * sin(an)); } }
        ((fl4*)(F.ws + WS_TABINV))[e] = (fl4){vi[0], vi[1], vi[2], vi[3]}; ((fl4*)(F.ws + WS_TABW))[e] = (fl4){vw[0], vw[1], vw[2], vw[3]};
    }
    for (int e = F.vcu * 512 + F.tid; e < NG * 4 * 2 * 64; e += F.G * 512) {
        const int ln = e & 63, s = (e >> 6) & 1, q = (e >> 7) & 3, g = e >> 9, ch = ln & 31, hw = ln >> 5; unsigned hv[8];
#pragma unroll
        for (int ee = 0; ee < 8; ++ee) { const int p = (q & 1) * 32 + 8 * (2 * s + (ee >> 2)) + 4 * hw + (ee & 3); float v = 0.f;
            if (ch < 16) v = (q < 2) ? F.in[I_CRE][(size_t)(g * 16 + ch) * 64 + p] : -F.in[I_CIM][(size_t)(g * 16 + ch) * 64 + p];
            hv[ee] = f2bf(v); }
        v4u w; w.x = hv[0] | (hv[1] << 16); w.y = hv[2] | (hv[3] << 16); w.z = hv[4] | (hv[5] << 16); w.w = hv[6] | (hv[7] << 16);
        ((v4u*)(F.ws + WS_CA))[e] = w; }
}

constexpr int P2W_GLU = (SSMW / 32) * (SSMW / 256), P2W_OUT = (DM / 32) * (DM / 256), P2W_UP = (DM / 32) * (DFF / 256), P2W_DOWN = (DFF / 32) * (DM / 256);
constexpr int P2W_ITEMS = P2W_GLU + P2W_OUT + 2 * P2W_UP + P2W_DOWN;
__device__ __forceinline__ void p2_weight_item(Frame& F, int it) {
    int r = it;
    if (r < P2W_GLU) { p0_tr_item<0, false>(F.in[I_WGLU], SSMW, SSMW, 0, SSMW, F.ws + WS_WGLU, r, F.lane, 1.f); return; } r -= P2W_GLU;
    if (r < P2W_OUT) { p0_tr_item<0, true>(F.in[I_WOUT], DM, DM, 0, DM, F.ws + WS_WOUT, r, F.lane, SC_WOUT); return; } r -= P2W_OUT;
    if (r < P2W_UP) { p2_mx6_item<1>(F.in[I_WUP], DM, DFF, F.ws + WS_WUG, r, F.lane); return; } r -= P2W_UP;
    if (r < P2W_UP) { p2_mx6_item<2>(F.in[I_WGATE], DM, DFF, F.ws + WS_WUG, r, F.lane); return; } r -= P2W_UP;
    p0_tr_item<0, true>(F.in[I_WDOWN], DFF, DM, 0, DM, F.ws + WS_WDOWN, r, F.lane, SC_WDN);
}

typedef short bf16x8_t __attribute__((ext_vector_type(8)));
typedef float f32x16_t __attribute__((ext_vector_type(16)));
typedef float fl2 __attribute__((ext_vector_type(2)));
constexpr int IDX_NLDS = 30;
__device__ __forceinline__ void idx_mfma_pair(Frame& F, int b, int ti, unsigned* maskout, const LAS bf16* kl) {
    const int lane = F.lane, j = lane & 31, hw = lane >> 5, t0 = 2 * ti, th = t0 + hw;
    const bf16* proj = (const bf16*)(F.ws + WS_PROJ);
    const bf16* pb = proj + (size_t)(b * SEQ) * NPROJ;
    bf16x8_t qa[4];
    { const int q = (j >> 2) & 1, head = (j >> 3) * 4 + (j & 3); const bf16* qp = pb + (size_t)(t0 + q) * NPROJ + QI_OFF + head * IDIM + 8 * hw;
#pragma unroll
      for (int s = 0; s < 4; ++s) qa[s] = *(const bf16x8_t*)(qp + 16 * s); }
    float w[16];
    { const bf16* wp = pb + (size_t)th * NPROJ + WI_OFF; const v4u a = *(const v4u*)wp, c = *(const v4u*)(wp + 8);
      w[0] = bflo(a.x); w[1] = bfhi(a.x); w[2] = bflo(a.y); w[3] = bfhi(a.y); w[4] = bflo(a.z); w[5] = bfhi(a.z); w[6] = bflo(a.w); w[7] = bfhi(a.w);
      w[8] = bflo(c.x); w[9] = bfhi(c.x); w[10] = bflo(c.y); w[11] = bfhi(c.y); w[12] = bflo(c.z); w[13] = bfhi(c.z); w[14] = bflo(c.w); w[15] = bfhi(c.w);
#pragma unroll
      for (int r = 0; r < 16; ++r) w[r] *= IDX_W_SCALE; }
    const int kbnd = t0 >> 5;
    const float pen = (j > th - 32 * kbnd) ? -__builtin_inff() : 0.f;
    const int nkt = (t0 + 1) / 32 + 1;
    const float NEG = -__builtin_inff();
    float sc[64];
    const bf16* kp = (const bf16*)(F.ws + WS_KIPACK) + (size_t)(b * 64) * 4 * 64 * 8 + (size_t)lane * 8;
    typedef float f32x2_t __attribute__((ext_vector_type(2)));
    f32x2_t w2[8];
#pragma unroll
    for (int r = 0; r < 8; ++r) w2[r] = (f32x2_t){0.5f * w[2 * r], 0.5f * w[2 * r + 1]};
    bf16x8_t kA[2][4], kB[2][4];
#pragma unroll
    for (int t2 = 0; t2 < 2; ++t2)
#pragma unroll
        for (int s = 0; s < 4; ++s) kA[t2][s] = *(const LAS bf16x8_t*)(kl + (t2 * 4 + s) * 512);
    unsigned kl2a = (unsigned)(size_t)kl + 16 * 4096; asm volatile("" : "+v"(kl2a));
    const LAS bf16* kl2 = (const LAS bf16*)(size_t)kl2a;
#pragma unroll
    for (int kp2 = 0; kp2 < 32; ++kp2) {
        if (2 * kp2 < nkt) {
            if (2 * (kp2 + 1) < nkt) {
#pragma unroll
                for (int t2 = 0; t2 < 2; ++t2)
#pragma unroll
                    for (int s = 0; s < 4; ++s) { const bf16x8_t v = (2 * kp2 + 2 < 16) ? *(const LAS bf16x8_t*)(kl + ((2 * kp2 + 2 + t2) * 4 + s) * 512) : (2 * kp2 + 2 < IDX_NLDS) ? *(const LAS bf16x8_t*)(kl2 + ((2 * kp2 + 2 - 16 + t2) * 4 + s) * 512) : *(const bf16x8_t*)(kp + (size_t)((2 * kp2 + 2 + t2) * 4 + s) * 512);
                        if (kp2 & 1) kA[t2][s] = v; else kB[t2][s] = v; } }
            f32x16_t acc0 = {}, acc1 = {};
#pragma unroll
            for (int s = 0; s < 4; ++s) { acc0 = __builtin_amdgcn_mfma_f32_32x32x16_bf16(qa[s], (kp2 & 1) ? kB[0][s] : kA[0][s], acc0, 0, 0, 0);
                acc1 = __builtin_amdgcn_mfma_f32_32x32x16_bf16(qa[s], (kp2 & 1) ? kB[1][s] : kA[1][s], acc1, 0, 0, 0); }
            f32x2_t s0 = {0.f, 0.f}, s1 = {0.f, 0.f}; float a0 = 0.f, b0 = 0.f, a1 = 0.f, b1 = 0.f;
#pragma unroll
            for (int r = 0; r < 8; ++r) { const f32x2_t x0 = {acc0[2 * r], acc0[2 * r + 1]}, x1 = {acc1[2 * r], acc1[2 * r + 1]};
                s0 = x0 * w2[r] + s0; s1 = x1 * w2[r] + s1;
                a0 = fmaf(w2[r].x, fabsf(x0.x), a0); b0 = fmaf(w2[r].y, fabsf(x0.y), b0); a1 = fmaf(w2[r].x, fabsf(x1.x), a1); b1 = fmaf(w2[r].y, fabsf(x1.y), b1); }
            float v0 = (s0.x + s0.y) + (a0 + b0), v1 = (s1.x + s1.y) + (a1 + b1);
            if (2 * kp2 == kbnd) { v0 += pen; v1 = NEG; } else if (2 * kp2 + 1 == kbnd) v1 += pen;
            sc[2 * kp2] = v0; sc[2 * kp2 + 1] = v1;
        } else { sc[2 * kp2] = NEG; sc[2 * kp2 + 1] = NEG; }
    }
    float thr = -3.0e38f, tieval = 0.f; bool tie = false; int need = 0;
    bool act = th >= TOPK;
    if (__any(act)) {
        float mn = sc[0], mx = sc[0];
#pragma unroll
        for (int kt = 1; kt < 8; ++kt) mn = __builtin_amdgcn_fmed3f(mn, sc[kt], NEG);
#pragma unroll
        for (int kt = 1; kt < 64; ++kt) mx = __builtin_amdgcn_fmed3f(mx, sc[kt], __builtin_inff());
#define IDX_DPP_F(v, ctrl) __builtin_bit_cast(float, __builtin_amdgcn_update_dpp(0, __builtin_bit_cast(int, v), ctrl, 0xf, 0xf, false))
        mn = fminf(mn, IDX_DPP_F(mn, 0x128)); mn = fminf(mn, IDX_DPP_F(mn, 0x124)); mn = fminf(mn, IDX_DPP_F(mn, 0x122)); mn = fminf(mn, IDX_DPP_F(mn, 0x121));
        mx = fmaxf(mx, IDX_DPP_F(mx, 0x128)); mx = fmaxf(mx, IDX_DPP_F(mx, 0x124)); mx = fmaxf(mx, IDX_DPP_F(mx, 0x122)); mx = fmaxf(mx, IDX_DPP_F(mx, 0x121));
#undef IDX_DPP_F
        { const float a0 = __builtin_bit_cast(float, __builtin_amdgcn_readlane(__builtin_bit_cast(int, mn), 0)), a1 = __builtin_bit_cast(float, __builtin_amdgcn_readlane(__builtin_bit_cast(int, mn), 16));
          const float a2 = __builtin_bit_cast(float, __builtin_amdgcn_readlane(__builtin_bit_cast(int, mn), 32)), a3 = __builtin_bit_cast(float, __builtin_amdgcn_readlane(__builtin_bit_cast(int, mn), 48));
          const float b0 = __builtin_bit_cast(float, __builtin_amdgcn_readlane(__builtin_bit_cast(int, mx), 0)), b1 = __builtin_bit_cast(float, __builtin_amdgcn_readlane(__builtin_bit_cast(int, mx), 16));
          const float b2 = __builtin_bit_cast(float, __builtin_amdgcn_readlane(__builtin_bit_cast(int, mx), 32)), b3 = __builtin_bit_cast(float, __builtin_amdgcn_readlane(__builtin_bit_cast(int, mx), 48));
          mn = hw ? fminf(a2, a3) : fminf(a0, a1); mx = hw ? fmaxf(b2, b3) : fmaxf(b0, b1); }
        float lo = mn, hi = mx + fabsf(mx) * 1e-6f + 1e-30f;
        int chi = 0;
        float glo = (float)(th + 1) - ((float)TOPK - 0.5f), ghi = -((float)TOPK - 0.5f); int side = 0;
        const int ngrp = (nkt + 7) >> 3;
        for (int it = 0; it < 200; ++it) {
            if (!__any(act)) break;
            float mid = hi - ghi * (hi - lo) * __builtin_amdgcn_rcpf(ghi - glo);
            if (!(mid > lo && mid < hi)) mid = 0.5f * (lo + hi);
            const bool conv = !(mid > lo && mid < hi);
            unsigned ba = 0u, bb = 0u;
#pragma unroll
            for (int g8 = 0; g8 < 4; ++g8) if (g8 < ngrp) {
#pragma unroll
                for (int kt = 8 * g8; kt < 8 * g8 + 8; ++kt) ba = __builtin_amdgcn_alignbit(ba, __builtin_bit_cast(unsigned, sc[kt] - mid), 31); }
#pragma unroll
            for (int g8 = 4; g8 < 8; ++g8) if (g8 < ngrp) {
#pragma unroll
                for (int kt = 8 * g8; kt < 8 * g8 + 8; ++kt) bb = __builtin_amdgcn_alignbit(bb, __builtin_bit_cast(unsigned, sc[kt] - mid), 31); }
            int cl = 8 * ngrp - (__builtin_popcount(ba) + __builtin_popcount(bb));
            cl += __builtin_amdgcn_update_dpp(0, cl, 0x128, 0xf, 0xf, false);
            cl += __builtin_amdgcn_update_dpp(0, cl, 0x124, 0xf, 0xf, false);
            cl += __builtin_amdgcn_update_dpp(0, cl, 0x122, 0xf, 0xf, false);
            cl += __builtin_amdgcn_update_dpp(0, cl, 0x121, 0xf, 0xf, false);
            const int c0 = __builtin_amdgcn_readlane(cl, 0) + __builtin_amdgcn_readlane(cl, 16), c1 = __builtin_amdgcn_readlane(cl, 32) + __builtin_amdgcn_readlane(cl, 48);
            const int c = hw ? c1 : c0;
            if (act) {
                if (conv) { act = false; tie = true; tieval = lo; thr = hi; need = TOPK - chi; }
                else if (c == TOPK) { act = false; thr = mid; }
                else if (c > TOPK) { lo = mid; glo = (float)c - ((float)TOPK - 0.5f); if (side == 1) ghi *= 0.5f; side = 1; }
                else { hi = mid; chi = c; ghi = (float)c - ((float)TOPK - 0.5f); if (side == -1) glo *= 0.5f; side = -1; }
            }
        }
        if (act) { thr = hi; }
    }
    unsigned w0v = 0u, w1v = 0u;
    const bool anytie = __any(tie);
    int need0 = __builtin_amdgcn_readlane(need, 0), need1 = __builtin_amdgcn_readlane(need, 32);
    if (!anytie) {
#define IDX_WL(KT) if ((KT) < nkt) { const unsigned long long bal_ = __ballot(sc[KT] >= thr); const unsigned x0_ = (unsigned)bal_, x1_ = (unsigned)(bal_ >> 32); \
        asm volatile("s_nop 1\n\tv_writelane_b32 %0, %2, " #KT "\n\tv_writelane_b32 %1, %3, " #KT : "+v"(w0v), "+v"(w1v) : "s"(x0_), "s"(x1_)); }
        IDX_WL(0) IDX_WL(1) IDX_WL(2) IDX_WL(3) IDX_WL(4) IDX_WL(5) IDX_WL(6) IDX_WL(7) IDX_WL(8) IDX_WL(9) IDX_WL(10) IDX_WL(11) IDX_WL(12) IDX_WL(13) IDX_WL(14) IDX_WL(15) IDX_WL(16) IDX_WL(17) IDX_WL(18) IDX_WL(19) IDX_WL(20) IDX_WL(21) IDX_WL(22) IDX_WL(23) IDX_WL(24) IDX_WL(25) IDX_WL(26) IDX_WL(27) IDX_WL(28) IDX_WL(29) IDX_WL(30) IDX_WL(31) IDX_WL(32) IDX_WL(33) IDX_WL(34) IDX_WL(35) IDX_WL(36) IDX_WL(37) IDX_WL(38) IDX_WL(39) IDX_WL(40) IDX_WL(41) IDX_WL(42) IDX_WL(43) IDX_WL(44) IDX_WL(45) IDX_WL(46) IDX_WL(47) IDX_WL(48) IDX_WL(49) IDX_WL(50) IDX_WL(51) IDX_WL(52) IDX_WL(53) IDX_WL(54) IDX_WL(55) IDX_WL(56) IDX_WL(57) IDX_WL(58) IDX_WL(59) IDX_WL(60) IDX_WL(61) IDX_WL(62) IDX_WL(63)
#undef IDX_WL
    } else
#pragma unroll
    for (int kt = 0; kt < 64; ++kt) if (kt < nkt) {
        const unsigned long long bal = __ballot(sc[kt] >= thr);
        unsigned x0 = (unsigned)bal, x1 = (unsigned)(bal >> 32);
        if (anytie) {
            const unsigned long long be = __ballot(tie && sc[kt] == tieval);
            unsigned e0 = (unsigned)be, e1 = (unsigned)(be >> 32);
            while (__builtin_popcount(e0) > need0) e0 &= ~(0x80000000u >> __builtin_clz(e0));
            while (__builtin_popcount(e1) > need1) e1 &= ~(0x80000000u >> __builtin_clz(e1));
            need0 -= __builtin_popcount(e0); need1 -= __builtin_popcount(e1);
            x0 |= e0; x1 |= e1;
        }
        w0v = (lane == kt) ? x0 : w0v; w1v = (lane == kt) ? x1 : w1v;
    }
    maskout[(size_t)(b * SEQ + t0) * 64 + lane] = w0v;
    maskout[(size_t)(b * SEQ + t0 + 1) * 64 + lane] = w1v;
}


__device__ __forceinline__ bf16x8_t ssm_pack8(const f32x16_t& v, int base) {
    v4u w; w.x = pg8::cvt_pk_bf16(v[base + 0], v[base + 1]); w.y = pg8::cvt_pk_bf16(v[base + 2], v[base + 3]); w.z = pg8::cvt_pk_bf16(v[base + 4], v[base + 5]); w.w = pg8::cvt_pk_bf16(v[base + 6], v[base + 7]);
    return __builtin_bit_cast(bf16x8_t, w);
}
__device__ __forceinline__ void ssm_mfma_task(Frame& F, int b, int g, const LAS fl4* tInv, const LAS fl4* tW, bf16* ygo, int c_light, int c_begin, int c_end) {
    const int lane = F.lane, j = lane & 31, hw = lane >> 5;
    const bf16* pu = (const bf16*)(F.ws + WS_PROJ) + (size_t)(b * SEQ) * NPROJ + U_OFF + g * 16;
    bf16x8_t bc[4], ca[4][2], tri[2];
#pragma unroll
    for (int nt = 0; nt < 4; ++nt) bc[nt] = *(const bf16x8_t*)((const bf16*)(F.ws + WS_BCAT) + (size_t)((g * 128 + nt * 32 + j) * 16 + 8 * hw));
#pragma unroll
    for (int q = 0; q < 4; ++q)
#pragma unroll
        for (int s = 0; s < 2; ++s) ca[q][s] = *(const bf16x8_t*)((const bf16*)(F.ws + WS_CA) + (size_t)((((g * 4 + q) * 2 + s) * 64 + lane) * 8));
#pragma unroll
    for (int s = 0; s < 2; ++s) { v4u w;
        unsigned hv[8];
#pragma unroll
        for (int e = 0; e < 8; ++e) { const int i = 8 * (2 * s + (e >> 2)) + 4 * hw + (e & 3); hv[e] = (i <= j) ? 0x3F80u : 0u; }
        w.x = hv[0] | (hv[1] << 16); w.y = hv[2] | (hv[3] << 16); w.z = hv[4] | (hv[5] << 16); w.w = hv[6] | (hv[7] << 16);
        tri[s] = __builtin_bit_cast(bf16x8_t, w); }
    float2 a32[2];
#pragma unroll
    for (int pt = 0; pt < 2; ++pt) a32[pt] = ((const float2*)(F.ws + WS_TABA32))[g * 64 + pt * 32 + j];
    float dv[8];
#pragma unroll
    for (int k = 0; k < 8; ++k) dv[k] = F.in[I_D][g * 16 + (k & 3) + 8 * (k >> 2) + 4 * hw];
    float hcr[2] = {0.f, 0.f}, hci[2] = {0.f, 0.f};
    const bf16* pl = pu + (size_t)j * NPROJ;
    if (c_light < c_begin) {
        bf16x8_t ul = *(const bf16x8_t*)(pl + (size_t)c_light * 32 * NPROJ + 8 * hw);
#pragma unroll 1
        for (int c = c_light; c < c_begin; ++c) {
            const bf16x8_t ulc = ul;
            if (c + 1 < c_begin) ul = *(const bf16x8_t*)(pl + (size_t)(c + 1) * 32 * NPROJ + 8 * hw);
            f32x16_t d[4];
#pragma unroll
            for (int nt = 0; nt < 4; ++nt) { f32x16_t z = {}; d[nt] = __builtin_amdgcn_mfma_f32_32x32x16_bf16(ulc, bc[nt], z, 0, 0, 0); }
#pragma unroll
            for (int pt = 0; pt < 2; ++pt) { float sr = 0.f, si = 0.f;
                fl2 sr2 = {0.f, 0.f}, si2 = {0.f, 0.f};
#pragma unroll
                for (int rp = 0; rp < 8; ++rp) { const fl4 w = tInv[(pt * 8 + rp) * 64 + lane]; const fl2 wre = {w.x, w.y}, wim = {w.z, w.w};
                    const fl2 re = {d[pt][2 * rp], d[pt][2 * rp + 1]}, im = {d[2 + pt][2 * rp], d[2 + pt][2 * rp + 1]}; sr2 += wre * re - wim * im; si2 += wre * im + wim * re; }
                sr = sr2.x + sr2.y; si = si2.x + si2.y;
                sr += __shfl_xor(sr, 32); si += __shfl_xor(si, 32);
                sr += hcr[pt]; si += hci[pt];
                hcr[pt] = a32[pt].x * sr - a32[pt].y * si; hci[pt] = a32[pt].x * si + a32[pt].y * sr; }
        }
    }
    const bf16* pf = pl + (size_t)c_begin * 32 * NPROJ;
    bf16x8_t ua = *(const bf16x8_t*)(pf + 8 * hw);
    v2u ue0 = *(const v2u*)(pf + 4 * hw), ue1 = *(const v2u*)(pf + 8 + 4 * hw);
#pragma unroll 1
    for (int c = c_begin; c < c_end; ++c) {
        const bf16x8_t uac = ua; const v2u uc0 = ue0, uc1 = ue1;
        if (c + 1 < c_end) { const bf16* pn = pl + (size_t)(c + 1) * 32 * NPROJ; ua = *(const bf16x8_t*)(pn + 8 * hw); ue0 = *(const v2u*)(pn + 4 * hw); ue1 = *(const v2u*)(pn + 8 + 4 * hw); }
        f32x16_t d[4];
#pragma unroll
        for (int nt = 0; nt < 4; ++nt) { f32x16_t z = {}; d[nt] = __builtin_amdgcn_mfma_f32_32x32x16_bf16(uac, bc[nt], z, 0, 0, 0); }
#pragma unroll
        for (int pt = 0; pt < 2; ++pt) { float sr = 0.f, si = 0.f;
            fl2 sr2 = {0.f, 0.f}, si2 = {0.f, 0.f};
#pragma unroll
            for (int rp = 0; rp < 8; ++rp) { const fl4 w = tInv[(pt * 8 + rp) * 64 + lane]; const fl2 wre = {w.x, w.y}, wim = {w.z, w.w};
                const fl2 re = {d[pt][2 * rp], d[pt][2 * rp + 1]}, im = {d[2 + pt][2 * rp], d[2 + pt][2 * rp + 1]};
                fl2 xr = wre * re - wim * im, xi = wre * im + wim * re;
                if (rp == 0) { xr.x += (hw == 0) ? hcr[pt] : 0.f; xi.x += (hw == 0) ? hci[pt] : 0.f; }
                d[pt][2 * rp] = xr.x; d[pt][2 * rp + 1] = xr.y; d[2 + pt][2 * rp] = xi.x; d[2 + pt][2 * rp + 1] = xi.y; sr2 += xr; si2 += xi; }
            sr = sr2.x + sr2.y; si = si2.x + si2.y;
            sr += __shfl_xor(sr, 32); si += __shfl_xor(si, 32);
            hcr[pt] = a32[pt].x * sr - a32[pt].y * si; hci[pt] = a32[pt].x * si + a32[pt].y * sr; }
        f32x16_t st[4];
#pragma unroll
        for (int q = 0; q < 4; ++q) { f32x16_t z = {}; st[q] = __builtin_amdgcn_mfma_f32_32x32x16_bf16(ssm_pack8(d[q], 0), tri[0], z, 0, 0, 0);
            st[q] = __builtin_amdgcn_mfma_f32_32x32x16_bf16(ssm_pack8(d[q], 8), tri[1], st[q], 0, 0, 0); }
#pragma unroll
        for (int pt = 0; pt < 2; ++pt)
#pragma unroll
            for (int rp = 0; rp < 8; ++rp) { const fl4 w = tW[(pt * 8 + rp) * 64 + lane]; const fl2 wre = {w.x, w.y}, wim = {w.z, w.w};
                const fl2 sre = {st[pt][2 * rp], st[pt][2 * rp + 1]}, sim = {st[2 + pt][2 * rp], st[2 + pt][2 * rp + 1]};
                const fl2 hr = wre * sre - wim * sim, hi = wre * sim + wim * sre;
                st[pt][2 * rp] = hr.x; st[pt][2 * rp + 1] = hr.y; st[2 + pt][2 * rp] = hi.x; st[2 + pt][2 * rp + 1] = hi.y; }
        f32x16_t y = {};
#pragma unroll
        for (int q = 0; q < 4; ++q) { y = __builtin_amdgcn_mfma_f32_32x32x16_bf16(ca[q][0], ssm_pack8(st[q], 0), y, 0, 0, 0); y = __builtin_amdgcn_mfma_f32_32x32x16_bf16(ca[q][1], ssm_pack8(st[q], 8), y, 0, 0, 0); }
        float o[8];
        o[0] = y[0] + dv[0] * bflo(uc0.x); o[1] = y[1] + dv[1] * bfhi(uc0.x); o[2] = y[2] + dv[2] * bflo(uc0.y); o[3] = y[3] + dv[3] * bfhi(uc0.y);
        o[4] = y[4] + dv[4] * bflo(uc1.x); o[5] = y[5] + dv[5] * bfhi(uc1.x); o[6] = y[6] + dv[6] * bflo(uc1.y); o[7] = y[7] + dv[7] * bfhi(uc1.y);
        const pg8::f32x2 g0 = pg8::gelu_pk((pg8::f32x2){o[0], o[1]}), g1 = pg8::gelu_pk((pg8::f32x2){o[2], o[3]}), g2 = pg8::gelu_pk((pg8::f32x2){o[4], o[5]}), g3 = pg8::gelu_pk((pg8::f32x2){o[6], o[7]});
        bf16* yo = ygo + (size_t)(b * SEQ + c * 32 + j) * SSMW + g * 16 + 4 * hw;
        v2u w0; w0.x = pg8::cvt_pk_bf16(g0.x, g0.y); w0.y = pg8::cvt_pk_bf16(g1.x, g1.y); *(v2u*)yo = w0;
        v2u w1; w1.x = pg8::cvt_pk_bf16(g2.x, g2.y); w1.y = pg8::cvt_pk_bf16(g3.x, g3.y); *(v2u*)(yo + 8) = w1;
    }
}


namespace att {
using bf16x8 = __attribute__((ext_vector_type(8))) short;
using s16x4  = __attribute__((ext_vector_type(4))) short;
using f32x16 = __attribute__((ext_vector_type(16))) float;
using u32x4  = __attribute__((ext_vector_type(4))) unsigned;
constexpr int D = 128, NW = 8, QBLK = 32, KVBLK = 64;
constexpr float SCALE = 0.088388347648318440f;
constexpr float THR = 8.f;
constexpr int LDK = NPROJ;
constexpr int SHM_V = KVBLK * D * 2, SHM_K = KVBLK * D * 2, SHM_ATTN = 3 * SHM_V + 3 * SHM_K + NW * 64 * 4;
#define KSWZ(row, colB) ((row) * 256 + ((colB) ^ (((row) & 15) << 4)))
#define SBAR() __builtin_amdgcn_sched_barrier(0)
__device__ __forceinline__ int crow(int r, int hi) { return (r & 3) + 8 * (r >> 2) + 4 * hi; }
__device__ __forceinline__ unsigned cvtpk(float lo, float hi) { unsigned r; asm volatile("v_cvt_pk_bf16_f32 %0, %1, %2" : "=v"(r) : "v"(lo), "v"(hi)); return r; }

__device__ __forceinline__ void partialSM(f32x16& p0, f32x16& p1, float& m_reg, float& mn, float& alpha, float base) {
  constexpr float C = SCALE * 1.4426950408889634f;
  float pm0 = p0[0], pm1 = p0[1], pm2 = p0[2], pm3 = p0[3];
#define MX3(a, b, c) __builtin_fmaxf(__builtin_fmaxf(a, b), c)
  pm0 = MX3(pm0, p0[4], p0[8]); pm1 = MX3(pm1, p0[5], p0[9]); pm2 = MX3(pm2, p0[6], p0[10]); pm3 = MX3(pm3, p0[7], p0[11]);
  pm0 = MX3(pm0, p0[12], p1[0]); pm1 = MX3(pm1, p0[13], p1[1]); pm2 = MX3(pm2, p0[14], p1[2]); pm3 = MX3(pm3, p0[15], p1[3]);
  pm0 = MX3(pm0, p1[4], p1[8]); pm1 = MX3(pm1, p1[5], p1[9]); pm2 = MX3(pm2, p1[6], p1[10]); pm3 = MX3(pm3, p1[7], p1[11]);
  pm0 = MX3(pm0, p1[12], p1[13]); pm1 = MX3(pm1, p1[14], p1[15]);
  float pmax = MX3(pm0, pm1, pm2); pmax = fmaxf(pmax, pm3);
#undef MX3
  pmax += base;
  { auto rr = __builtin_amdgcn_permlane32_swap(__float_as_uint(pmax), __float_as_uint(pmax), false, false);
    pmax = fmaxf(__uint_as_float(rr[0]), __uint_as_float(rr[1])); }
  if (__builtin_expect(__all(pmax - m_reg <= THR / SCALE), 1)) { mn = m_reg; alpha = 1.f; }
  else { mn = fmaxf(m_reg, pmax); alpha = __builtin_amdgcn_exp2f((m_reg - mn) * C); m_reg = mn; }
  float mnC = (base - mn) * C;
  for (int r = 0; r < 16; ++r) p0[r] = fmaf(p0[r], C, mnC); for (int r = 0; r < 16; ++r) p1[r] = fmaf(p1[r], C, mnC);
  for (int r = 0; r < 16; ++r) p0[r] = __builtin_amdgcn_exp2f(p0[r]);
}
__device__ __forceinline__ void finishSM(f32x16& p0, f32x16& p1, float alpha, float& l_reg, bf16x8& pa0, bf16x8& pa1, bf16x8& pa2, bf16x8& pa3) {
  for (int r = 0; r < 16; ++r) p1[r] = __builtin_amdgcn_exp2f(p1[r]);
  float ps = 0; for (int r = 0; r < 16; ++r) ps += p0[r]; for (int r = 0; r < 16; ++r) ps += p1[r];
  { auto rr = __builtin_amdgcn_permlane32_swap(__float_as_uint(ps), __float_as_uint(ps), false, false);
    ps = __uint_as_float(rr[0]) + __uint_as_float(rr[1]); }
  l_reg = l_reg * alpha + ps;
#define PK4(P, BASE, OUT) do { unsigned a0 = cvtpk(P[BASE + 0], P[BASE + 1]), a1 = cvtpk(P[BASE + 2], P[BASE + 3]);   \
    unsigned b0 = cvtpk(P[BASE + 4], P[BASE + 5]), b1 = cvtpk(P[BASE + 6], P[BASE + 7]);                              \
    auto r0 = __builtin_amdgcn_permlane32_swap(a0, b0, false, false); auto r1 = __builtin_amdgcn_permlane32_swap(a1, b1, false, false); \
    u32x4 w = {r0[0], r1[0], r0[1], r1[1]}; OUT = *reinterpret_cast<bf16x8*>(&w); } while (0)
  PK4(p0, 0, pa0); PK4(p0, 8, pa1); PK4(p1, 0, pa2); PK4(p1, 8, pa3);
#undef PK4
}
__device__ __forceinline__ void qkt(f32x16& p0, f32x16& p1, const bf16* Ks, const bf16x8* qr, int r32, int hi, float slopeS, v2u mw) {
  p0 = f32x16{}; p1 = f32x16{};
  for (int d0 = 0; d0 < 8; ++d0) { int cb = (d0 * 16 + hi * 8) * 2;
    bf16x8 b0 = *reinterpret_cast<const bf16x8*>((const char*)Ks + KSWZ(r32, cb));
    bf16x8 b1 = *reinterpret_cast<const bf16x8*>((const char*)Ks + KSWZ(32 + r32, cb));
    p0 = __builtin_amdgcn_mfma_f32_32x32x16_bf16(b0, qr[d0], p0, 0, 0, 0);
    p1 = __builtin_amdgcn_mfma_f32_32x32x16_bf16(b1, qr[d0], p1, 0, 0, 0); }
  const unsigned s0 = mw.x >> (4 * hi), s1 = mw.y >> (4 * hi); const float NEG = -__builtin_inff();
#pragma unroll
  for (int r = 0; r < 16; ++r) { const int cr = (r & 3) + 8 * (r >> 2);
    const unsigned m0 = (unsigned)(((int)(s0 << (31 - cr))) >> 31), m1 = (unsigned)(((int)(s1 << (31 - cr))) >> 31);
    p0[r] = __uint_as_float((m0 & __float_as_uint(fmaf(slopeS, (float)cr, p0[r]))) | (~m0 & 0xFF800000u));
    p1[r] = __uint_as_float((m1 & __float_as_uint(fmaf(slopeS, (float)(32 + cr), p1[r]))) | (~m1 & 0xFF800000u)); }
  (void)NEG;
}
__device__ __forceinline__ int v_st(int k, int c) { const int kk = (k & ~0xC) | ((k & 4) << 1) | ((k & 8) >> 1); return ((kk >> 3) * 4 + (c >> 5)) * 512 + ((kk & 7) * 32 + (c & 31)) * 2; }
__device__ __forceinline__ int v_rd_base(int lane) { return ((lane & 3) << 3) | (((lane >> 2) & 3) << 6) | (((lane >> 4) & 1) << 5) | (((lane >> 5) & 1) << 8); }
constexpr int v_rd_off(int d0, int ks, int half) { return d0 * 512 + ks * 4096 + half * 2048; }
template <int OFF> __device__ __forceinline__ s16x4 tr_read(int vb) {
  s16x4 r; asm volatile("ds_read_b64_tr_b16 %0, %1 offset:%2" : "=&v"(r) : "v"(vb), "i"(OFF) : "memory"); return r;
}
template <int D0> __device__ __forceinline__ void pv_one(f32x16& od, int vb, bf16x8 pa0, bf16x8 pa1, bf16x8 pa2, bf16x8 pa3) {
  const s16x4 l0 = tr_read<v_rd_off(D0, 0, 0)>(vb), h0 = tr_read<v_rd_off(D0, 0, 1)>(vb), l1 = tr_read<v_rd_off(D0, 1, 0)>(vb), h1 = tr_read<v_rd_off(D0, 1, 1)>(vb);
  const s16x4 l2 = tr_read<v_rd_off(D0, 2, 0)>(vb), h2 = tr_read<v_rd_off(D0, 2, 1)>(vb), l3 = tr_read<v_rd_off(D0, 3, 0)>(vb), h3 = tr_read<v_rd_off(D0, 3, 1)>(vb);
  asm volatile("s_waitcnt lgkmcnt(0)" ::: "memory"); SBAR();
#define PK(L, H) (bf16x8){L[0], L[1], L[2], L[3], H[0], H[1], H[2], H[3]}
  od = __builtin_amdgcn_mfma_f32_32x32x16_bf16(pa0, PK(l0, h0), od, 0, 0, 0);
  od = __builtin_amdgcn_mfma_f32_32x32x16_bf16(pa1, PK(l1, h1), od, 0, 0, 0);
  od = __builtin_amdgcn_mfma_f32_32x32x16_bf16(pa2, PK(l2, h2), od, 0, 0, 0);
  od = __builtin_amdgcn_mfma_f32_32x32x16_bf16(pa3, PK(l3, h3), od, 0, 0, 0);
#undef PK
}
__device__ __forceinline__ void pv_d0(f32x16* o, int vb, bf16x8 pa0, bf16x8 pa1, bf16x8 pa2, bf16x8 pa3) {
  pv_one<0>(o[0], vb, pa0, pa1, pa2, pa3); pv_one<1>(o[1], vb, pa0, pa1, pa2, pa3); pv_one<2>(o[2], vb, pa0, pa1, pa2, pa3); pv_one<3>(o[3], vb, pa0, pa1, pa2, pa3);
}
__device__ __forceinline__ void attn_mask_body(const bf16* __restrict__ Qb, const bf16* __restrict__ Kh, const bf16* __restrict__ Vh, const unsigned* __restrict__ Mb,
                                               unsigned char* __restrict__ Ob, int seq, float slopeS, char* lds) {
  const int tid = threadIdx.x, wid = tid >> 6, lane = tid & 63, r32 = lane & 31, hi = lane >> 5;
  bf16* V_lds = (bf16*)lds; bf16* K_lds = (bf16*)(lds + 3 * SHM_V);
  float* ws = (float*)(lds + 3 * SHM_V + 3 * SHM_K) + wid * 64; float* li_l = ws; float* al_l = ws + 32;
  float m_reg = -1e30f, l_reg = 0; f32x16 o[4] = {}; bf16x8 qr[8];
  const bf16* Qw = Qb + (long)(wid * QBLK + r32) * NPROJ + hi * 8;
#pragma unroll
  for (int d0 = 0; d0 < 8; ++d0) qr[d0] = *reinterpret_cast<const bf16x8*>(Qw + d0 * 16);
  const unsigned mvoff = (unsigned)(wid * QBLK + r32) * 256u;
#define MWLD(j) __builtin_bit_cast(v2u, __builtin_amdgcn_raw_buffer_load_b64(rm, mvoff, (j) * 8, 0))
  const float hb = slopeS * (float)(4 * hi);
  const int sr = tid >> 4, sc = (tid & 15) * 8, vst0 = v_st(sr, sc), vst1 = v_st(32 + sr, sc);
  const int vb0 = (int)(uintptr_t)V_lds + v_rd_base(lane);
  struct { bf16x8 vs0, vs1, ks0, ks1; } sr_[2];
  const unsigned kvoff = (unsigned)(sr * LDK + sc) * 2u;
  const __amdgpu_buffer_rsrc_t rk = __builtin_amdgcn_make_buffer_rsrc((void*)Kh, 0, SEQ * NPROJ * 2, 0x00020000);
  const __amdgpu_buffer_rsrc_t rv = __builtin_amdgcn_make_buffer_rsrc((void*)Vh, 0, SEQ * NPROJ * 2, 0x00020000);
  const __amdgpu_buffer_rsrc_t rm = __builtin_amdgcn_make_buffer_rsrc((void*)Mb, 0, 256 * 256, 0x00020000);
#define BL16(rs, so) __builtin_bit_cast(bf16x8, __builtin_amdgcn_raw_buffer_load_b128(rs, kvoff, (so), 0))
#define SLOAD(i, k0) do { const int so_ = (k0) * (LDK * 2); \
    sr_[i].vs0 = BL16(rv, so_); sr_[i].vs1 = BL16(rv, so_ + 32 * LDK * 2); sr_[i].ks0 = BL16(rk, so_); sr_[i].ks1 = BL16(rk, so_ + 32 * LDK * 2); } while (0)
#define SWRITE(b, i) do { *(bf16x8*)((char*)V_lds + (b) * SHM_V + vst0) = sr_[i].vs0;          \
    *(bf16x8*)((char*)V_lds + (b) * SHM_V + vst1) = sr_[i].vs1; int kc = sc * 2;               \
    *(bf16x8*)((char*)K_lds + (b) * SHM_K + KSWZ(sr, kc)) = sr_[i].ks0;                       \
    *(bf16x8*)((char*)K_lds + (b) * SHM_K + KSWZ(32 + sr, kc)) = sr_[i].ks1; } while (0)
#define SWAIT() asm volatile("s_waitcnt vmcnt(4)" ::: "memory")
#define RESC(a) do { if (__any((a) < 1.f)) { if (hi == 0) al_l[r32] = (a); asm volatile("s_waitcnt lgkmcnt(0)" ::: "memory"); \
    for (int d = 0; d < 4; ++d) for (int r = 0; r < 16; ++r) o[d][r] *= al_l[crow(r, hi)]; } } while (0)
#define TBASE(j) fmaf(slopeS, (float)(64 * (j)), hb)
  f32x16 pA0, pA1, pB0, pB1; float mnA, mnB, alA, alB; bf16x8 pa0, pa1, pa2, pa3; const int NT = seq / KVBLK;
  v2u mwA = MWLD(0), mwB = MWLD(1);
  int sp = 0, sq = 1, sw = 2;
  SLOAD(0, 0); asm volatile("s_waitcnt vmcnt(0)" ::: "memory"); SWRITE(0, 0);
  SLOAD(0, KVBLK); asm volatile("s_waitcnt vmcnt(0)" ::: "memory"); SWRITE(1, 0);
  if (2 < NT) SLOAD(0, 2 * KVBLK);
  __syncthreads();
  qkt(pA0, pA1, K_lds, qr, r32, hi, slopeS, mwA); partialSM(pA0, pA1, m_reg, mnA, alA, TBASE(0));
#define ROT3() do { const int t_ = sp; sp = sq; sq = sw; sw = t_; } while (0)
  for (int j = 1; j + 1 < NT; j += 2) {
    SWRITE(sw, 0);
    mwA = MWLD(j + 1);
    SBAR(); qkt(pB0, pB1, (bf16*)((char*)K_lds + sq * SHM_K), qr, r32, hi, slopeS, mwB);
    finishSM(pA0, pA1, alA, l_reg, pa0, pa1, pa2, pa3); SBAR();
    SLOAD(0, (j + 2) * KVBLK); SBAR();
    pv_d0(o, vb0 + sp * (int)SHM_V, pa0, pa1, pa2, pa3); partialSM(pB0, pB1, m_reg, mnB, alB, TBASE(j));
    RESC(alB); __syncthreads(); ROT3();
    SWRITE(sw, 0);
    mwB = MWLD(j + 2);
    SBAR(); qkt(pA0, pA1, (bf16*)((char*)K_lds + sq * SHM_K), qr, r32, hi, slopeS, mwA);
    finishSM(pB0, pB1, alB, l_reg, pa0, pa1, pa2, pa3); SBAR();
    if (j + 3 < NT) SLOAD(0, (j + 3) * KVBLK); SBAR();
    pv_d0(o, vb0 + sp * (int)SHM_V, pa0, pa1, pa2, pa3); partialSM(pA0, pA1, m_reg, mnA, alA, TBASE(j + 1));
    RESC(alA); __syncthreads(); ROT3();
  }
  SBAR(); qkt(pB0, pB1, (bf16*)((char*)K_lds + sq * SHM_K), qr, r32, hi, slopeS, mwB);
  finishSM(pA0, pA1, alA, l_reg, pa0, pa1, pa2, pa3); SBAR();
  pv_d0(o, vb0 + sp * (int)SHM_V, pa0, pa1, pa2, pa3); partialSM(pB0, pB1, m_reg, mnB, alB, TBASE(NT - 1));
  RESC(alB);
  finishSM(pB0, pB1, alB, l_reg, pa0, pa1, pa2, pa3); SBAR();
  pv_d0(o, vb0 + sq * (int)SHM_V, pa0, pa1, pa2, pa3);
#undef ROT3
  if (hi == 0) li_l[r32] = l_reg; asm volatile("s_waitcnt lgkmcnt(0)" ::: "memory");
  float rli[16];
#pragma unroll
  for (int r = 0; r < 16; ++r) rli[r] = __builtin_amdgcn_rcpf(li_l[crow(r, hi)]);
  unsigned char* Ow = Ob + (long)(wid * QBLK) * 2048;
#pragma unroll
  for (int r = 0; r < 16; ++r) { int orow = crow(r, hi); const float sc = rli[r] * SC_MIX;
    const unsigned w = pk4_fp8(o[0][r] * sc, o[1][r] * sc, o[2][r] * sc, o[3][r] * sc);
    for (int d0 = 0; d0 < 4; ++d0) Ow[(long)orow * 2048 + d0 * 32 + r32] = (unsigned char)(w >> (8 * d0)); }
#undef SLOAD
#undef SWRITE
#undef SWAIT
#undef RESC
#undef TBASE
#undef MWLD
#undef BL16
}
#undef KSWZ
#undef SBAR
}

template <bool OUT_BF16, bool IN_BF16 = false>
__device__ __forceinline__ void ln_row(const void* xrow, void* orow, const float* gam, const float* bet, int lane, unsigned* q8row = nullptr, float q8scale = 1.f) {
    const f32x4* xr = (const f32x4*)xrow + lane; const v2u* xh = (const v2u*)xrow + lane; const f32x4* gr = (const f32x4*)gam + lane; const f32x4* br = (const f32x4*)bet + lane;
    f32x4 v[8]; float s = 0.f;
#pragma unroll
    for (int j = 0; j < 8; ++j) { if constexpr (IN_BF16) { const v2u w = xh[64 * j]; v[j] = (f32x4){bflo(w.x), bfhi(w.x), bflo(w.y), bfhi(w.y)}; } else v[j] = xr[64 * j];
        s += (v[j][0] + v[j][1]) + (v[j][2] + v[j][3]); }
    const float mean = wave_sum(s) * (1.f / DM); float s2 = 0.f;
#pragma unroll
    for (int j = 0; j < 8; ++j) { v[j] = v[j] - mean; s2 += (v[j][0] * v[j][0] + v[j][1] * v[j][1]) + (v[j][2] * v[j][2] + v[j][3] * v[j][3]); }
    const float rstd = 1.f / sqrtf(wave_sum(s2) * (1.f / DM) + LN_EPS);
#pragma unroll
    for (int j = 0; j < 8; ++j) { const f32x4 o = v[j] * rstd * gr[64 * j] + br[64 * j];
        if constexpr (OUT_BF16) { v2u w; w.x = pk2(o[0], o[1]); w.y = pk2(o[2], o[3]); ((v2u*)orow)[lane + 64 * j] = w;
            if (q8row) q8row[lane + 64 * j] = pk4_fp8(o[0] * q8scale, o[1] * q8scale, o[2] * q8scale, o[3] * q8scale); }
        else ((f32x4*)orow)[lane + 64 * j] = o; }
}
template <bool OUT_BF16, bool IN_BF16 = false>
__device__ __forceinline__ void ln_row2(const void* xa, const void* xb_, void* oa, void* ob, const float* gam, const float* bet, int lane, unsigned* qa = nullptr, unsigned* qb = nullptr, float q8scale = 1.f, float2* sa = nullptr, float2* sb = nullptr) {
    const f32x4* gr = (const f32x4*)gam + lane; const f32x4* br = (const f32x4*)bet + lane;
    f32x4 v[2][8]; float s[2] = {0.f, 0.f};
#pragma unroll
    for (int r = 0; r < 2; ++r) { const void* xrow = r ? xb_ : xa; const f32x4* xr = (const f32x4*)xrow + lane; const v2u* xh = (const v2u*)xrow + lane;
#pragma unroll
        for (int j = 0; j < 8; ++j) { if constexpr (IN_BF16) { const v2u w = xh[64 * j]; v[r][j] = (f32x4){bflo(w.x), bfhi(w.x), bflo(w.y), bfhi(w.y)}; } else v[r][j] = xr[64 * j]; } }
#pragma unroll
    for (int r = 0; r < 2; ++r)
#pragma unroll
        for (int j = 0; j < 8; ++j) s[r] += (v[r][j][0] + v[r][j][1]) + (v[r][j][2] + v[r][j][3]);
    const float mean0 = wave_sum(s[0]) * (1.f / DM), mean1 = wave_sum(s[1]) * (1.f / DM); float s2[2] = {0.f, 0.f};
#pragma unroll
    for (int r = 0; r < 2; ++r) { const float mean = r ? mean1 : mean0;
#pragma unroll
        for (int j = 0; j < 8; ++j) { v[r][j] = v[r][j] - mean; s2[r] += (v[r][j][0] * v[r][j][0] + v[r][j][1] * v[r][j][1]) + (v[r][j][2] * v[r][j][2] + v[r][j][3] * v[r][j][3]); } }
    const float rstd0 = 1.f / sqrtf(wave_sum(s2[0]) * (1.f / DM) + LN_EPS), rstd1 = 1.f / sqrtf(wave_sum(s2[1]) * (1.f / DM) + LN_EPS);
    if (sa && lane == 0) { *sa = make_float2(mean0, rstd0); *sb = make_float2(mean1, rstd1); }
#pragma unroll
    for (int j = 0; j < 8; ++j) { const f32x4 g = gr[64 * j], b = br[64 * j];
#pragma unroll
        for (int r = 0; r < 2; ++r) { const f32x4 o = v[r][j] * (r ? rstd1 : rstd0) * g + b; void* orow = r ? ob : oa; unsigned* q8row = r ? qb : qa;
            if constexpr (OUT_BF16) { if (orow) { v2u w; w.x = pk2(o[0], o[1]); w.y = pk2(o[2], o[3]); ((v2u*)orow)[lane + 64 * j] = w; }
                if (q8row) q8row[lane + 64 * j] = pk4_fp8(o[0] * q8scale, o[1] * q8scale, o[2] * q8scale, o[3] * q8scale); }
            else ((f32x4*)orow)[lane + 64 * j] = o; } }
}
__device__ __forceinline__ float gelu_erf(float v) { return 0.5f * v * (1.0f + erff(v * 0.70710678118654752f)); }

__device__ __forceinline__ void ln_row2_mx6(const bf16* ra, const bf16* rb, const f32x4 (&g8)[8], const f32x4 (&b8)[8], int lane, unsigned char* qa, unsigned char* qb, float2* sa, float2* sb) {
    float v[2][32];
#pragma unroll
    for (int q = 0; q < 2; ++q) { const v4u* rp = (const v4u*)((q ? rb : ra) + 32 * lane);
#pragma unroll
        for (int j = 0; j < 4; ++j) { const v4u w = rp[j]; v[q][8 * j] = bflo(w.x); v[q][8 * j + 1] = bfhi(w.x); v[q][8 * j + 2] = bflo(w.y); v[q][8 * j + 3] = bfhi(w.y);
            v[q][8 * j + 4] = bflo(w.z); v[q][8 * j + 5] = bfhi(w.z); v[q][8 * j + 6] = bflo(w.w); v[q][8 * j + 7] = bfhi(w.w); } }
    float s0 = 0.f, s1 = 0.f;
#pragma unroll
    for (int i = 0; i < 32; ++i) { s0 += v[0][i]; s1 += v[1][i]; }
    const float mean0 = wave_sum(s0) * (1.f / DM), mean1 = wave_sum(s1) * (1.f / DM);
    float t0 = 0.f, t1 = 0.f;
#pragma unroll
    for (int i = 0; i < 32; ++i) { const float d0 = v[0][i] - mean0, d1 = v[1][i] - mean1; t0 = fmaf(d0, d0, t0); t1 = fmaf(d1, d1, t1); }
    const float rstd0 = 1.f / sqrtf(wave_sum(t0) * (1.f / DM) + LN_EPS), rstd1 = 1.f / sqrtf(wave_sum(t1) * (1.f / DM) + LN_EPS);
    if (lane == 0) { *sa = make_float2(mean0, rstd0); *sb = make_float2(mean1, rstd1); }
    v16f32 x0, y0, x1, y1;
#pragma unroll
    for (int j = 0; j < 8; ++j) { const f32x4 g = g8[j], b = b8[j];
#pragma unroll
        for (int e = 0; e < 4; ++e) { const int i = 4 * j + e; const float o0 = (v[0][i] - mean0) * rstd0 * g[e] + b[e], o1 = (v[1][i] - mean1) * rstd1 * g[e] + b[e];
            if (i < 16) { x0[i] = o0; x1[i] = o1; } else { y0[i - 16] = o0; y1[i - 16] = o1; } } }
    float a0, a1; MX6_AMAX(x0, y0, a0); MX6_AMAX(x1, y1, a1);
    mx6_store_block(qa, lane, x0, y0, a0); mx6_store_block(qb, lane, x1, y1, a1);
}

struct Args { const float* in[22]; float* out; unsigned char* ws; int ph_lo, ph_hi; };
constexpr int N_PHASES = 11;
__global__ void __launch_bounds__(NWAVES * 64, 2) mk_fwd(Args args) {
    extern __shared__ __attribute__((aligned(16))) unsigned char lds[];
    Frame F;
    F.lds = (LAS unsigned char*)lds;
    F.MISC = (volatile LAS unsigned*)(F.lds + MISC_OFF);
    F.tid = threadIdx.x; F.lane = F.tid & 63; F.wave = __builtin_amdgcn_readfirstlane(F.tid >> 6);
    F.G = gridDim.x; { const int bx = blockIdx.x; F.vcu = (F.G % 8 == 0) ? (bx % 8) * (F.G / 8) + bx / 8 : bx; }
    F.ws = args.ws; F.out = args.out; F.ctl = (unsigned*)(args.ws + WS_CTL);
#pragma unroll
    for (int i = 0; i < 22; ++i) F.in[i] = args.in[i];
    for (int u = F.tid; u < (LDS_BYTES - LDSCTL_OFF) / 4; u += NWAVES * 64) ((LAS unsigned*)(F.lds + LDSCTL_OFF))[u] = 0u;
    __syncthreads();
    const int lo = args.ph_lo, hi = args.ph_hi;
    XcdBarrier bar; bar.bar = F.ctl + CW_BAR; bar.x = 0; bar.st = nullptr;
    if (hi - lo > 1) bar = xcd_barrier_post(F.ctl + CW_BAR, F.MISC + 8);
#define IN(k) (lo <= (k) && (k) < hi)
#define SEAM(k) do { if (IN(k) && IN((k) + 1)) xcd_barrier(bar); } while (0)
    const int gw = F.vcu * NWAVES + F.wave, NGW = F.G * NWAVES;
    bf16* xb = (bf16*)(F.ws + WS_XB); bf16* proj = (bf16*)(F.ws + WS_PROJ); bf16* ygb = (bf16*)(F.ws + WS_YG); unsigned char* mix8 = (unsigned char*)(F.ws + WS_MIX);   unsigned char* act8 = (unsigned char*)(F.ws + WS_ACT);

    if (IN(0)) { p0_prologue(F); } SEAM(0);
    if (IN(1)) {
        const int c = (int)blockIdx.x; const bool g256 = (F.G == 256);
        pg8::ListOrder Sb, Sf;
        if (g256) { Sb.init(M, NPROJ - NP8, c, 256, c < 64 ? 2 : 1); Sf.init(M, NP8, c, 192, c < 64 ? 1 : 3); }
        else { Sb.init(M, NPROJ - NP8, c, F.G, 1 << 20); Sf.init(M, NP8, c, F.G, 1 << 20); }
        { pg8::Gemm g{xb, (const bf16*)(F.ws + WS_WIN) + (size_t)NP8 * DM, M, NPROJ - NP8, DM};
          pg8::EpiProj E{proj, NPROJ, (bf16*)(F.ws + WS_KIPACK), KI_OFF, SEQ, NP8, 1.f};
          pg8::gemm_phase<pg8::EpiProj, pg8::ListOrder, true, true, false>(F.lds + RING_OFF, g, Sb, E); }
        { pg8::Gemm g{(const bf16*)(F.ws + WS_MIX + 32 * MiB), (const bf16*)(F.ws + WS_WIN8), M, NP8, DM / 2};
          pg8::EpiProj E{proj, NPROJ, (bf16*)(F.ws + WS_KIPACK), KI_OFF, SEQ, 0, 1.f / (SC_X * SC_WIN)};
          pg8::gemm_phase<pg8::EpiProj, pg8::ListOrder, true, true, true>(F.lds + RING_OFF, g, Sf, E); }
    } SEAM(1);
    if (IN(2)) {
        { const int g = (F.vcu >> 2) & (NG - 1); LAS fl4* tInv = (LAS fl4*)(F.lds + RING_OFF); LAS fl4* tW = tInv + 2 * 8 * 64;
          for (int i = F.tid; i < 1024; i += NWAVES * 64) { tInv[i] = ((const fl4*)(F.ws + WS_TABINV))[g * 1024 + i]; tW[i] = ((const fl4*)(F.ws + WS_TABW))[g * 1024 + i]; }
          const int ib = F.vcu & 7;
          { const v4u* ksrc = (const v4u*)(F.ws + WS_KIPACK + (size_t)ib * 64 * 4096); LAS v4u* kdst = (LAS v4u*)(F.lds + RING_OFF + 32768);
#pragma unroll 4
            for (int i = F.tid; i < IDX_NLDS * 256; i += NWAVES * 64) kdst[i] = ksrc[i]; }
          LDS_WAIT(); __syncthreads();
          if ((F.wave & 2) == 0) { const int bb = 2 * (F.vcu & 3) + (F.wave & 1), half = F.wave >> 2;
              if (F.vcu < 4 * NG) ssm_mfma_task(F, bb, g, tInv, tW, ygb, 0, half ? SEQ / 64 : 0, half ? SEQ / 32 : SEQ / 64); }
          { LAS unsigned* ctr = (LAS unsigned*)(F.lds + MISC_OFF + 64); LAS unsigned* ctr2 = (LAS unsigned*)(F.lds + MISC_OFF + 68); const int ic = F.vcu >> 3, inb = (F.G - ib + 7) >> 3, npb = (SEQ / 2 + inb - 1) / inb;
            const LAS bf16* kl = (const LAS bf16*)(F.lds + RING_OFF + 32768) + F.lane * 8;
#pragma unroll 1
            for (int pass = 0; pass < 3; ++pass) {
                if (pass == 1) {
                    for (;;) { unsigned m = 0; if (F.lane == 0) m = __hip_atomic_fetch_add(ctr, 1u, __ATOMIC_RELAXED, __HIP_MEMORY_SCOPE_WORKGROUP);
                        m = __builtin_amdgcn_readfirstlane(m); if ((int)m >= npb) break;
                        const int k = (int)m * inb + ((m & 1u) ? inb - 1 - ic : ic); if (k >= SEQ / 2) continue;
                        int ibo; asm volatile("s_mov_b32 %0, %1" : "=s"(ibo) : "s"(ib));
                        idx_mfma_pair(F, ibo, 1023 - k, (unsigned*)(F.ws + WS_MASK), kl); }
                } else if (pass == 2 || F.wave == 7) {
                    for (;;) { unsigned m = 0; if (F.lane == 0) m = __hip_atomic_fetch_add(ctr2, 1u, __ATOMIC_RELAXED, __HIP_MEMORY_SCOPE_WORKGROUP);
                        m = __builtin_amdgcn_readfirstlane(m); const int it = (int)m * F.G + F.vcu; if (it >= P2W_ITEMS) break;
                        p2_weight_item(F, it); } }
            } } }
    } SEAM(2);
    if (IN(3)) {
        const unsigned* maskw = (const unsigned*)(F.ws + WS_MASK);
#pragma unroll 1
        for (int pi = F.vcu; pi < 256; pi += F.G) { const int b = pi >> 5, h = (pi >> 2) & 7, qp = pi & 3, c = h >> 2;
#pragma unroll 1
            for (int half = 0; half < 2; ++half) { const int qb = half ? qp : 7 - qp; const size_t row0 = (size_t)b * SEQ + qb * 256;
                att::attn_mask_body(proj + row0 * NPROJ + Q_OFF + h * HD, proj + (size_t)b * SEQ * NPROJ + K_OFF + c * HD, proj + (size_t)b * SEQ * NPROJ + V_OFF + c * HD,
                                    maskw + row0 * 64, mix8 + row0 * 2048 + 1024 + h * HD, 256 * (qb + 1), exp2f(-(float)(h + 1)) / att::SCALE, (char*)lds + RING_OFF);
                __syncthreads(); } }
    }
    if (IN(4)) { pg8::Gemm g{ygb, (const bf16*)(F.ws + WS_WGLU), M, SSMW, SSMW}; pg8::StaticOrder S; S.init(M, SSMW, F.G, (int)blockIdx.x);
        pg8::EpiGlu E{ygb, mix8, SSMW, 2048, F.in[I_BGLU], SC_MIX};
        pg8::gemm_phase<pg8::EpiGlu, pg8::StaticOrder, true, true>(F.lds + RING_OFF, g, S, E); } SEAM(4);
    if (IN(5)) { pg8::Gemm g{(const bf16*)mix8, (const bf16*)(F.ws + WS_WOUT), M, DM, 2048 / 2}; pg8::StaticOrder S; S.init(M, DM, F.G, (int)blockIdx.x);
        pg8::EpiRes<true, true> E{xb, F.out, DM, DN_ALPHA, 1.f / (SC_MIX * SC_WOUT)};
        pg8::gemm_phase<pg8::EpiRes<true, true>, pg8::StaticOrder, true, true, true>(F.lds + RING_OFF, g, S, E); } SEAM(5);
    if (IN(6)) { unsigned* q8 = (unsigned*)(F.ws + WS_MIX + 32 * MiB); const bf16* r1b = (const bf16*)F.out;
        f32x4 g8[8], b8[8];
#pragma unroll
        for (int j = 0; j < 8; ++j) { g8[j] = ((const f32x4*)(F.in[I_LN1G] + 32 * F.lane))[j]; b8[j] = ((const f32x4*)(F.in[I_LN1B] + 32 * F.lane))[j]; }
        for (int m = gw; m < M; m += 2 * NGW) { const int m2 = (m + NGW < M) ? m + NGW : m;
            ln_row2_mx6(r1b + (size_t)m * DM, r1b + (size_t)m2 * DM, g8, b8, F.lane, (unsigned char*)q8 + (size_t)m * DM, (unsigned char*)q8 + (size_t)m2 * DM,
                        (float2*)(F.ws + WS_RSTAT) + m, (float2*)(F.ws + WS_RSTAT) + m2); } } SEAM(6);
    if (IN(7)) { pg8::Gemm g{(const bf16*)(F.ws + WS_MIX + 32 * MiB), (const bf16*)(F.ws + WS_WUG), M, NUG, DM / 2}; pg8::StaticOrder S; S.init(M, NUG, F.G, (int)blockIdx.x);
        pg8::EpiFfn E{act8, (float*)(F.ws + WS_PEND_UP), (float*)(F.ws + WS_PEND_G), (float*)(F.ws + WS_HALO), F.in[I_CONVW], F.in[I_CONVB], DFF, 1.f, SC_ACT};
        pg8::gemm_phase<pg8::EpiFfn, pg8::StaticOrder, true, true, true, true>(F.lds + RING_OFF, g, S, E); } SEAM(7);
    if (IN(8)) { const float* pu = (const float*)(F.ws + WS_PEND_UP); const float* pg = (const float*)(F.ws + WS_PEND_G); const float* ph = (const float*)(F.ws + WS_HALO);
        const float* cw = F.in[I_CONVW]; const float* cb = F.in[I_CONVB];
        for (int idx = F.vcu * 512 + F.tid; idx < 512 * (DFF / 4); idx += F.G * 512) { const int r2 = idx / (DFF / 4), f = (idx % (DFF / 4)) * 4, rb = r2 >> 1, rho = r2 & 1; const bool first = (rb & 31) == 0;
            const f32x4 x0 = *(const f32x4*)(pu + (size_t)r2 * DFF + f), gt = *(const f32x4*)(pg + (size_t)r2 * DFF + f); const f32x4 z = {0.f, 0.f, 0.f, 0.f};
            f32x4 h1, h2;
            if (rho == 0) { h1 = first ? z : *(const f32x4*)(ph + (size_t)((rb - 1) * 2 + 1) * DFF + f); h2 = first ? z : *(const f32x4*)(ph + (size_t)((rb - 1) * 2) * DFF + f); }
            else { h1 = *(const f32x4*)(pu + (size_t)(rb * 2) * DFF + f); h2 = first ? z : *(const f32x4*)(ph + (size_t)((rb - 1) * 2 + 1) * DFF + f); }
            const f32x4 hc = *(const f32x4*)(cb + f) + *(const f32x4*)(cw + f) * h2 + *(const f32x4*)(cw + DFF + f) * h1 + *(const f32x4*)(cw + 2 * DFF + f) * x0;
            *(unsigned*)(act8 + (size_t)(rb * 64 + rho) * DFF + f) = pk4_fp8(gelu_erf(hc[0]) * gt[0] * SC_ACT, gelu_erf(hc[1]) * gt[1] * SC_ACT, gelu_erf(hc[2]) * gt[2] * SC_ACT, gelu_erf(hc[3]) * gt[3] * SC_ACT); } } SEAM(8);
    if (IN(9)) { pg8::Gemm g{(const bf16*)act8, (const bf16*)(F.ws + WS_WDOWN), M, DM, DFF / 2}; pg8::StaticOrder S; S.init(M, DM, F.G, (int)blockIdx.x);
        pg8::EpiDownLN E{(const bf16*)F.out, (bf16*)(F.ws + WS_MIX), (const pg8::f32x2*)(F.ws + WS_RSTAT), F.in[I_LN1G], F.in[I_LN1B], DM, DN_ALPHA, 1.f / (SC_ACT * SC_WDN)};
        pg8::gemm_phase<pg8::EpiDownLN, pg8::StaticOrder, true, true, true>(F.lds + RING_OFF, g, S, E); } SEAM(9);
    if (IN(10)) { const bf16* r2b = (const bf16*)(F.ws + WS_MIX);
        for (int m = gw; m < M; m += 2 * NGW) { const int m2 = (m + NGW < M) ? m + NGW : m;
            ln_row2<false, true>(r2b + (size_t)m * DM, r2b + (size_t)m2 * DM, F.out + (size_t)m * DM, F.out + (size_t)m2 * DM, F.in[I_LN2G], F.in[I_LN2B], F.lane); }
    }
#undef IN
#undef SEAM
}

#ifndef MK_ONE_LAUNCH
#define MK_ONE_LAUNCH 1
#endif
extern "C" void kernel_launch(void* const* d_in, const int* in_sizes, int n_in, void* d_out, int out_size, void* d_ws, size_t ws_size, hipStream_t stream) {
    static int grid = 0;
    if (grid == 0) {
        if (n_in != 22 || in_sizes[0] != M * DM || out_size != M * DM || ws_size < WS_END) { fprintf(stderr, "kernel_launch: shape/workspace mismatch (n_in %d, in0 %d, out %d, ws %zu, need %zu)\n", n_in, n_in > 0 ? in_sizes[0] : -1, out_size, ws_size, (size_t)WS_END); grid = -1; return; }
        int dev = 0, cus = 0, per_cu = 0;
        if (hipGetDevice(&dev) != hipSuccess || hipDeviceGetAttribute(&cus, hipDeviceAttributeMultiprocessorCount, dev) != hipSuccess) { grid = -1; return; }
        if (hipFuncSetAttribute((const void*)mk_fwd, hipFuncAttributeMaxDynamicSharedMemorySize, LDS_BYTES) != hipSuccess) { fprintf(stderr, "kernel_launch: hipFuncSetAttribute failed\n"); grid = -1; return; }
        if (hipOccupancyMaxActiveBlocksPerMultiprocessor(&per_cu, (const void*)mk_fwd, NWAVES * 64, LDS_BYTES) != hipSuccess || per_cu < 1) fprintf(stderr, "kernel_launch: occupancy query reports %d\n", per_cu);
        (void)hipGetLastError();
        grid = cus;
    }
    if (grid < 0) return;
    if (hipMemsetAsync((char*)d_ws + WS_CTL, 0, CTL_ZERO_BYTES, stream) != hipSuccess) return;
    Args a{};
    for (int i = 0; i < 22; ++i) a.in[i] = (const float*)d_in[i];
    a.out = (float*)d_out; a.ws = (unsigned char*)d_ws;
#if MK_ONE_LAUNCH
    a.ph_lo = 0; a.ph_hi = N_PHASES;
    hipLaunchKernelGGL(mk_fwd, dim3(grid), dim3(NWAVES * 64), LDS_BYTES, stream, a);
#else
    for (int p = 0; p < N_PHASES; ++p) { a.ph_lo = p; a.ph_hi = p + 1; hipLaunchKernelGGL(mk_fwd, dim3(grid), dim3(NWAVES * 64), LDS_BYTES, stream, a); }
#endif
}
```

```cpp
#include <hip/hip_runtime.h>
#include <cstdio>
#include <cstdint>
namespace pg8 {
#define PG8_LAS __attribute__((address_space(3)))
typedef unsigned short bf16_t;
typedef short bf16x8 __attribute__((ext_vector_type(8)));
typedef float f32x4 __attribute__((ext_vector_type(4)));
typedef unsigned u32x4 __attribute__((ext_vector_type(4)));
typedef int v8i32 __attribute__((ext_vector_type(8)));
constexpr int BM = 256, BK = 64, HALF = 128, HTB = HALF * BK * 2  , STAGE_BYTES = 8 * HTB, NXCD = 8, WGM = 8;

__host__ __device__ __forceinline__ int lds_byte(int r, int c) { const int st = (r >> 4) * 2 + (c >> 5), rr = r & 15, cc = c & 31, ob = rr * 64 + cc * 2; return st * 1024 + (ob ^ (((ob >> 9) & 1) << 5)); }
__host__ __device__ __forceinline__ void stage_rc(int b, int& R, int& C) { const int st = b / 1024, sb = b % 1024, swz = sb ^ (((sb >> 9) & 1) << 5); R = (st >> 1) * 16 + swz / 64; C = (st & 1) * 32 + (swz % 64) / 2; }
__host__ __device__ __forceinline__ int perm32(int rho) { const int n = rho >> 4, i = rho & 15; return 8 * (i >> 2) + 4 * n + (i & 3); }

struct Unit { int pm, pn; };
struct Gemm { const bf16_t* A; const bf16_t* Bt; int M, N, K; };

struct StaticOrder {
    int nM, nN, nwg, G, c;
    __host__ __device__ void init(int M, int N, int G_, int c_) { nM = M / BM; nN = N / BM; nwg = nM * nN; G = G_; c = c_; }
    __host__ __device__ bool next(int i, Unit& u) const {
        const long L = (long)i * G + c; if (L >= nwg) return false;
        int wgid = (int)L; { const int q = nwg / NXCD, r = nwg % NXCD, xcd = wgid % NXCD, off = wgid / NXCD; wgid = (xcd < r ? xcd * (q + 1) : r * (q + 1) + (xcd - r) * q) + off; }
        const int nig = WGM * nN, gid = wgid / nig, fm = gid * WGM, gsz = (nM - fm) < WGM ? (nM - fm) : WGM;
        u.pm = fm + ((wgid % nig) % gsz); u.pn = (wgid % nig) / gsz; return true;
    }
    __device__ __forceinline__ void a_ready(const Unit&) const {}
    __device__ __forceinline__ void done(const Unit&) const {}
};

struct ListOrder {
    int nM, nN, nwg, L0, dL, cnt;
    __host__ __device__ void init(int M, int N, int L0_, int dL_, int cnt_) { nM = M / BM; nN = N / BM; nwg = nM * nN; L0 = L0_; dL = dL_; cnt = cnt_; }
    __host__ __device__ bool next(int i, Unit& u) const {
        if (i >= cnt) return false; const int L = L0 + i * dL; if (L >= nwg) return false;
        int wgid = L; { const int q = nwg / NXCD, r = nwg % NXCD, xcd = wgid % NXCD, off = wgid / NXCD; wgid = (xcd < r ? xcd * (q + 1) : r * (q + 1) + (xcd - r) * q) + off; }
        const int nig = WGM * nN, gid = wgid / nig, fm = gid * WGM, gsz = (nM - fm) < WGM ? (nM - fm) : WGM;
        u.pm = fm + ((wgid % nig) % gsz); u.pn = (wgid % nig) / gsz; return true;
    }
    __device__ __forceinline__ void a_ready(const Unit&) const {}
    __device__ __forceinline__ void done(const Unit&) const {}
};

__device__ __forceinline__ unsigned cvt_pk_bf16(float lo, float hi) { unsigned r; asm volatile("v_cvt_pk_bf16_f32 %0, %1, %2" : "=v"(r) : "v"(lo), "v"(hi)); return r; }
typedef float f32x2 __attribute__((ext_vector_type(2)));
__device__ __forceinline__ f32x2 gelu_pk(f32x2 v) {
    f32x2 vc; vc.x = __builtin_amdgcn_fmed3f(v.x, -4.6f, 4.6f); vc.y = __builtin_amdgcn_fmed3f(v.y, -4.6f, 4.6f);
    const f32x2 w = vc * vc;
    f32x2 r = w * 7.3846917937e-14f + (-9.6073152826e-12f);
    r = r * w + 5.6255834838e-10f; r = r * w + (-1.9781858177e-08f); r = r * w + 4.7227388803e-07f; r = r * w + (-8.2408235147e-06f); r = r * w + 1.1056416036e-04f;
    r = r * w + (-1.1755027258e-03f); r = r * w + 9.9585457053e-03f; r = r * w + (-6.6482846440e-02f); r = r * w + 3.9894164923e-01f;
    return v * (vc * r + 0.5f);
}

template <int ACT  > struct EpiBf16 {
    static constexpr bool PERM = true, AFTER_DRAIN = false; static_assert(ACT == 0 || ACT == 1, "EpiBf16: ACT is 0 (none) or 1 (gelu_pk)");
    bf16_t* O; int ldc; const float* bias; int split_cols; size_t split_stride; float scale0;
    __device__ __forceinline__ void operator()(const f32x4 (&acc)[2][2][4][2], const Unit& u, int wr, int wc, int fr, int fq) const {
        const int row0 = u.pm * BM + wr * 64 + fr; int colt = u.pn * BM; bf16_t* base = O;
        float sc = 1.f; if (split_cols) { const int t = colt / split_cols; base += (size_t)t * split_stride; colt -= t * split_cols; if (t == 0) sc = scale0; }
        const int col0 = colt + wc * 32 + 8 * fq, bcol0 = u.pn * BM + wc * 32 + 8 * fq;
        f32x4 bv[2][2];
#pragma unroll
        for (int bj = 0; bj < 2; ++bj)
#pragma unroll
            for (int n = 0; n < 2; ++n) bv[bj][n] = bias ? *(const f32x4*)(bias + bcol0 + bj * HALF + 4 * n) : (f32x4){0.f, 0.f, 0.f, 0.f};
#pragma unroll
        for (int ai = 0; ai < 2; ++ai)
#pragma unroll
            for (int m = 0; m < 4; ++m) { bf16_t* rowp = base + (size_t)(row0 + ai * HALF + m * 16) * ldc + col0;
#pragma unroll
                for (int bj = 0; bj < 2; ++bj) { f32x4 v0 = acc[ai][bj][m][0] + bv[bj][0], v1 = acc[ai][bj][m][1] + bv[bj][1];
                    if (ACT == 1) { f32x2 a = gelu_pk((f32x2){v0[0], v0[1]}), b = gelu_pk((f32x2){v0[2], v0[3]}), c = gelu_pk((f32x2){v1[0], v1[1]}), d = gelu_pk((f32x2){v1[2], v1[3]});
                        v0 = (f32x4){a.x, a.y, b.x, b.y}; v1 = (f32x4){c.x, c.y, d.x, d.y}; }
                    v0 = v0 * sc; v1 = v1 * sc; u32x4 w; w.x = cvt_pk_bf16(v0[0], v0[1]); w.y = cvt_pk_bf16(v0[2], v0[3]); w.z = cvt_pk_bf16(v1[0], v1[1]); w.w = cvt_pk_bf16(v1[2], v1[3]);
                    *(u32x4*)(rowp + bj * HALF) = w; } }
    }
};

__device__ __forceinline__ float bf2f(unsigned short b) { return __uint_as_float(((unsigned)b) << 16); }
__device__ __forceinline__ float bflo(unsigned w) { return __uint_as_float(w << 16); }
__device__ __forceinline__ float bfhi(unsigned w) { return __uint_as_float(w & 0xffff0000u); }
__device__ __forceinline__ float dpp_ror1(float x) { return __builtin_bit_cast(float, __builtin_amdgcn_update_dpp(0, __builtin_bit_cast(int, x), 0x121, 0xf, 0xf, false)); }
__device__ __forceinline__ float dpp_ror2(float x) { return __builtin_bit_cast(float, __builtin_amdgcn_update_dpp(0, __builtin_bit_cast(int, x), 0x122, 0xf, 0xf, false)); }
__device__ __forceinline__ float clamp448(float v) { return __builtin_amdgcn_fmed3f(v, -448.f, 448.f); }
__device__ __forceinline__ unsigned pk4_fp8(float a, float b, float c, float d) {
    int w = 0; w = __builtin_amdgcn_cvt_pk_fp8_f32(clamp448(a), clamp448(b), w, false); w = __builtin_amdgcn_cvt_pk_fp8_f32(clamp448(c), clamp448(d), w, true); return (unsigned)w; }
__device__ __forceinline__ float sigmoidf_fast(float v) { return __builtin_amdgcn_rcpf(1.0f + __builtin_amdgcn_exp2f(-1.4426950408889634f * v)); }

struct EpiProj {
    static constexpr bool PERM = true, AFTER_DRAIN = false;
    bf16_t* O; int ldc; bf16_t* kipack; int kcol0; int seq; int col_off; float ascale;
    __device__ __forceinline__ void operator()(const f32x4 (&acc)[2][2][4][2], const Unit& u, int wr, int wc, int fr, int fq) const {
        const int row0 = u.pm * BM + wr * 64 + fr, col0 = col_off + u.pn * BM + wc * 32 + 8 * fq;
        const bool kt_tile = (col_off + u.pn * BM == kcol0) && (wc < 2);
#pragma unroll
        for (int ai = 0; ai < 2; ++ai)
#pragma unroll
            for (int m = 0; m < 4; ++m) { const int row = row0 + ai * HALF + m * 16; bf16_t* rowp = O + (size_t)row * ldc + col0;
#pragma unroll
                for (int bj = 0; bj < 2; ++bj) { const f32x4 v0 = acc[ai][bj][m][0] * ascale, v1 = acc[ai][bj][m][1] * ascale;
                    u32x4 w; w.x = cvt_pk_bf16(v0[0], v0[1]); w.y = cvt_pk_bf16(v0[2], v0[3]); w.z = cvt_pk_bf16(v1[0], v1[1]); w.w = cvt_pk_bf16(v1[2], v1[3]);
                    *(u32x4*)(rowp + bj * HALF) = w;
                    if (bj == 0 && kt_tile) { const int b = row / seq, t = row % seq, d0 = wc * 32 + 8 * fq;
                        *(u32x4*)(kipack + ((size_t)((b * (seq / 32) + (t >> 5)) * 4 + (d0 >> 4)) * 64 + (t & 31) + 32 * ((d0 >> 3) & 1)) * 8) = w; } } }
    }
};
struct EpiGlu {
    static constexpr bool PERM = true, AFTER_DRAIN = false;
    const bf16_t* yg; unsigned char* O; int ldy, ldo; const float* bias; float oscale;
    __device__ __forceinline__ void operator()(const f32x4 (&acc)[2][2][4][2], const Unit& u, int wr, int wc, int fr, int fq) const {
        const int row0 = u.pm * BM + wr * 64 + fr, col0 = u.pn * BM + wc * 32 + 8 * fq;
        f32x4 bv[2][2];
#pragma unroll
        for (int bj = 0; bj < 2; ++bj)
#pragma unroll
            for (int n = 0; n < 2; ++n) bv[bj][n] = *(const f32x4*)(bias + col0 + bj * HALF + 4 * n);
#pragma unroll
        for (int ai = 0; ai < 2; ++ai)
#pragma unroll
            for (int m = 0; m < 4; ++m) { const size_t row = (size_t)(row0 + ai * HALF + m * 16);
#pragma unroll
                for (int bj = 0; bj < 2; ++bj) { const int c = col0 + bj * HALF;
                    const u32x4 yv = *(const u32x4*)(yg + row * ldy + c);
                    const f32x4 v0 = acc[ai][bj][m][0] + bv[bj][0], v1 = acc[ai][bj][m][1] + bv[bj][1];
                    float o[8];
                    o[0] = bflo(yv.x) * sigmoidf_fast(v0[0]); o[1] = bfhi(yv.x) * sigmoidf_fast(v0[1]); o[2] = bflo(yv.y) * sigmoidf_fast(v0[2]); o[3] = bfhi(yv.y) * sigmoidf_fast(v0[3]);
                    o[4] = bflo(yv.z) * sigmoidf_fast(v1[0]); o[5] = bfhi(yv.z) * sigmoidf_fast(v1[1]); o[6] = bflo(yv.w) * sigmoidf_fast(v1[2]); o[7] = bfhi(yv.w) * sigmoidf_fast(v1[3]);
                    typedef unsigned u32x2v __attribute__((ext_vector_type(2))); const float os = oscale;
                    u32x2v w; w.x = pk4_fp8(o[0] * os, o[1] * os, o[2] * os, o[3] * os); w.y = pk4_fp8(o[4] * os, o[5] * os, o[6] * os, o[7] * os);
                    *(u32x2v*)(O + row * ldo + c) = w; } }
    }
};
template <bool RES_BF16, bool OUT_BF16 = false> struct EpiRes {
    static constexpr bool PERM = false, AFTER_DRAIN = false;
    const void* res; float* out; int ldc; float alpha; float ascale;
    __device__ __forceinline__ void operator()(const f32x4 (&acc)[2][2][4][2], const Unit& u, int wr, int wc, int fr, int fq) const {
        typedef unsigned u32x2v __attribute__((ext_vector_type(2)));
        const int row0 = u.pm * BM + wr * 64 + fr, col0 = u.pn * BM + wc * 32 + 4 * fq;
#pragma unroll
        for (int ai = 0; ai < 2; ++ai)
#pragma unroll
            for (int m = 0; m < 4; ++m) { const size_t off = (size_t)(row0 + ai * HALF + m * 16) * ldc + col0;
#pragma unroll
                for (int bj = 0; bj < 2; ++bj)
#pragma unroll
                    for (int n = 0; n < 2; ++n) { const size_t o2 = off + bj * HALF + n * 16; f32x4 r;
                        if constexpr (RES_BF16) { const u32x2v w = *(const u32x2v*)((const bf16_t*)res + o2); r = (f32x4){bflo(w.x), bfhi(w.x), bflo(w.y), bfhi(w.y)}; }
                        else r = *(const f32x4*)((const float*)res + o2);
                        const f32x4 o = r * alpha + acc[ai][bj][m][n] * ascale;
                        if constexpr (OUT_BF16) { u32x2v w; w.x = cvt_pk_bf16(o[0], o[1]); w.y = cvt_pk_bf16(o[2], o[3]); *(u32x2v*)((bf16_t*)out + o2) = w; }
                        else *(f32x4*)(out + o2) = o; } }
    }
};
struct EpiDownLN {
    static constexpr bool PERM = false, AFTER_DRAIN = false;
    const bf16_t* r1; bf16_t* out; const f32x2* rstat; const float* gam; const float* bet; int ldc; float alpha, ascale;
    __device__ __forceinline__ void operator()(const f32x4 (&acc)[2][2][4][2], const Unit& u, int wr, int wc, int fr, int fq) const {
        typedef unsigned u32x2v __attribute__((ext_vector_type(2)));
        const int row0 = u.pm * BM + wr * 64 + fr, col0 = u.pn * BM + wc * 32 + 4 * fq;
        f32x4 gv[2][2], bv[2][2];
#pragma unroll
        for (int bj = 0; bj < 2; ++bj)
#pragma unroll
            for (int n = 0; n < 2; ++n) { gv[bj][n] = *(const f32x4*)(gam + col0 + bj * HALF + n * 16) * alpha; bv[bj][n] = *(const f32x4*)(bet + col0 + bj * HALF + n * 16) * alpha; }
#pragma unroll
        for (int ai = 0; ai < 2; ++ai)
#pragma unroll
            for (int m = 0; m < 4; ++m) { const int row = row0 + ai * HALF + m * 16; const f32x2 st = rstat[row]; const size_t off = (size_t)row * ldc + col0;
#pragma unroll
                for (int bj = 0; bj < 2; ++bj)
#pragma unroll
                    for (int n = 0; n < 2; ++n) { const size_t o2 = off + bj * HALF + n * 16; const u32x2v w0 = *(const u32x2v*)(r1 + o2);
                        const f32x4 r = {bflo(w0.x), bfhi(w0.x), bflo(w0.y), bfhi(w0.y)};
                        const f32x4 o = (r - st.x) * st.y * gv[bj][n] + bv[bj][n] + acc[ai][bj][m][n] * ascale;
                        u32x2v w; w.x = cvt_pk_bf16(o[0], o[1]); w.y = cvt_pk_bf16(o[2], o[3]); *(u32x2v*)(out + o2) = w; } }
    }
};
struct EpiFfn {
    static constexpr bool PERM = true, AFTER_DRAIN = false;
    unsigned char* act; float* pend_up; float* pend_gate; float* halo_up; const float* cw; const float* cb; int ldc; float ascale, oscale;
    __device__ __forceinline__ void operator()(const f32x4 (&acc)[2][2][4][2], const Unit& u, int wr, int wc, int fr, int fq) const {
        const int f0 = u.pn * HALF + wc * 32 + 8 * fq;
        float c0[8], c1[8], c2[8], cbv[8];
        { const f32x4 a0 = *(const f32x4*)(cw + f0), a1 = *(const f32x4*)(cw + f0 + 4), b0 = *(const f32x4*)(cw + ldc + f0), b1 = *(const f32x4*)(cw + ldc + f0 + 4);
          const f32x4 d0 = *(const f32x4*)(cw + 2 * ldc + f0), d1 = *(const f32x4*)(cw + 2 * ldc + f0 + 4), e0 = *(const f32x4*)(cb + f0), e1 = *(const f32x4*)(cb + f0 + 4);
#pragma unroll
          for (int j = 0; j < 4; ++j) { c0[j] = a0[j] * ascale; c0[4 + j] = a1[j] * ascale; c1[j] = b0[j] * ascale; c1[4 + j] = b1[j] * ascale; c2[j] = d0[j] * ascale; c2[4 + j] = d1[j] * ascale; cbv[j] = e0[j]; cbv[4 + j] = e1[j]; } }
        const float gs = ascale * oscale;
#pragma unroll
        for (int ai = 0; ai < 2; ++ai) {
            const int rb = u.pm * 4 + ai * 2 + wr;
#pragma unroll
            for (int m = 0; m < 4; ++m) {
                const size_t row = (size_t)(rb * 64 + m * 16 + fr);
                float a[8];
#pragma unroll
                for (int n = 0; n < 2; ++n)
#pragma unroll
                    for (int j = 0; j < 4; ++j) { const int e = 4 * n + j;
                        const float x0 = acc[ai][0][m][n][j];
                        float h1 = dpp_ror1(x0), h2 = dpp_ror2(x0);
                        if (m > 0) { const float xm = acc[ai][0][m - 1][n][j]; const float q1 = dpp_ror1(xm), q2 = dpp_ror2(xm); h1 = fr >= 1 ? h1 : q1; h2 = fr >= 2 ? h2 : q2; }
                        a[e] = cbv[e] + c0[e] * h2 + c1[e] * h1 + c2[e] * x0; }
                const f32x2 g0 = gelu_pk((f32x2){a[0], a[1]}), g1 = gelu_pk((f32x2){a[2], a[3]}), g2 = gelu_pk((f32x2){a[4], a[5]}), g3 = gelu_pk((f32x2){a[6], a[7]});
                const f32x4 gr0 = acc[ai][1][m][0], gr1 = acc[ai][1][m][1];
                const f32x2 o0 = g0 * (f32x2){gr0[0], gr0[1]} * gs, o1 = g1 * (f32x2){gr0[2], gr0[3]} * gs, o2 = g2 * (f32x2){gr1[0], gr1[1]} * gs, o3 = g3 * (f32x2){gr1[2], gr1[3]} * gs;
                typedef unsigned u32x2v __attribute__((ext_vector_type(2)));
                u32x2v w; w.x = pk4_fp8(o0.x, o0.y, o1.x, o1.y); w.y = pk4_fp8(o2.x, o2.y, o3.x, o3.y);
                if (m == 0) {
                    if (fr >= 2) *(u32x2v*)(act + row * ldc + f0) = w;
                    else { float* pu = pend_up + (size_t)(rb * 2 + fr) * ldc + f0; float* pg = pend_gate + (size_t)(rb * 2 + fr) * ldc + f0;
                        *(f32x4*)pu = acc[ai][0][m][0] * ascale; *(f32x4*)(pu + 4) = acc[ai][0][m][1] * ascale; *(f32x4*)pg = gr0 * ascale; *(f32x4*)(pg + 4) = gr1 * ascale; }
                } else {
                    *(u32x2v*)(act + row * ldc + f0) = w;
                    if (m == 3 && fr >= 14) { float* ph = halo_up + (size_t)(rb * 2 + (fr - 14)) * ldc + f0; *(f32x4*)ph = acc[ai][0][m][0] * ascale; *(f32x4*)(ph + 4) = acc[ai][0][m][1] * ascale; }
                }
            }
        }
    }
};
template <class Epi, class Sched, bool ALIGN_EPI = false, bool SP2 = false, bool F8 = false, bool F6 = false>
__device__ __forceinline__ void gemm_phase(PG8_LAS unsigned char* lds, const Gemm g, const Sched& S, const Epi& E) {
    const int tid = threadIdx.x, wid = __builtin_amdgcn_readfirstlane(tid >> 6), lane = tid & 63, wr = wid >> 2, wc = wid & 3, fr = lane & 15, fq = lane >> 4;
    const int K = g.K, nt = K / BK;
    unsigned voffA[2], voffB[2];
#pragma unroll
    for (int i = 0; i < 2; ++i) { int R, C; stage_rc(tid * 16 + i * 8192, R, C); const int Rb = Epi::PERM ? ((R & ~31) + perm32(R & 31)) : R;
        voffA[i] = (unsigned)(R * K + C) * 2u; voffB[i] = (unsigned)(Rb * K + C) * 2u; }
    const size_t kstep = (size_t)(BK * 2);
    const size_t hstep = (size_t)HALF * K * 2;
    const size_t tstep = 2 * hstep;
    const unsigned ldsw = (unsigned)wid * 1024u;
    const int aoff = lds_byte(wr * 64 + fr, fq * 8), boff = lds_byte(wc * 32 + fr, fq * 8);
#define PG8_SA(b, h) (((b) * 2 + (h)) * HTB)
#define PG8_SB(b, h) ((4 + (b) * 2 + (h)) * HTB)
#define PG8_STAGE(bufoff, gbase, voff) do { _Pragma("unroll") for (int _i = 0; _i < 2; ++_i) \
        __builtin_amdgcn_global_load_lds((const unsigned*)((const char*)(gbase) + (voff)[_i]), (PG8_LAS unsigned*)(lds + (bufoff) + ldsw + _i * 8192), 16, 0, 0); } while (0)
#define PG8_LDA(dst, b, h) do { _Pragma("unroll") for (int m = 0; m < 4; ++m) _Pragma("unroll") for (int k = 0; k < 2; ++k) dst[m][k] = *(const PG8_LAS bf16x8*)(lds + PG8_SA(b, h) + aoff + m * 2048 + k * 1024); } while (0)
#define PG8_LDB(dst, b, h) do { _Pragma("unroll") for (int n = 0; n < 2; ++n) _Pragma("unroll") for (int k = 0; k < 2; ++k) dst[n][k] = *(const PG8_LAS bf16x8*)(lds + PG8_SB(b, h) + boff + n * 2048 + k * 1024); } while (0)
#define PG8_CAT(lo, hi) __builtin_bit_cast(v8i32, __builtin_shufflevector(lo, hi, 0, 1, 2, 3, 4, 5, 6, 7, 8, 9, 10, 11, 12, 13, 14, 15))
#define PG8_MMA(ai, bj, At, Bt) do { __builtin_amdgcn_s_setprio(1); _Pragma("unroll") for (int m = 0; m < 4; ++m) _Pragma("unroll") for (int n = 0; n < 2; ++n) { \
        if constexpr (F8 && F6) { const v8i32 cb_ = PG8_CAT(Bt[n][0], Bt[n][1]), ca_ = PG8_CAT(At[m][0], At[m][1]); \
            asm volatile("s_nop 3\n\tv_mfma_scale_f32_16x16x128_f8f6f4 %0, %1, %2, %0, %3, %4 op_sel_hi:[0,0,0] cbsz:2 blgp:2" : "+v"(acc[ai][bj][m][n]) \
                         : "v"(__builtin_shufflevector(cb_, cb_, 0, 1, 2, 3, 4, 5)), "v"(__builtin_shufflevector(ca_, ca_, 0, 1, 2, 3, 4, 5)), "v"(cb_[6]), "v"(ca_[6])); } \
        else if constexpr (F8) asm volatile("v_mfma_scale_f32_16x16x128_f8f6f4 %0, %1, %2, %0, %3, %3 op_sel_hi:[0,0,0]" : "+v"(acc[ai][bj][m][n]) : "v"(PG8_CAT(Bt[n][0], Bt[n][1])), "v"(PG8_CAT(At[m][0], At[m][1])), "v"(f8scale)); \
        else { _Pragma("unroll") for (int k = 0; k < 2; ++k) acc[ai][bj][m][n] = __builtin_amdgcn_mfma_f32_16x16x32_bf16(Bt[n][k], At[m][k], acc[ai][bj][m][n], 0, 0, 0); } } __builtin_amdgcn_s_setprio(0); } while (0)
#define PG8_WAIT_V(n) asm volatile("s_waitcnt vmcnt(" #n ")" ::: "memory")
#define PG8_WAIT_L(n) asm volatile("s_waitcnt lgkmcnt(" #n ")" ::: "memory")
#define PG8_BAR __builtin_amdgcn_s_barrier()
#define PG8_SCHED __builtin_amdgcn_sched_barrier(0)
    Unit cur, nxt; int ui = 0;
    if (!S.next(0, cur)) return;
    const int f8scale = 0x7F7F7F7F;
    f32x4 acc[2][2][4][2];
#pragma unroll
    for (int a = 0; a < 2; ++a)
#pragma unroll
        for (int b = 0; b < 2; ++b)
#pragma unroll
            for (int m = 0; m < 4; ++m)
#pragma unroll
                for (int n = 0; n < 2; ++n) acc[a][b][m][n] = (f32x4){0.f, 0.f, 0.f, 0.f};
    bf16x8 At[4][2], B0[2][2], B1[2][2];
    const char* cA = (const char*)g.A + (size_t)cur.pm * tstep; const char* cB = (const char*)g.Bt + (size_t)cur.pn * tstep;
    S.a_ready(cur);
    if constexpr (SP2) {
        PG8_STAGE(PG8_SB(0, 0), cB, voffB); PG8_STAGE(PG8_SB(0, 1), cB + hstep, voffB); PG8_STAGE(PG8_SA(0, 0), cA, voffA); PG8_STAGE(PG8_SA(0, 1), cA + hstep, voffA);
        if (wr == 1) PG8_BAR;
        PG8_WAIT_V(2); PG8_BAR;
        PG8_STAGE(PG8_SB(1, 0), cB + kstep, voffB); PG8_STAGE(PG8_SA(1, 0), cA + kstep, voffA); PG8_STAGE(PG8_SB(1, 1), cB + hstep + kstep, voffB);
        PG8_WAIT_V(6); PG8_BAR;
    } else {
        PG8_STAGE(PG8_SB(0, 0), cB, voffB); PG8_STAGE(PG8_SA(0, 0), cA, voffA); PG8_STAGE(PG8_SB(0, 1), cB + hstep, voffB); PG8_STAGE(PG8_SA(0, 1), cA + hstep, voffA);
        if (wr == 1) PG8_BAR;
        PG8_WAIT_V(4); PG8_BAR;
        PG8_STAGE(PG8_SB(1, 0), cB + kstep, voffB); PG8_STAGE(PG8_SA(1, 0), cA + kstep, voffA); PG8_STAGE(PG8_SB(1, 1), cB + hstep + kstep, voffB);
        PG8_WAIT_V(6); PG8_BAR;
    }
    for (;;) {
        const bool has_next = S.next(ui + 1, nxt);
        const char* nA = has_next ? (const char*)g.A + (size_t)nxt.pm * tstep : cA; const char* nB = has_next ? (const char*)g.Bt + (size_t)nxt.pn * tstep : cB;
        for (int t = 0; t < nt; t += 2) {
            const bool last = (t == nt - 2);
            const char* a1 = cA + (size_t)(t + 1) * kstep;
            const char* a2 = last ? nA : cA + (size_t)(t + 2) * kstep; const char* b2 = last ? nB : cB + (size_t)(t + 2) * kstep;
            const char* a3 = a2 + kstep; const char* b3 = b2 + kstep;
            if (last && has_next) S.a_ready(nxt);
            if constexpr (SP2) {
            PG8_LDB(B0, 0, 0); PG8_LDB(B1, 0, 1); PG8_SCHED; PG8_LDA(At, 0, 0); PG8_STAGE(PG8_SA(1, 1), a1 + hstep, voffA);
            PG8_WAIT_V(8); PG8_WAIT_L(0); PG8_BAR; PG8_MMA(0, 0, At, B0); PG8_MMA(0, 1, At, B1); PG8_BAR; PG8_SCHED;
            PG8_LDA(At, 0, 1); PG8_STAGE(PG8_SB(0, 0), b2, voffB); PG8_STAGE(PG8_SB(0, 1), b2 + hstep, voffB); PG8_STAGE(PG8_SA(0, 0), a2, voffA);
            PG8_WAIT_V(8); PG8_WAIT_L(0); PG8_BAR; PG8_MMA(1, 0, At, B0); PG8_MMA(1, 1, At, B1); PG8_BAR; PG8_SCHED;
            PG8_LDB(B0, 1, 0); PG8_LDB(B1, 1, 1); PG8_SCHED; PG8_LDA(At, 1, 0); PG8_STAGE(PG8_SA(0, 1), a2 + hstep, voffA);
            PG8_WAIT_V(8); PG8_WAIT_L(0); PG8_BAR; PG8_MMA(0, 0, At, B0); PG8_MMA(0, 1, At, B1); PG8_BAR; PG8_SCHED;
            PG8_LDA(At, 1, 1); PG8_STAGE(PG8_SB(1, 0), b3, voffB); PG8_STAGE(PG8_SB(1, 1), b3 + hstep, voffB); PG8_STAGE(PG8_SA(1, 0), a3, voffA);
            PG8_WAIT_V(8); PG8_WAIT_L(0); PG8_BAR; PG8_MMA(1, 0, At, B0); PG8_MMA(1, 1, At, B1); PG8_BAR; PG8_SCHED;
            } else {
            PG8_LDB(B0, 0, 0); PG8_SCHED; PG8_LDA(At, 0, 0); PG8_STAGE(PG8_SA(1, 1), a1 + hstep, voffA);
            PG8_WAIT_L(8); PG8_BAR; PG8_WAIT_L(0); PG8_MMA(0, 0, At, B0); PG8_BAR; PG8_SCHED;
            PG8_LDB(B1, 0, 1); PG8_STAGE(PG8_SB(0, 0), b2, voffB);
            PG8_BAR; PG8_WAIT_L(0); PG8_MMA(0, 1, At, B1); PG8_BAR;
            PG8_LDA(At, 0, 1); PG8_STAGE(PG8_SA(0, 0), a2, voffA);
            PG8_BAR; PG8_WAIT_L(0); PG8_MMA(1, 0, At, B0); PG8_BAR; PG8_SCHED;
            PG8_STAGE(PG8_SB(0, 1), b2 + hstep, voffB);
            PG8_WAIT_V(6); PG8_BAR; PG8_MMA(1, 1, At, B1); PG8_BAR;
            PG8_LDB(B0, 1, 0); PG8_SCHED; PG8_LDA(At, 1, 0); PG8_STAGE(PG8_SA(0, 1), a2 + hstep, voffA);
            PG8_WAIT_L(8); PG8_BAR; PG8_WAIT_L(0); PG8_MMA(0, 0, At, B0); PG8_BAR; PG8_SCHED;
            PG8_LDB(B1, 1, 1); PG8_STAGE(PG8_SB(1, 0), b3, voffB);
            PG8_BAR; PG8_WAIT_L(0); PG8_MMA(0, 1, At, B1); PG8_BAR;
            PG8_LDA(At, 1, 1); PG8_STAGE(PG8_SA(1, 0), a3, voffA);
            PG8_BAR; PG8_WAIT_L(0); PG8_MMA(1, 0, At, B0); PG8_BAR; PG8_SCHED;
            PG8_STAGE(PG8_SB(1, 1), b3 + hstep, voffB);
            PG8_WAIT_V(6); PG8_BAR; PG8_MMA(1, 1, At, B1); PG8_BAR;
            }
        }
        if constexpr (ALIGN_EPI) { if (wr == 0) PG8_BAR; }
        if constexpr (F8) asm volatile("s_nop 15\n\ts_nop 15" ::: "memory");
        if constexpr (!Epi::AFTER_DRAIN) { E(acc, cur, wr, wc, fr, fq); S.done(cur); }
        if (!has_next) break;
#pragma unroll
        for (int a = 0; a < 2; ++a)
#pragma unroll
            for (int b = 0; b < 2; ++b)
#pragma unroll
                for (int m = 0; m < 4; ++m)
#pragma unroll
                    for (int n = 0; n < 2; ++n) acc[a][b][m][n] = (f32x4){0.f, 0.f, 0.f, 0.f};
        cur = nxt; cA = nA; cB = nB; ++ui;
        if constexpr (ALIGN_EPI) { if (wr == 1) PG8_BAR; }
    }
    PG8_WAIT_V(0);
    if constexpr (!ALIGN_EPI) { if (wr == 0) PG8_BAR; }
    PG8_BAR;
    if constexpr (Epi::AFTER_DRAIN) { E.fused(acc, cur, wr, wc, fr, fq, lds, wid, lane); S.done(cur); }
#undef PG8_SA
#undef PG8_SB
#undef PG8_STAGE
#undef PG8_LDA
#undef PG8_LDB
#undef PG8_MMA
#undef PG8_CAT
#undef PG8_WAIT_V
#undef PG8_WAIT_L
#undef PG8_BAR
#undef PG8_SCHED
}
}

constexpr int NWAVES = 8;
constexpr int NB = 8, SEQ = 2048, DM = 2048, M = NB * SEQ;
constexpr int N_IN = 3664, NPROJ = 3840, NP8 = 2560;
constexpr int U_OFF = 0, Q_OFF = 1024, K_OFF = 2048, V_OFF = 2304, QI_OFF = 2560, KI_OFF = 3584, WI_OFF = 3648;
constexpr int SSMW = 1024, NG = 64, GCH = 16, NST = 64;
constexpr int NH = 8, HD = 128, NKV = 2, NIH = 16, IDIM = 64, TOPK = 256;
constexpr int DFF = 5632, NUG = 2 * DFF;
constexpr float LN_EPS = 1e-5f;
constexpr float DN_ALPHA = 1.189207115002721f;
constexpr float IDX_W_SCALE = 0.03125f;
constexpr float ATT_SCALE = 0.08838834764831845f;
constexpr float SC_H1 = 32.f, SC_WUG = 2048.f, SC_ACT = 8.f, SC_WDN = 4096.f, SC_MIX = 8.f, SC_WOUT = 4096.f, SC_X = 32.f, SC_WIN = 2048.f;

constexpr size_t MiB = 1u << 20;
constexpr size_t WS_CTL = 0, CTL_ZERO_BYTES = 1 * MiB;
constexpr size_t WS_WIN = 2 * MiB, WS_WGLU = 17 * MiB, WS_WOUT = 19 * MiB, WS_WUG = 27 * MiB, WS_WDOWN = 71 * MiB;
constexpr size_t WS_TABA = 93 * MiB, WS_TABB = 93 * MiB + 65536;
constexpr size_t WS_TABINV = 94 * MiB, WS_TABW = 95 * MiB, WS_CA = 96 * MiB, WS_BCAT = 96 * MiB + 524288, WS_TABA32 = 96 * MiB + 786432;
constexpr size_t WS_KIPACK = 97 * MiB;
constexpr size_t WS_MASK = 100 * MiB;
constexpr size_t WS_XB = 104 * MiB;
constexpr size_t WS_MIX = 168 * MiB;
constexpr size_t WS_PROJ = 232 * MiB;
constexpr size_t WS_YG = 352 * MiB;
constexpr size_t WS_ACT = 232 * MiB;
constexpr size_t WS_PEND_UP = 408 * MiB, WS_PEND_G = 420 * MiB, WS_HALO = 432 * MiB, WS_WIN8 = 444 * MiB, WS_RSTAT = 450 * MiB, WS_END = 451 * MiB;
static_assert(WS_WIN + (size_t)NPROJ * DM * 2 <= WS_WGLU && WS_WUG + (size_t)NUG * DM * 2 <= WS_WDOWN && WS_WDOWN + (size_t)DM * DFF * 2 <= WS_TABA, "ws map");
static_assert(WS_PROJ + (size_t)M * NPROJ * 2 <= WS_YG && WS_YG + (size_t)M * SSMW * 2 <= WS_PEND_UP && WS_ACT + (size_t)M * DFF * 2 <= WS_PEND_UP && (size_t)512 * DFF * 4 <= 12 * MiB && WS_WIN8 + (size_t)NP8 * DM <= WS_RSTAT && WS_RSTAT + (size_t)M * 8 <= WS_END, "ws map 2");
constexpr int CW_BAR = 4096;

constexpr int RING_OFF = 0, RING_BYTES = 131072;
constexpr int LDS_BYTES = 163840;
constexpr int LDSCTL_OFF = LDS_BYTES - 1024, MISC_OFF = LDSCTL_OFF + 320;

#define GAS __attribute__((address_space(1)))
#define LAS __attribute__((address_space(3)))
typedef unsigned short bf16;
typedef unsigned v4u __attribute__((ext_vector_type(4)));
typedef unsigned v2u __attribute__((ext_vector_type(2)));
typedef float f32x4 __attribute__((ext_vector_type(4)));
typedef float fl4 __attribute__((ext_vector_type(4)));
#define LDS_WAIT() asm volatile("s_waitcnt lgkmcnt(0)" ::: "memory")
#define VM_WAIT() asm volatile("s_waitcnt vmcnt(0)" ::: "memory")
__device__ __forceinline__ unsigned f2bf(float f) { unsigned u = __builtin_bit_cast(unsigned, f); return (u + 0x7fffu + ((u >> 16) & 1u)) >> 16; }
__device__ __forceinline__ unsigned pk2(float lo, float hi) { return f2bf(lo) | (f2bf(hi) << 16); }
__device__ __forceinline__ float bflo(unsigned w) { return __uint_as_float(w << 16); }
__device__ __forceinline__ float bfhi(unsigned w) { return __uint_as_float(w & 0xffff0000u); }
__device__ __forceinline__ float bf2f(bf16 b) { return __uint_as_float(((unsigned)b) << 16); }
__device__ __forceinline__ unsigned pk4_fp8(float a, float b, float c, float d) {
    int w = 0; w = __builtin_amdgcn_cvt_pk_fp8_f32(__builtin_amdgcn_fmed3f(a, -448.f, 448.f), __builtin_amdgcn_fmed3f(b, -448.f, 448.f), w, false);
    w = __builtin_amdgcn_cvt_pk_fp8_f32(__builtin_amdgcn_fmed3f(c, -448.f, 448.f), __builtin_amdgcn_fmed3f(d, -448.f, 448.f), w, true); return (unsigned)w; }
#define XB_TMO      128
#define XB_XCNT(j)  (256  + 64 * (j))
#define XB_XSUB(j)  (1280 + 64 * (j))
#define XB_XGEN(j)  (2304 + 64 * (j))
#define XB_TOP      3328
#define XB_TOPGEN   3392
#define XCD_BAR_WORDS 3456
#define XB_SPIN_CAP (1u << 18)

__device__ __forceinline__ unsigned xb_ld(unsigned* p)              { return __hip_atomic_load(p, __ATOMIC_RELAXED, __HIP_MEMORY_SCOPE_AGENT); }
__device__ __forceinline__ unsigned xb_add(unsigned* p, unsigned v) { return __hip_atomic_fetch_add(p, v, __ATOMIC_RELAXED, __HIP_MEMORY_SCOPE_AGENT); }
__device__ __forceinline__ unsigned xb_xcc_id() { return (unsigned)__builtin_amdgcn_s_getreg((3 << 11) | 20) & 0xFu; }
#define XB_SPIN(cond, bar) do { unsigned _sp = 0; while (cond) { __builtin_amdgcn_s_sleep(1); \
    if ((++_sp & 255u) == 0u) { if (xb_ld(&(bar)[XB_TMO])) break; if (_sp > XB_SPIN_CAP) { atomicAdd(&(bar)[XB_TMO], 1u); break; } } } } while (0)

struct XcdBarrier {
    unsigned* bar; unsigned x;
    volatile LAS unsigned* st;
};

__device__ __forceinline__ XcdBarrier xcd_barrier_post(unsigned* bar, volatile LAS unsigned* st) {
    XcdBarrier b; b.bar = bar; b.x = xb_xcc_id(); b.st = st;
    if (threadIdx.x == 0) (void)xb_add(&bar[XB_XCNT(b.x)], 1u);
    return b;
}
__device__ __forceinline__ void xcd_barrier_complete(unsigned* bar, unsigned x, unsigned& nloc, unsigned& nx) {
    const unsigned G = gridDim.x * gridDim.y * gridDim.z;
    unsigned sum, cnt, mine, sp = 0u;
    for (;;) {
        sum = 0u; cnt = 0u; mine = 0u;
#pragma unroll
        for (unsigned j = 0; j < 16; ++j) { const unsigned c = xb_ld(&bar[XB_XCNT(j)]); sum += c; cnt += (c > 0u) ? 1u : 0u; mine = (j == x) ? c : mine; }
        if (sum == G) break;
        __builtin_amdgcn_s_sleep(1);
        if ((++sp & 255u) == 0u) { if (xb_ld(&bar[XB_TMO])) break; if (sp > XB_SPIN_CAP) { atomicAdd(&bar[XB_TMO], 1u); break; } }
    }
    nloc = mine > 0u ? mine : 1u; nx = cnt > 0u ? cnt : 1u;
}

__device__ __forceinline__ void xcd_barrier(const XcdBarrier& b) {
    asm volatile("s_waitcnt vmcnt(0)" ::: "memory");
    __syncthreads();
    if (threadIdx.x == 0) {
        unsigned* bar = b.bar;
        __builtin_amdgcn_s_waitcnt(0);
        unsigned nloc = b.st[0], nx = b.st[1];
        if (nloc == 0u) { xcd_barrier_complete(bar, b.x, nloc, nx); b.st[0] = nloc; b.st[1] = nx; }
        const unsigned old = xb_add(&bar[XB_XSUB(b.x)], 1u);
        const unsigned gen = old / nloc;
        if (old + 1u == (gen + 1u) * nloc) {
            __builtin_amdgcn_fence(__ATOMIC_RELEASE, "agent");
            asm volatile("s_waitcnt vmcnt(0)" ::: "memory");
            const unsigned og = xb_add(&bar[XB_TOP], 1u);
            const unsigned tg = og / nx;
            if (og + 1u == (tg + 1u) * nx) xb_add(&bar[XB_TOPGEN], 1u);
            else XB_SPIN(xb_ld(&bar[XB_TOPGEN]) == tg, bar);
            __builtin_amdgcn_fence(__ATOMIC_ACQUIRE, "agent");
            xb_add(&bar[XB_XGEN(b.x)], 1u);
            asm volatile("s_waitcnt vmcnt(0)" ::: "memory");
        } else {
            XB_SPIN(xb_ld(&bar[XB_XGEN(b.x)]) == gen, bar);
            __builtin_amdgcn_fence(__ATOMIC_ACQUIRE, "agent");
            asm volatile("s_waitcnt vmcnt(0)" ::: "memory");
        }
    }
    __syncthreads();
}

struct Frame {
    LAS unsigned char* lds;
    volatile LAS unsigned* MISC;
    unsigned* ctl;
    int tid, lane, wave, vcu, G;
    const float* in[22]; float* out; unsigned char* ws;
};
enum { I_X = 0, I_WIN, I_ARE, I_AIM, I_LOGDT, I_BRE, I_BIM, I_CRE, I_CIM, I_D, I_WGLU, I_BGLU, I_WOUT, I_LN1G, I_LN1B, I_WUP, I_WGATE, I_CONVW, I_CONVB, I_WDOWN, I_LN2G, I_LN2B };

__device__ __forceinline__ float wave_sum(float v) {
#pragma unroll
    for (int o = 1; o < 64; o <<= 1) v += __shfl_xor(v, o);
    return v;
}

typedef float v16f32 __attribute__((ext_vector_type(16)));
typedef unsigned v6u32 __attribute__((ext_vector_type(6)));
__device__ __forceinline__ void mx6_store_block(unsigned char* row, int b, v16f32 x, v16f32 y, float amax) {
    unsigned E = __float_as_uint(amax) >> 23; E = E < 3u ? 3u : E;
    const unsigned sb = E - 2u; const float inv = __uint_as_float((254u - sb) << 23);
    const v6u32 r = __builtin_amdgcn_cvt_scalef32_2xpk16_fp6_f32(x * inv, y * inv, 1.0f);
    unsigned char* p = row + (b >> 2) * 128 + (b & 3) * 16;
    *(v4u*)p = (v4u){r[0], r[1], r[2], r[3]}; *(v4u*)(p + 64) = (v4u){r[4], r[5], sb, 0u};
}
#define MX6_AMAX(x, y, am) do { am = 0.f; _Pragma("unroll") for (int i_ = 0; i_ < 16; ++i_) am = __builtin_fmaxf(__builtin_fmaxf(__builtin_fabsf(x[i_]), __builtin_fabsf(y[i_])), am); } while (0)
template <int MODE>
__device__ __forceinline__ void p2_mx6_item(const float* W, int K, int N, void* WT, int item, int lane) {
    const int nblk = N / 256, kb = item / nblk, nb = item % nblk, k0 = 32 * kb;
#pragma unroll 1
    for (int sub = 0; sub < 4; ++sub) { const int nn = nb * 256 + sub * 64 + lane; const float* wp = W + (size_t)k0 * N + nn;
        v16f32 x, y;
#pragma unroll
        for (int i = 0; i < 16; ++i) { x[i] = wp[(size_t)i * N]; y[i] = wp[(size_t)(16 + i) * N]; }
        float am; MX6_AMAX(x, y, am);
        const int R = MODE == 0 ? nn : (256 * (nn >> 7) + (nn & 127) + (MODE == 2 ? 128 : 0));
        mx6_store_block((unsigned char*)WT + (size_t)R * K, kb, x, y, am); }
}
template <int MODE, bool F8OUT>
__device__ __forceinline__ void p0_tr_item(const float* W, int K, int N, int noff, int nend, void* WT, int item, int lane, float sc) {
    const int nblk = (nend - noff) / 256, kb = item / nblk, nb = item % nblk, k0 = 32 * kb, n = noff + nb * 256 + lane * 4;
    constexpr int KS = F8OUT ? 16 : 8;
    const bool inb = n < N;
#pragma unroll
    for (int kk = 0; kk < 32; kk += KS) {
        f32x4 v[KS];
#pragma unroll
        for (int i = 0; i < KS; ++i) v[i] = inb ? *(const f32x4*)(W + (size_t)(k0 + kk + i) * N + n) : (f32x4){0.f, 0.f, 0.f, 0.f};
#pragma unroll
        for (int c = 0; c < 4; ++c) { const int nn = n + c; const int R = MODE == 0 ? nn : (256 * (nn >> 7) + (nn & 127) + (MODE == 2 ? 128 : 0));
            v4u o;
            if constexpr (F8OUT) { o.x = pk4_fp8(v[0][c] * sc, v[1][c] * sc, v[2][c] * sc, v[3][c] * sc); o.y = pk4_fp8(v[4][c] * sc, v[5][c] * sc, v[6][c] * sc, v[7][c] * sc);
                o.z = pk4_fp8(v[8][c] * sc, v[9][c] * sc, v[10][c] * sc, v[11][c] * sc); o.w = pk4_fp8(v[12][c] * sc, v[13][c] * sc, v[14][c] * sc, v[15][c] * sc);
                *(v4u*)((unsigned char*)WT + (size_t)R * K + k0 + kk) = o; }
            else { o.x = pk2(v[0][c], v[1][c]); o.y = pk2(v[2][c], v[3][c]); o.z = pk2(v[4][c], v[5][c]); o.w = pk2(v[6][c], v[7][c]);
                *(v4u*)((bf16*)WT + (size_t)R * K + k0 + kk) = o; } }
    }
}
__device__ __forceinline__ void p0_prologue(Frame& F) {
    LAS float* scr = (LAS float*)(F.lds + RING_OFF + F.wave * 16384);
    const int gw = F.vcu * NWAVES + F.wave, NGW = F.G * NWAVES;
    bf16* win_t = (bf16*)(F.ws + WS_WIN); bf16* wglu_t = (bf16*)(F.ws + WS_WGLU); bf16* wout_t = (bf16*)(F.ws + WS_WOUT); bf16* wug_t = (bf16*)(F.ws + WS_WUG); bf16* wdown_t = (bf16*)(F.ws + WS_WDOWN);
    constexpr int I_IN8 = (DM / 32) * (NP8 / 256), I_IN = (DM / 32) * ((NPROJ - NP8) / 256);
    for (int it = gw; it < I_IN8 + I_IN; it += NGW) {
        int r = it;
        if (r < I_IN8) { p0_tr_item<0, true>(F.in[I_WIN], DM, N_IN, 0, NP8, F.ws + WS_WIN8, r, F.lane, SC_WIN); continue; } r -= I_IN8;
        p0_tr_item<0, false>(F.in[I_WIN], DM, N_IN, NP8, NPROJ, win_t, r, F.lane, 1.f);
    }
    { const size_t n8 = (size_t)M * DM / 8; const f32x4* xs = (const f32x4*)F.in[I_X]; v4u* xd = (v4u*)(F.ws + WS_XB);
#pragma unroll 4
      for (size_t i = (size_t)F.vcu * 512 + F.tid; i < n8; i += (size_t)F.G * 512) { const f32x4 a = xs[2 * i], b = xs[2 * i + 1];
          v4u o; o.x = pk2(a[0], a[1]); o.y = pk2(a[2], a[3]); o.z = pk2(b[0], b[1]); o.w = pk2(b[2], b[3]); xd[i] = o;
          v2u o8; o8.x = pk4_fp8(a[0] * SC_X, a[1] * SC_X, a[2] * SC_X, a[3] * SC_X); o8.y = pk4_fp8(b[0] * SC_X, b[1] * SC_X, b[2] * SC_X, b[3] * SC_X); ((v2u*)(F.ws + WS_MIX + 32 * MiB))[i] = o8; } }
    { const int gi = F.vcu * 512 + F.tid;
      if (gi < NG * NST) { const int g = gi >> 6;
          const double dt = exp((double)F.in[I_LOGDT][g]); const double are = (double)F.in[I_ARE][gi], aim = (double)F.in[I_AIM][gi];
          const double mag = exp(dt * are), ang = dt * aim; const double abr = mag * cos(ang), abi = mag * sin(ang);
          const double nr = abr - 1.0, ni = abi, den = are * are + aim * aim;
          const double fre = (nr * are + ni * aim) / den, fim = (ni * are - nr * aim) / den;
          float2* ta = (float2*)(F.ws + WS_TABA); float2* tb = (float2*)(F.ws + WS_TABB);
          ta[gi] = make_float2((float)abr, (float)abi);
#pragma unroll
          for (int h = 0; h < GCH; ++h) { const double br = (double)F.in[I_BRE][gi * GCH + h], bi = (double)F.in[I_BIM][gi * GCH + h];
              const float bbr = (float)(fre * br - fim * bi), bbi = (float)(fre * bi + fim * br);
              tb[gi * GCH + h] = make_float2(bbr, bbi);
              const int p = gi & 63; bf16* bcat = (bf16*)(F.ws + WS_BCAT);
              bcat[(size_t)(g * 128 + p) * 16 + h] = (bf16)f2bf(bbr); bcat[(size_t)(g * 128 + 64 + p) * 16 + h] = (bf16)f2bf(bbi); }
          { const double m32 = exp(32.0 * dt * are), a32 = 32.0 * dt * aim; ((float2*)(F.ws + WS_TABA32))[gi] = make_float2((float)(m32 * cos(a32)), (float)(m32 * sin(a32))); } } }
    for (int e = F.vcu * 512 + F.tid; e < NG * 2 * 8 * 64; e += F.G * 512) {
        const int ln = e & 63, rp = (e >> 6) & 7, pt = (e >> 9) & 1, g = e >> 10, hw = ln >> 5, jl = ln & 31;
        const double dt = exp((double)F.in[I_LOGDT][g]); float vi[4], vw[4];
#pragma unroll
        for (int k = 0; k < 2; ++k) { const int r = 2 * rp + k, cr = (r & 3) + 8 * (r >> 2) + 4 * hw;
            { const int p = pt * 32 + jl; const double are = (double)F.in[I_ARE][g * 64 + p], aim = (double)F.in[I_AIM][g * 64 + p], kk = -(double)cr; const double mg = exp(kk * dt * are), an = kk * dt * aim;
              vi[k] = (float)(mg * cos(an)); vi[2 + k] = (float)(mg * sin(an)); }
            { const int p = pt * 32 + cr; const double are = (double)F.in[I_ARE][g * 64 + p], aim = (double)F.in[I_AIM][g * 64 + p], kk = (double)jl; const double mg = exp(kk * dt * are), an = kk * dt * aim;
              vw[k] = (float)(mg * cos(an)); vw[2 + k] = (float)(mg * sin(an)); } }
        ((fl4*)(F.ws + WS_TABINV))[e] = (fl4){vi[0], vi[1], vi[2], vi[3]}; ((fl4*)(F.ws + WS_TABW))[e] = (fl4){vw[0], vw[1], vw[2], vw[3]};
    }
    for (int e = F.vcu * 512 + F.tid; e < NG * 4 * 2 * 64; e += F.G * 512) {
        const int ln = e & 63, s = (e >> 6) & 1, q = (e >> 7) & 3, g = e >> 9, ch = ln & 31, hw = ln >> 5; unsigned hv[8];
#pragma unroll
        for (int ee = 0; ee < 8; ++ee) { const int p = (q & 1) * 32 + 8 * (2 * s + (ee >> 2)) + 4 * hw + (ee & 3); float v = 0.f;
            if (ch < 16) v = (q < 2) ? F.in[I_CRE][(size_t)(g * 16 + ch) * 64 + p] : -F.in[I_CIM][(size_t)(g * 16 + ch) * 64 + p];
            hv[ee] = f2bf(v); }
        v4u w; w.x = hv[0] | (hv[1] << 16); w.y = hv[2] | (hv[3] << 16); w.z = hv[4] | (hv[5] << 16); w.w = hv[6] | (hv[7] << 16);
        ((v4u*)(F.ws + WS_CA))[e] = w; }
}

constexpr int P2W_GLU = (SSMW / 32) * (SSMW / 256), P2W_OUT = (DM / 32) * (DM / 256), P2W_UP = (DM / 32) * (DFF / 256), P2W_DOWN = (DFF / 32) * (DM / 256);
constexpr int P2W_ITEMS = P2W_GLU + P2W_OUT + 2 * P2W_UP + P2W_DOWN;
__device__ __forceinline__ void p2_weight_item(Frame& F, int it) {
    int r = it;
    if (r < P2W_GLU) { p0_tr_item<0, false>(F.in[I_WGLU], SSMW, SSMW, 0, SSMW, F.ws + WS_WGLU, r, F.lane, 1.f); return; } r -= P2W_GLU;
    if (r < P2W_OUT) { p0_tr_item<0, true>(F.in[I_WOUT], DM, DM, 0, DM, F.ws + WS_WOUT, r, F.lane, SC_WOUT); return; } r -= P2W_OUT;
    if (r < P2W_UP) { p2_mx6_item<1>(F.in[I_WUP], DM, DFF, F.ws + WS_WUG, r, F.lane); return; } r -= P2W_UP;
    if (r < P2W_UP) { p2_mx6_item<2>(F.in[I_WGATE], DM, DFF, F.ws + WS_WUG, r, F.lane); return; } r -= P2W_UP;
    p0_tr_item<0, true>(F.in[I_WDOWN], DFF, DM, 0, DM, F.ws + WS_WDOWN, r, F.lane, SC_WDN);
}

typedef short bf16x8_t __attribute__((ext_vector_type(8)));
typedef float f32x16_t __attribute__((ext_vector_type(16)));
typedef float fl2 __attribute__((ext_vector_type(2)));
constexpr int IDX_NLDS = 30;
__device__ __forceinline__ void idx_mfma_pair(Frame& F, int b, int ti, unsigned* maskout, const LAS bf16* kl) {
    const int lane = F.lane, j = lane & 31, hw = lane >> 5, t0 = 2 * ti, th = t0 + hw;
    const bf16* proj = (const bf16*)(F.ws + WS_PROJ);
    const bf16* pb = proj + (size_t)(b * SEQ) * NPROJ;
    bf16x8_t qa[4];
    { const int q = (j >> 2) & 1, head = (j >> 3) * 4 + (j & 3); const bf16* qp = pb + (size_t)(t0 + q) * NPROJ + QI_OFF + head * IDIM + 8 * hw;
#pragma unroll
      for (int s = 0; s < 4; ++s) qa[s] = *(const bf16x8_t*)(qp + 16 * s); }
    float w[16];
    { const bf16* wp = pb + (size_t)th * NPROJ + WI_OFF; const v4u a = *(const v4u*)wp, c = *(const v4u*)(wp + 8);
      w[0] = bflo(a.x); w[1] = bfhi(a.x); w[2] = bflo(a.y); w[3] = bfhi(a.y); w[4] = bflo(a.z); w[5] = bfhi(a.z); w[6] = bflo(a.w); w[7] = bfhi(a.w);
      w[8] = bflo(c.x); w[9] = bfhi(c.x); w[10] = bflo(c.y); w[11] = bfhi(c.y); w[12] = bflo(c.z); w[13] = bfhi(c.z); w[14] = bflo(c.w); w[15] = bfhi(c.w);
#pragma unroll
      for (int r = 0; r < 16; ++r) w[r] *= IDX_W_SCALE; }
    const int kbnd = t0 >> 5;
    const float pen = (j > th - 32 * kbnd) ? -__builtin_inff() : 0.f;
    const int nkt = (t0 + 1) / 32 + 1;
    const float NEG = -__builtin_inff();
    float sc[64];
    const bf16* kp = (const bf16*)(F.ws + WS_KIPACK) + (size_t)(b * 64) * 4 * 64 * 8 + (size_t)lane * 8;
    typedef float f32x2_t __attribute__((ext_vector_type(2)));
    f32x2_t w2[8];
#pragma unroll
    for (int r = 0; r < 8; ++r) w2[r] = (f32x2_t){0.5f * w[2 * r], 0.5f * w[2 * r + 1]};
    bf16x8_t kA[2][4], kB[2][4];
#pragma unroll
    for (int t2 = 0; t2 < 2; ++t2)
#pragma unroll
        for (int s = 0; s < 4; ++s) kA[t2][s] = *(const LAS bf16x8_t*)(kl + (t2 * 4 + s) * 512);
    unsigned kl2a = (unsigned)(size_t)kl + 16 * 4096; asm volatile("" : "+v"(kl2a));
    const LAS bf16* kl2 = (const LAS bf16*)(size_t)kl2a;
#pragma unroll
    for (int kp2 = 0; kp2 < 32; ++kp2) {
        if (2 * kp2 < nkt) {
            if (2 * (kp2 + 1) < nkt) {
#pragma unroll
                for (int t2 = 0; t2 < 2; ++t2)
#pragma unroll
                    for (int s = 0; s < 4; ++s) { const bf16x8_t v = (2 * kp2 + 2 < 16) ? *(const LAS bf16x8_t*)(kl + ((2 * kp2 + 2 + t2) * 4 + s) * 512) : (2 * kp2 + 2 < IDX_NLDS) ? *(const LAS bf16x8_t*)(kl2 + ((2 * kp2 + 2 - 16 + t2) * 4 + s) * 512) : *(const bf16x8_t*)(kp + (size_t)((2 * kp2 + 2 + t2) * 4 + s) * 512);
                        if (kp2 & 1) kA[t2][s] = v; else kB[t2][s] = v; } }
            f32x16_t acc0 = {}, acc1 = {};
#pragma unroll
            for (int s = 0; s < 4; ++s) { acc0 = __builtin_amdgcn_mfma_f32_32x32x16_bf16(qa[s], (kp2 & 1) ? kB[0][s] : kA[0][s], acc0, 0, 0, 0);
                acc1 = __builtin_amdgcn_mfma_f32_32x32x16_bf16(qa[s], (kp2 & 1) ? kB[1][s] : kA[1][s], acc1, 0, 0, 0); }
            f32x2_t s0 = {0.f, 0.f}, s1 = {0.f, 0.f}; float a0 = 0.f, b0 = 0.f, a1 = 0.f, b1 = 0.f;
#pragma unroll
            for (int r = 0; r < 8; ++r) { const f32x2_t x0 = {acc0[2 * r], acc0[2 * r + 1]}, x1 = {acc1[2 * r], acc1[2 * r + 1]};
                s0 = x0 * w2[r] + s0; s1 = x1 * w2[r] + s1;
                a0 = fmaf(w2[r].x, fabsf(x0.x), a0); b0 = fmaf(w2[r].y, fabsf(x0.y), b0); a1 = fmaf(w2[r].x, fabsf(x1.x), a1); b1 = fmaf(w2[r].y, fabsf(x1.y), b1); }
            float v0 = (s0.x + s0.y) + (a0 + b0), v1 = (s1.x + s1.y) + (a1 + b1);
            if (2 * kp2 == kbnd) { v0 += pen; v1 = NEG; } else if (2 * kp2 + 1 == kbnd) v1 += pen;
            sc[2 * kp2] = v0; sc[2 * kp2 + 1] = v1;
        } else { sc[2 * kp2] = NEG; sc[2 * kp2 + 1] = NEG; }
    }
    float thr = -3.0e38f, tieval = 0.f; bool tie = false; int need = 0;
    bool act = th >= TOPK;
    if (__any(act)) {
        float mn = sc[0], mx = sc[0];
#pragma unroll
        for (int kt = 1; kt < 8; ++kt) mn = __builtin_amdgcn_fmed3f(mn, sc[kt], NEG);
#pragma unroll
        for (int kt = 1; kt < 64; ++kt) mx = __builtin_amdgcn_fmed3f(mx, sc[kt], __builtin_inff());
#define IDX_DPP_F(v, ctrl) __builtin_bit_cast(float, __builtin_amdgcn_update_dpp(0, __builtin_bit_cast(int, v), ctrl, 0xf, 0xf, false))
        mn = fminf(mn, IDX_DPP_F(mn, 0x128)); mn = fminf(mn, IDX_DPP_F(mn, 0x124)); mn = fminf(mn, IDX_DPP_F(mn, 0x122)); mn = fminf(mn, IDX_DPP_F(mn, 0x121));
        mx = fmaxf(mx, IDX_DPP_F(mx, 0x128)); mx = fmaxf(mx, IDX_DPP_F(mx, 0x124)); mx = fmaxf(mx, IDX_DPP_F(mx, 0x122)); mx = fmaxf(mx, IDX_DPP_F(mx, 0x121));
#undef IDX_DPP_F
        { const float a0 = __builtin_bit_cast(float, __builtin_amdgcn_readlane(__builtin_bit_cast(int, mn), 0)), a1 = __builtin_bit_cast(float, __builtin_amdgcn_readlane(__builtin_bit_cast(int, mn), 16));
          const float a2 = __builtin_bit_cast(float, __builtin_amdgcn_readlane(__builtin_bit_cast(int, mn), 32)), a3 = __builtin_bit_cast(float, __builtin_amdgcn_readlane(__builtin_bit_cast(int, mn), 48));
          const float b0 = __builtin_bit_cast(float, __builtin_amdgcn_readlane(__builtin_bit_cast(int, mx), 0)), b1 = __builtin_bit_cast(float, __builtin_amdgcn_readlane(__builtin_bit_cast(int, mx), 16));
          const float b2 = __builtin_bit_cast(float, __builtin_amdgcn_readlane(__builtin_bit_cast(int, mx), 32)), b3 = __builtin_bit_cast(float, __builtin_amdgcn_readlane(__builtin_bit_cast(int, mx), 48));
          mn = hw ? fminf(a2, a3) : fminf(a0, a1); mx = hw ? fmaxf(b2, b3) : fmaxf(b0, b1); }
        float lo = mn, hi = mx + fabsf(mx) * 1e-6f + 1e-30f;
        int chi = 0;
        float glo = (float)(th + 1) - ((float)TOPK - 0.5f), ghi = -((float)TOPK - 0.5f); int side = 0;
        const int ngrp = (nkt + 7) >> 3;
        for (int it = 0; it < 200; ++it) {
            if (!__any(act)) break;
            float mid = hi - ghi * (hi - lo) * __builtin_amdgcn_rcpf(ghi - glo);
            if (!(mid > lo && mid < hi)) mid = 0.5f * (lo + hi);
            const bool conv = !(mid > lo && mid < hi);
            unsigned ba = 0u, bb = 0u;
#pragma unroll
            for (int g8 = 0; g8 < 4; ++g8) if (g8 < ngrp) {
#pragma unroll
                for (int kt = 8 * g8; kt < 8 * g8 + 8; ++kt) ba = __builtin_amdgcn_alignbit(ba, __builtin_bit_cast(unsigned, sc[kt] - mid), 31); }
#pragma unroll
            for (int g8 = 4; g8 < 8; ++g8) if (g8 < ngrp) {
#pragma unroll
                for (int kt = 8 * g8; kt < 8 * g8 + 8; ++kt) bb = __builtin_amdgcn_alignbit(bb, __builtin_bit_cast(unsigned, sc[kt] - mid), 31); }
            int cl = 8 * ngrp - (__builtin_popcount(ba) + __builtin_popcount(bb));
            cl += __builtin_amdgcn_update_dpp(0, cl, 0x128, 0xf, 0xf, false);
            cl += __builtin_amdgcn_update_dpp(0, cl, 0x124, 0xf, 0xf, false);
            cl += __builtin_amdgcn_update_dpp(0, cl, 0x122, 0xf, 0xf, false);
            cl += __builtin_amdgcn_update_dpp(0, cl, 0x121, 0xf, 0xf, false);
            const int c0 = __builtin_amdgcn_readlane(cl, 0) + __builtin_amdgcn_readlane(cl, 16), c1 = __builtin_amdgcn_readlane(cl, 32) + __builtin_amdgcn_readlane(cl, 48);
            const int c = hw ? c1 : c0;
            if (act) {
                if (conv) { act = false; tie = true; tieval = lo; thr = hi; need = TOPK - chi; }
                else if (c == TOPK) { act = false; thr = mid; }
                else if (c > TOPK) { lo = mid; glo = (float)c - ((float)TOPK - 0.5f); if (side == 1) ghi *= 0.5f; side = 1; }
                else { hi = mid; chi = c; ghi = (float)c - ((float)TOPK - 0.5f); if (side == -1) glo *= 0.5f; side = -1; }
            }
        }
        if (act) { thr = hi; }
    }
    unsigned w0v = 0u, w1v = 0u;
    const bool anytie = __any(tie);
    int need0 = __builtin_amdgcn_readlane(need, 0), need1 = __builtin_amdgcn_readlane(need, 32);
    if (!anytie) {
#define IDX_WL(KT) if ((KT) < nkt) { const unsigned long long bal_ = __ballot(sc[KT] >= thr); const unsigned x0_ = (unsigned)bal_, x1_ = (unsigned)(bal_ >> 32); \
        asm volatile("s_nop 1\n\tv_writelane_b32 %0, %2, " #KT "\n\tv_writelane_b32 %1, %3, " #KT : "+v"(w0v), "+v"(w1v) : "s"(x0_), "s"(x1_)); }
        IDX_WL(0) IDX_WL(1) IDX_WL(2) IDX_WL(3) IDX_WL(4) IDX_WL(5) IDX_WL(6) IDX_WL(7) IDX_WL(8) IDX_WL(9) IDX_WL(10) IDX_WL(11) IDX_WL(12) IDX_WL(13) IDX_WL(14) IDX_WL(15) IDX_WL(16) IDX_WL(17) IDX_WL(18) IDX_WL(19) IDX_WL(20) IDX_WL(21) IDX_WL(22) IDX_WL(23) IDX_WL(24) IDX_WL(25) IDX_WL(26) IDX_WL(27) IDX_WL(28) IDX_WL(29) IDX_WL(30) IDX_WL(31) IDX_WL(32) IDX_WL(33) IDX_WL(34) IDX_WL(35) IDX_WL(36) IDX_WL(37) IDX_WL(38) IDX_WL(39) IDX_WL(40) IDX_WL(41) IDX_WL(42) IDX_WL(43) IDX_WL(44) IDX_WL(45) IDX_WL(46) IDX_WL(47) IDX_WL(48) IDX_WL(49) IDX_WL(50) IDX_WL(51) IDX_WL(52) IDX_WL(53) IDX_WL(54) IDX_WL(55) IDX_WL(56) IDX_WL(57) IDX_WL(58) IDX_WL(59) IDX_WL(60) IDX_WL(61) IDX_WL(62) IDX_WL(63)
#undef IDX_WL
    } else
#pragma unroll
    for (int kt = 0; kt < 64; ++kt) if (kt < nkt) {
        const unsigned long long bal = __ballot(sc[kt] >= thr);
        unsigned x0 = (unsigned)bal, x1 = (unsigned)(bal >> 32);
        if (anytie) {
            const unsigned long long be = __ballot(tie && sc[kt] == tieval);
            unsigned e0 = (unsigned)be, e1 = (unsigned)(be >> 32);
            while (__builtin_popcount(e0) > need0) e0 &= ~(0x80000000u >> __builtin_clz(e0));
            while (__builtin_popcount(e1) > need1) e1 &= ~(0x80000000u >> __builtin_clz(e1));
            need0 -= __builtin_popcount(e0); need1 -= __builtin_popcount(e1);
            x0 |= e0; x1 |= e1;
        }
        w0v = (lane == kt) ? x0 : w0v; w1v = (lane == kt) ? x1 : w1v;
    }
    maskout[(size_t)(b * SEQ + t0) * 64 + lane] = w0v;
    maskout[(size_t)(b * SEQ + t0 + 1) * 64 + lane] = w1v;
}


__device__ __forceinline__ bf16x8_t ssm_pack8(const f32x16_t& v, int base) {
    v4u w; w.x = pg8::cvt_pk_bf16(v[base + 0], v[base + 1]); w.y = pg8::cvt_pk_bf16(v[base + 2], v[base + 3]); w.z = pg8::cvt_pk_bf16(v[base + 4], v[base + 5]); w.w = pg8::cvt_pk_bf16(v[base + 6], v[base + 7]);
    return __builtin_bit_cast(bf16x8_t, w);
}
__device__ __forceinline__ void ssm_mfma_task(Frame& F, int b, int g, const LAS fl4* tInv, const LAS fl4* tW, bf16* ygo, int c_light, int c_begin, int c_end) {
    const int lane = F.lane, j = lane & 31, hw = lane >> 5;
    const bf16* pu = (const bf16*)(F.ws + WS_PROJ) + (size_t)(b * SEQ) * NPROJ + U_OFF + g * 16;
    bf16x8_t bc[4], ca[4][2], tri[2];
#pragma unroll
    for (int nt = 0; nt < 4; ++nt) bc[nt] = *(const bf16x8_t*)((const bf16*)(F.ws + WS_BCAT) + (size_t)((g * 128 + nt * 32 + j) * 16 + 8 * hw));
#pragma unroll
    for (int q = 0; q < 4; ++q)
#pragma unroll
        for (int s = 0; s < 2; ++s) ca[q][s] = *(const bf16x8_t*)((const bf16*)(F.ws + WS_CA) + (size_t)((((g * 4 + q) * 2 + s) * 64 + lane) * 8));
#pragma unroll
    for (int s = 0; s < 2; ++s) { v4u w;
        unsigned hv[8];
#pragma unroll
        for (int e = 0; e < 8; ++e) { const int i = 8 * (2 * s + (e >> 2)) + 4 * hw + (e & 3); hv[e] = (i <= j) ? 0x3F80u : 0u; }
        w.x = hv[0] | (hv[1] << 16); w.y = hv[2] | (hv[3] << 16); w.z = hv[4] | (hv[5] << 16); w.w = hv[6] | (hv[7] << 16);
        tri[s] = __builtin_bit_cast(bf16x8_t, w); }
    float2 a32[2];
#pragma unroll
    for (int pt = 0; pt < 2; ++pt) a32[pt] = ((const float2*)(F.ws + WS_TABA32))[g * 64 + pt * 32 + j];
    float dv[8];
#pragma unroll
    for (int k = 0; k < 8; ++k) dv[k] = F.in[I_D][g * 16 + (k & 3) + 8 * (k >> 2) + 4 * hw];
    float hcr[2] = {0.f, 0.f}, hci[2] = {0.f, 0.f};
    const bf16* pl = pu + (size_t)j * NPROJ;
    if (c_light < c_begin) {
        bf16x8_t ul = *(const bf16x8_t*)(pl + (size_t)c_light * 32 * NPROJ + 8 * hw);
#pragma unroll 1
        for (int c = c_light; c < c_begin; ++c) {
            const bf16x8_t ulc = ul;
            if (c + 1 < c_begin) ul = *(const bf16x8_t*)(pl + (size_t)(c + 1) * 32 * NPROJ + 8 * hw);
            f32x16_t d[4];
#pragma unroll
            for (int nt = 0; nt < 4; ++nt) { f32x16_t z = {}; d[nt] = __builtin_amdgcn_mfma_f32_32x32x16_bf16(ulc, bc[nt], z, 0, 0, 0); }
#pragma unroll
            for (int pt = 0; pt < 2; ++pt) { float sr = 0.f, si = 0.f;
                fl2 sr2 = {0.f, 0.f}, si2 = {0.f, 0.f};
#pragma unroll
                for (int rp = 0; rp < 8; ++rp) { const fl4 w = tInv[(pt * 8 + rp) * 64 + lane]; const fl2 wre = {w.x, w.y}, wim = {w.z, w.w};
                    const fl2 re = {d[pt][2 * rp], d[pt][2 * rp + 1]}, im = {d[2 + pt][2 * rp], d[2 + pt][2 * rp + 1]}; sr2 += wre * re - wim * im; si2 += wre * im + wim * re; }
                sr = sr2.x + sr2.y; si = si2.x + si2.y;
                sr += __shfl_xor(sr, 32); si += __shfl_xor(si, 32);
                sr += hcr[pt]; si += hci[pt];
                hcr[pt] = a32[pt].x * sr - a32[pt].y * si; hci[pt] = a32[pt].x * si + a32[pt].y * sr; }
        }
    }
    const bf16* pf = pl + (size_t)c_begin * 32 * NPROJ;
    bf16x8_t ua = *(const bf16x8_t*)(pf + 8 * hw);
    v2u ue0 = *(const v2u*)(pf + 4 * hw), ue1 = *(const v2u*)(pf + 8 + 4 * hw);
#pragma unroll 1
    for (int c = c_begin; c < c_end; ++c) {
        const bf16x8_t uac = ua; const v2u uc0 = ue0, uc1 = ue1;
        if (c + 1 < c_end) { const bf16* pn = pl + (size_t)(c + 1) * 32 * NPROJ; ua = *(const bf16x8_t*)(pn + 8 * hw); ue0 = *(const v2u*)(pn + 4 * hw); ue1 = *(const v2u*)(pn + 8 + 4 * hw); }
        f32x16_t d[4];
#pragma unroll
        for (int nt = 0; nt < 4; ++nt) { f32x16_t z = {}; d[nt] = __builtin_amdgcn_mfma_f32_32x32x16_bf16(uac, bc[nt], z, 0, 0, 0); }
#pragma unroll
        for (int pt = 0; pt < 2; ++pt) { float sr = 0.f, si = 0.f;
            fl2 sr2 = {0.f, 0.f}, si2 = {0.f, 0.f};
#pragma unroll
            for (int rp = 0; rp < 8; ++rp) { const fl4 w = tInv[(pt * 8 + rp) * 64 + lane]; const fl2 wre = {w.x, w.y}, wim = {w.z, w.w};
                const fl2 re = {d[pt][2 * rp], d[pt][2 * rp + 1]}, im = {d[2 + pt][2 * rp], d[2 + pt][2 * rp + 1]};
                fl2 xr = wre * re - wim * im, xi = wre * im + wim * re;
                if (rp == 0) { xr.x += (hw == 0) ? hcr[pt] : 0.f; xi.x += (hw == 0) ? hci[pt] : 0.f; }
                d[pt][2 * rp] = xr.x; d[pt][2 * rp + 1] = xr.y; d[2 + pt][2 * rp] = xi.x; d[2 + pt][2 * rp + 1] = xi.y; sr2 += xr; si2 += xi; }
            sr = sr2.x + sr2.y; si = si2.x + si2.y;
            sr += __shfl_xor(sr, 32); si += __shfl_xor(si, 32);
            hcr[pt] = a32[pt].x * sr - a32[pt].y * si; hci[pt] = a32[pt].x * si + a32[pt].y * sr; }
        f32x16_t st[4];
#pragma unroll
        for (int q = 0; q < 4; ++q) { f32x16_t z = {}; st[q] = __builtin_amdgcn_mfma_f32_32x32x16_bf16(ssm_pack8(d[q], 0), tri[0], z, 0, 0, 0);
            st[q] = __builtin_amdgcn_mfma_f32_32x32x16_bf16(ssm_pack8(d[q], 8), tri[1], st[q], 0, 0, 0); }
#pragma unroll
        for (int pt = 0; pt < 2; ++pt)
#pragma unroll
            for (int rp = 0; rp < 8; ++rp) { const fl4 w = tW[(pt * 8 + rp) * 64 + lane]; const fl2 wre = {w.x, w.y}, wim = {w.z, w.w};
                const fl2 sre = {st[pt][2 * rp], st[pt][2 * rp + 1]}, sim = {st[2 + pt][2 * rp], st[2 + pt][2 * rp + 1]};
                const fl2 hr = wre * sre - wim * sim, hi = wre * sim + wim * sre;
                st[pt][2 * rp] = hr.x; st[pt][2 * rp + 1] = hr.y; st[2 + pt][2 * rp] = hi.x; st[2 + pt][2 * rp + 1] = hi.y; }
        f32x16_t y = {};
#pragma unroll
        for (int q = 0; q < 4; ++q) { y = __builtin_amdgcn_mfma_f32_32x32x16_bf16(ca[q][0], ssm_pack8(st[q], 0), y, 0, 0, 0); y = __builtin_amdgcn_mfma_f32_32x32x16_bf16(ca[q][1], ssm_pack8(st[q], 8), y, 0, 0, 0); }
        float o[8];
        o[0] = y[0] + dv[0] * bflo(uc0.x); o[1] = y[1] + dv[1] * bfhi(uc0.x); o[2] = y[2] + dv[2] * bflo(uc0.y); o[3] = y[3] + dv[3] * bfhi(uc0.y);
        o[4] = y[4] + dv[4] * bflo(uc1.x); o[5] = y[5] + dv[5] * bfhi(uc1.x); o[6] = y[6] + dv[6] * bflo(uc1.y); o[7] = y[7] + dv[7] * bfhi(uc1.y);
        const pg8::f32x2 g0 = pg8::gelu_pk((pg8::f32x2){o[0], o[1]}), g1 = pg8::gelu_pk((pg8::f32x2){o[2], o[3]}), g2 = pg8::gelu_pk((pg8::f32x2){o[4], o[5]}), g3 = pg8::gelu_pk((pg8::f32x2){o[6], o[7]});
        bf16* yo = ygo + (size_t)(b * SEQ + c * 32 + j) * SSMW + g * 16 + 4 * hw;
        v2u w0; w0.x = pg8::cvt_pk_bf16(g0.x, g0.y); w0.y = pg8::cvt_pk_bf16(g1.x, g1.y); *(v2u*)yo = w0;
        v2u w1; w1.x = pg8::cvt_pk_bf16(g2.x, g2.y); w1.y = pg8::cvt_pk_bf16(g3.x, g3.y); *(v2u*)(yo + 8) = w1;
    }
}


namespace att {
using bf16x8 = __attribute__((ext_vector_type(8))) short;
using s16x4  = __attribute__((ext_vector_type(4))) short;
using f32x16 = __attribute__((ext_vector_type(16))) float;
using u32x4  = __attribute__((ext_vector_type(4))) unsigned;
constexpr int D = 128, NW = 8, QBLK = 32, KVBLK = 64;
constexpr float SCALE = 0.088388347648318440f;
constexpr float THR = 8.f;
constexpr int LDK = NPROJ;
constexpr int SHM_V = KVBLK * D * 2, SHM_K = KVBLK * D * 2, SHM_ATTN = 2 * SHM_V + 2 * SHM_K + NW * 64 * 4;
#define KSWZ(row, colB) ((row) * 256 + ((colB) ^ (((row) & 7) << 4)))
#define SBAR() __builtin_amdgcn_sched_barrier(0)
__device__ __forceinline__ int crow(int r, int hi) { return (r & 3) + 8 * (r >> 2) + 4 * hi; }
__device__ __forceinline__ unsigned cvtpk(float lo, float hi) { unsigned r; asm volatile("v_cvt_pk_bf16_f32 %0, %1, %2" : "=v"(r) : "v"(lo), "v"(hi)); return r; }

__device__ __forceinline__ void partialSM(f32x16& p0, f32x16& p1, float& m_reg, float& mn, float& alpha, float base) {
  constexpr float C = SCALE * 1.4426950408889634f;
  float pm0 = p0[0], pm1 = p0[1], pm2 = p0[2], pm3 = p0[3];
#define MX3(a, b, c) __builtin_fmaxf(__builtin_fmaxf(a, b), c)
  pm0 = MX3(pm0, p0[4], p0[8]); pm1 = MX3(pm1, p0[5], p0[9]); pm2 = MX3(pm2, p0[6], p0[10]); pm3 = MX3(pm3, p0[7], p0[11]);
  pm0 = MX3(pm0, p0[12], p1[0]); pm1 = MX3(pm1, p0[13], p1[1]); pm2 = MX3(pm2, p0[14], p1[2]); pm3 = MX3(pm3, p0[15], p1[3]);
  pm0 = MX3(pm0, p1[4], p1[8]); pm1 = MX3(pm1, p1[5], p1[9]); pm2 = MX3(pm2, p1[6], p1[10]); pm3 = MX3(pm3, p1[7], p1[11]);
  pm0 = MX3(pm0, p1[12], p1[13]); pm1 = MX3(pm1, p1[14], p1[15]);
  float pmax = MX3(pm0, pm1, pm2); pmax = fmaxf(pmax, pm3);
#undef MX3
  pmax += base;
  { auto rr = __builtin_amdgcn_permlane32_swap(__float_as_uint(pmax), __float_as_uint(pmax), false, false);
    pmax = fmaxf(__uint_as_float(rr[0]), __uint_as_float(rr[1])); }
  if (__builtin_expect(__all(pmax - m_reg <= THR / SCALE), 1)) { mn = m_reg; alpha = 1.f; }
  else { mn = fmaxf(m_reg, pmax); alpha = __builtin_amdgcn_exp2f((m_reg - mn) * C); m_reg = mn; }
  float mnC = (base - mn) * C;
  for (int r = 0; r < 16; ++r) p0[r] = fmaf(p0[r], C, mnC); for (int r = 0; r < 16; ++r) p1[r] = fmaf(p1[r], C, mnC);
  for (int r = 0; r < 16; ++r) p0[r] = __builtin_amdgcn_exp2f(p0[r]);
}
__device__ __forceinline__ void finishSM(f32x16& p0, f32x16& p1, float alpha, float& l_reg, bf16x8& pa0, bf16x8& pa1, bf16x8& pa2, bf16x8& pa3) {
  for (int r = 0; r < 16; ++r) p1[r] = __builtin_amdgcn_exp2f(p1[r]);
  float ps = 0; for (int r = 0; r < 16; ++r) ps += p0[r]; for (int r = 0; r < 16; ++r) ps += p1[r];
  { auto rr = __builtin_amdgcn_permlane32_swap(__float_as_uint(ps), __float_as_uint(ps), false, false);
    ps = __uint_as_float(rr[0]) + __uint_as_float(rr[1]); }
  l_reg = l_reg * alpha + ps;
#define PK4(P, BASE, OUT) do { unsigned a0 = cvtpk(P[BASE + 0], P[BASE + 1]), a1 = cvtpk(P[BASE + 2], P[BASE + 3]);   \
    unsigned b0 = cvtpk(P[BASE + 4], P[BASE + 5]), b1 = cvtpk(P[BASE + 6], P[BASE + 7]);                              \
    auto r0 = __builtin_amdgcn_permlane32_swap(a0, b0, false, false); auto r1 = __builtin_amdgcn_permlane32_swap(a1, b1, false, false); \
    u32x4 w = {r0[0], r1[0], r0[1], r1[1]}; OUT = *reinterpret_cast<bf16x8*>(&w); } while (0)
  PK4(p0, 0, pa0); PK4(p0, 8, pa1); PK4(p1, 0, pa2); PK4(p1, 8, pa3);
#undef PK4
}
__device__ __forceinline__ void qkt(f32x16& p0, f32x16& p1, const bf16* Ks, const bf16x8* qr, int r32, int hi, float slopeS, v2u mw) {
  p0 = f32x16{}; p1 = f32x16{};
  for (int d0 = 0; d0 < 8; ++d0) { int cb = (d0 * 16 + hi * 8) * 2;
    bf16x8 b0 = *reinterpret_cast<const bf16x8*>((const char*)Ks + KSWZ(r32, cb));
    bf16x8 b1 = *reinterpret_cast<const bf16x8*>((const char*)Ks + KSWZ(32 + r32, cb));
    p0 = __builtin_amdgcn_mfma_f32_32x32x16_bf16(b0, qr[d0], p0, 0, 0, 0);
    p1 = __builtin_amdgcn_mfma_f32_32x32x16_bf16(b1, qr[d0], p1, 0, 0, 0); }
  const unsigned s0 = mw.x >> (4 * hi), s1 = mw.y >> (4 * hi); const float NEG = -__builtin_inff();
#pragma unroll
  for (int r = 0; r < 16; ++r) { const int cr = (r & 3) + 8 * (r >> 2);
    const unsigned m0 = (unsigned)(((int)(s0 << (31 - cr))) >> 31), m1 = (unsigned)(((int)(s1 << (31 - cr))) >> 31);
    p0[r] = __uint_as_float((m0 & __float_as_uint(fmaf(slopeS, (float)cr, p0[r]))) | (~m0 & 0xFF800000u));
    p1[r] = __uint_as_float((m1 & __float_as_uint(fmaf(slopeS, (float)(32 + cr), p1[r]))) | (~m1 & 0xFF800000u)); }
  (void)NEG;
}
__device__ __forceinline__ int v_st(int k, int c) { const int kk = (k & ~0xC) | ((k & 4) << 1) | ((k & 8) >> 1); return ((kk >> 3) * 4 + (c >> 5)) * 512 + ((kk & 7) * 32 + (c & 31)) * 2; }
__device__ __forceinline__ int v_rd_base(int lane) { return ((lane & 3) << 3) | (((lane >> 2) & 3) << 6) | (((lane >> 4) & 1) << 5) | (((lane >> 5) & 1) << 8); }
constexpr int v_rd_off(int d0, int ks, int half) { return d0 * 512 + ks * 4096 + half * 2048; }
template <int OFF> __device__ __forceinline__ s16x4 tr_read(int vb) {
  s16x4 r; asm volatile("ds_read_b64_tr_b16 %0, %1 offset:%2" : "=&v"(r) : "v"(vb), "i"(OFF) : "memory"); return r;
}
template <int D0> __device__ __forceinline__ void pv_one(f32x16& od, int vb, bf16x8 pa0, bf16x8 pa1, bf16x8 pa2, bf16x8 pa3) {
  const s16x4 l0 = tr_read<v_rd_off(D0, 0, 0)>(vb), h0 = tr_read<v_rd_off(D0, 0, 1)>(vb), l1 = tr_read<v_rd_off(D0, 1, 0)>(vb), h1 = tr_read<v_rd_off(D0, 1, 1)>(vb);
  const s16x4 l2 = tr_read<v_rd_off(D0, 2, 0)>(vb), h2 = tr_read<v_rd_off(D0, 2, 1)>(vb), l3 = tr_read<v_rd_off(D0, 3, 0)>(vb), h3 = tr_read<v_rd_off(D0, 3, 1)>(vb);
  asm volatile("s_waitcnt lgkmcnt(0)" ::: "memory"); SBAR();
#define PK(L, H) (bf16x8){L[0], L[1], L[2], L[3], H[0], H[1], H[2], H[3]}
  od = __builtin_amdgcn_mfma_f32_32x32x16_bf16(pa0, PK(l0, h0), od, 0, 0, 0);
  od = __builtin_amdgcn_mfma_f32_32x32x16_bf16(pa1, PK(l1, h1), od, 0, 0, 0);
  od = __builtin_amdgcn_mfma_f32_32x32x16_bf16(pa2, PK(l2, h2), od, 0, 0, 0);
  od = __builtin_amdgcn_mfma_f32_32x32x16_bf16(pa3, PK(l3, h3), od, 0, 0, 0);
#undef PK
}
__device__ __forceinline__ void pv_d0(f32x16* o, int vb, bf16x8 pa0, bf16x8 pa1, bf16x8 pa2, bf16x8 pa3) {
  pv_one<0>(o[0], vb, pa0, pa1, pa2, pa3); pv_one<1>(o[1], vb, pa0, pa1, pa2, pa3); pv_one<2>(o[2], vb, pa0, pa1, pa2, pa3); pv_one<3>(o[3], vb, pa0, pa1, pa2, pa3);
}
__device__ __forceinline__ void attn_mask_body(const bf16* __restrict__ Qb, const bf16* __restrict__ Kh, const bf16* __restrict__ Vh, const unsigned* __restrict__ Mb,
                                               unsigned char* __restrict__ Ob, int seq, float slopeS, char* lds) {
  const int tid = threadIdx.x, wid = tid >> 6, lane = tid & 63, r32 = lane & 31, hi = lane >> 5;
  bf16* V_lds = (bf16*)lds; bf16* K_lds = (bf16*)(lds + 2 * SHM_V);
  float* ws = (float*)(lds + 2 * SHM_V + 2 * SHM_K) + wid * 64; float* li_l = ws; float* al_l = ws + 32;
  float m_reg = -1e30f, l_reg = 0; f32x16 o[4] = {}; bf16x8 qr[8];
  const bf16* Qw = Qb + (long)(wid * QBLK + r32) * NPROJ + hi * 8;
#pragma unroll
  for (int d0 = 0; d0 < 8; ++d0) qr[d0] = *reinterpret_cast<const bf16x8*>(Qw + d0 * 16);
  const unsigned mvoff = (unsigned)(wid * QBLK + r32) * 256u;
#define MWLD(j) __builtin_bit_cast(v2u, __builtin_amdgcn_raw_buffer_load_b64(rm, mvoff, (j) * 8, 0))
  const float hb = slopeS * (float)(4 * hi);
  const int sr = tid >> 4, sc = (tid & 15) * 8, vst0 = v_st(sr, sc), vst1 = v_st(32 + sr, sc);
  const int vb0 = (int)(uintptr_t)V_lds + v_rd_base(lane);
  struct { bf16x8 vs0, vs1, ks0, ks1; } sr_[2];
  const unsigned kvoff = (unsigned)(sr * LDK + sc) * 2u;
  const __amdgpu_buffer_rsrc_t rk = __builtin_amdgcn_make_buffer_rsrc((void*)Kh, 0, SEQ * NPROJ * 2, 0x00020000);
  const __amdgpu_buffer_rsrc_t rv = __builtin_amdgcn_make_buffer_rsrc((void*)Vh, 0, SEQ * NPROJ * 2, 0x00020000);
  const __amdgpu_buffer_rsrc_t rm = __builtin_amdgcn_make_buffer_rsrc((void*)Mb, 0, 256 * 256, 0x00020000);
#define BL16(rs, so) __builtin_bit_cast(bf16x8, __builtin_amdgcn_raw_buffer_load_b128(rs, kvoff, (so), 0))
#define SLOAD(i, k0) do { const int so_ = (k0) * (LDK * 2); \
    sr_[i].vs0 = BL16(rv, so_); sr_[i].vs1 = BL16(rv, so_ + 32 * LDK * 2); sr_[i].ks0 = BL16(rk, so_); sr_[i].ks1 = BL16(rk, so_ + 32 * LDK * 2); } while (0)
#define SWRITE(b, i) do { *(bf16x8*)((char*)V_lds + (b) * SHM_V + vst0) = sr_[i].vs0;          \
    *(bf16x8*)((char*)V_lds + (b) * SHM_V + vst1) = sr_[i].vs1; int kc = sc * 2;               \
    *(bf16x8*)((char*)K_lds + (b) * SHM_K + KSWZ(sr, kc)) = sr_[i].ks0;                       \
    *(bf16x8*)((char*)K_lds + (b) * SHM_K + KSWZ(32 + sr, kc)) = sr_[i].ks1; } while (0)
#define SWAIT() asm volatile("s_waitcnt vmcnt(4)" ::: "memory")
#define RESC(a) do { if (__any((a) < 1.f)) { if (hi == 0) al_l[r32] = (a); asm volatile("s_waitcnt lgkmcnt(0)" ::: "memory"); \
    for (int d = 0; d < 4; ++d) for (int r = 0; r < 16; ++r) o[d][r] *= al_l[crow(r, hi)]; } } while (0)
#define TBASE(j) fmaf(slopeS, (float)(64 * (j)), hb)
  f32x16 pA0, pA1, pB0, pB1; float mnA, mnB, alA, alB; bf16x8 pa0, pa1, pa2, pa3; const int NT = seq / KVBLK;
  constexpr int SE = 0, SO = 1;
  v2u mwA = MWLD(0), mwB = MWLD(1);
  SLOAD(SE, 0); asm volatile("s_waitcnt vmcnt(0)" ::: "memory"); SWRITE(0, SE); __syncthreads();
  qkt(pA0, pA1, K_lds, qr, r32, hi, slopeS, mwA); partialSM(pA0, pA1, m_reg, mnA, alA, TBASE(0));
  SLOAD(SO, KVBLK); if (2 < NT) SLOAD(SE, 2 * KVBLK);
  SWAIT(); SWRITE(1, SO); __syncthreads();
  for (int j = 1; j + 1 < NT; j += 2) {
    mwA = MWLD(j + 1);
    SBAR(); qkt(pB0, pB1, (bf16*)((char*)K_lds + SHM_K), qr, r32, hi, slopeS, mwB);
    finishSM(pA0, pA1, alA, l_reg, pa0, pa1, pa2, pa3); SBAR();
    SLOAD(SO, (j + 2) * KVBLK); SBAR();
    pv_d0(o, vb0, pa0, pa1, pa2, pa3); partialSM(pB0, pB1, m_reg, mnB, alB, TBASE(j));
    __syncthreads(); SWAIT(); SWRITE(0, SE);
    RESC(alB); __syncthreads();
    mwB = MWLD(j + 2);
    SBAR(); qkt(pA0, pA1, K_lds, qr, r32, hi, slopeS, mwA);
    finishSM(pB0, pB1, alB, l_reg, pa0, pa1, pa2, pa3); SBAR();
    if (j + 3 < NT) SLOAD(SE, (j + 3) * KVBLK); SBAR();
    pv_d0(o, vb0 + (int)SHM_V, pa0, pa1, pa2, pa3); partialSM(pA0, pA1, m_reg, mnA, alA, TBASE(j + 1));
    __syncthreads(); SWAIT(); SWRITE(1, SO);
    RESC(alA); __syncthreads();
  }
  SBAR(); qkt(pB0, pB1, (bf16*)((char*)K_lds + SHM_K), qr, r32, hi, slopeS, mwB);
  finishSM(pA0, pA1, alA, l_reg, pa0, pa1, pa2, pa3); SBAR();
  pv_d0(o, vb0, pa0, pa1, pa2, pa3); partialSM(pB0, pB1, m_reg, mnB, alB, TBASE(NT - 1));
  __syncthreads(); RESC(alB);
  finishSM(pB0, pB1, alB, l_reg, pa0, pa1, pa2, pa3); SBAR();
  pv_d0(o, vb0 + (int)SHM_V, pa0, pa1, pa2, pa3);
  if (hi == 0) li_l[r32] = l_reg; asm volatile("s_waitcnt lgkmcnt(0)" ::: "memory");
  float rli[16];
#pragma unroll
  for (int r = 0; r < 16; ++r) rli[r] = __builtin_amdgcn_rcpf(li_l[crow(r, hi)]);
  unsigned char* Ow = Ob + (long)(wid * QBLK) * 2048;
#pragma unroll
  for (int r = 0; r < 16; ++r) { int orow = crow(r, hi); const float sc = rli[r] * SC_MIX;
    const unsigned w = pk4_fp8(o[0][r] * sc, o[1][r] * sc, o[2][r] * sc, o[3][r] * sc);
    for (int d0 = 0; d0 < 4; ++d0) Ow[(long)orow * 2048 + d0 * 32 + r32] = (unsigned char)(w >> (8 * d0)); }
#undef SLOAD
#undef SWRITE
#undef SWAIT
#undef RESC
#undef TBASE
#undef MWLD
#undef BL16
}
#undef KSWZ
#undef SBAR
}

template <bool OUT_BF16, bool IN_BF16 = false>
__device__ __forceinline__ void ln_row(const void* xrow, void* orow, const float* gam, const float* bet, int lane, unsigned* q8row = nullptr, float q8scale = 1.f) {
    const f32x4* xr = (const f32x4*)xrow + lane; const v2u* xh = (const v2u*)xrow + lane; const f32x4* gr = (const f32x4*)gam + lane; const f32x4* br = (const f32x4*)bet + lane;
    f32x4 v[8]; float s = 0.f;
#pragma unroll
    for (int j = 0; j < 8; ++j) { if constexpr (IN_BF16) { const v2u w = xh[64 * j]; v[j] = (f32x4){bflo(w.x), bfhi(w.x), bflo(w.y), bfhi(w.y)}; } else v[j] = xr[64 * j];
        s += (v[j][0] + v[j][1]) + (v[j][2] + v[j][3]); }
    const float mean = wave_sum(s) * (1.f / DM); float s2 = 0.f;
#pragma unroll
    for (int j = 0; j < 8; ++j) { v[j] = v[j] - mean; s2 += (v[j][0] * v[j][0] + v[j][1] * v[j][1]) + (v[j][2] * v[j][2] + v[j][3] * v[j][3]); }
    const float rstd = 1.f / sqrtf(wave_sum(s2) * (1.f / DM) + LN_EPS);
#pragma unroll
    for (int j = 0; j < 8; ++j) { const f32x4 o = v[j] * rstd * gr[64 * j] + br[64 * j];
        if constexpr (OUT_BF16) { v2u w; w.x = pk2(o[0], o[1]); w.y = pk2(o[2], o[3]); ((v2u*)orow)[lane + 64 * j] = w;
            if (q8row) q8row[lane + 64 * j] = pk4_fp8(o[0] * q8scale, o[1] * q8scale, o[2] * q8scale, o[3] * q8scale); }
        else ((f32x4*)orow)[lane + 64 * j] = o; }
}
template <bool OUT_BF16, bool IN_BF16 = false>
__device__ __forceinline__ void ln_row2(const void* xa, const void* xb_, void* oa, void* ob, const float* gam, const float* bet, int lane, unsigned* qa = nullptr, unsigned* qb = nullptr, float q8scale = 1.f, float2* sa = nullptr, float2* sb = nullptr) {
    const f32x4* gr = (const f32x4*)gam + lane; const f32x4* br = (const f32x4*)bet + lane;
    f32x4 v[2][8]; float s[2] = {0.f, 0.f};
#pragma unroll
    for (int r = 0; r < 2; ++r) { const void* xrow = r ? xb_ : xa; const f32x4* xr = (const f32x4*)xrow + lane; const v2u* xh = (const v2u*)xrow + lane;
#pragma unroll
        for (int j = 0; j < 8; ++j) { if constexpr (IN_BF16) { const v2u w = xh[64 * j]; v[r][j] = (f32x4){bflo(w.x), bfhi(w.x), bflo(w.y), bfhi(w.y)}; } else v[r][j] = xr[64 * j]; } }
#pragma unroll
    for (int r = 0; r < 2; ++r)
#pragma unroll
        for (int j = 0; j < 8; ++j) s[r] += (v[r][j][0] + v[r][j][1]) + (v[r][j][2] + v[r][j][3]);
    const float mean0 = wave_sum(s[0]) * (1.f / DM), mean1 = wave_sum(s[1]) * (1.f / DM); float s2[2] = {0.f, 0.f};
#pragma unroll
    for (int r = 0; r < 2; ++r) { const float mean = r ? mean1 : mean0;
#pragma unroll
        for (int j = 0; j < 8; ++j) { v[r][j] = v[r][j] - mean; s2[r] += (v[r][j][0] * v[r][j][0] + v[r][j][1] * v[r][j][1]) + (v[r][j][2] * v[r][j][2] + v[r][j][3] * v[r][j][3]); } }
    const float rstd0 = 1.f / sqrtf(wave_sum(s2[0]) * (1.f / DM) + LN_EPS), rstd1 = 1.f / sqrtf(wave_sum(s2[1]) * (1.f / DM) + LN_EPS);
    if (sa && lane == 0) { *sa = make_float2(mean0, rstd0); *sb = make_float2(mean1, rstd1); }
#pragma unroll
    for (int j = 0; j < 8; ++j) { const f32x4 g = gr[64 * j], b = br[64 * j];
#pragma unroll
        for (int r = 0; r < 2; ++r) { const f32x4 o = v[r][j] * (r ? rstd1 : rstd0) * g + b; void* orow = r ? ob : oa; unsigned* q8row = r ? qb : qa;
            if constexpr (OUT_BF16) { if (orow) { v2u w; w.x = pk2(o[0], o[1]); w.y = pk2(o[2], o[3]); ((v2u*)orow)[lane + 64 * j] = w; }
                if (q8row) q8row[lane + 64 * j] = pk4_fp8(o[0] * q8scale, o[1] * q8scale, o[2] * q8scale, o[3] * q8scale); }
            else ((f32x4*)orow)[lane + 64 * j] = o; } }
}
__device__ __forceinline__ float gelu_erf(float v) { return 0.5f * v * (1.0f + erff(v * 0.70710678118654752f)); }

__device__ __forceinline__ void ln_row2_mx6(const bf16* ra, const bf16* rb, const f32x4 (&g8)[8], const f32x4 (&b8)[8], int lane, unsigned char* qa, unsigned char* qb, float2* sa, float2* sb) {
    float v[2][32];
#pragma unroll
    for (int q = 0; q < 2; ++q) { const v4u* rp = (const v4u*)((q ? rb : ra) + 32 * lane);
#pragma unroll
        for (int j = 0; j < 4; ++j) { const v4u w = rp[j]; v[q][8 * j] = bflo(w.x); v[q][8 * j + 1] = bfhi(w.x); v[q][8 * j + 2] = bflo(w.y); v[q][8 * j + 3] = bfhi(w.y);
            v[q][8 * j + 4] = bflo(w.z); v[q][8 * j + 5] = bfhi(w.z); v[q][8 * j + 6] = bflo(w.w); v[q][8 * j + 7] = bfhi(w.w); } }
    float s0 = 0.f, s1 = 0.f;
#pragma unroll
    for (int i = 0; i < 32; ++i) { s0 += v[0][i]; s1 += v[1][i]; }
    const float mean0 = wave_sum(s0) * (1.f / DM), mean1 = wave_sum(s1) * (1.f / DM);
    float t0 = 0.f, t1 = 0.f;
#pragma unroll
    for (int i = 0; i < 32; ++i) { const float d0 = v[0][i] - mean0, d1 = v[1][i] - mean1; t0 = fmaf(d0, d0, t0); t1 = fmaf(d1, d1, t1); }
    const float rstd0 = 1.f / sqrtf(wave_sum(t0) * (1.f / DM) + LN_EPS), rstd1 = 1.f / sqrtf(wave_sum(t1) * (1.f / DM) + LN_EPS);
    if (lane == 0) { *sa = make_float2(mean0, rstd0); *sb = make_float2(mean1, rstd1); }
    v16f32 x0, y0, x1, y1;
#pragma unroll
    for (int j = 0; j < 8; ++j) { const f32x4 g = g8[j], b = b8[j];
#pragma unroll
        for (int e = 0; e < 4; ++e) { const int i = 4 * j + e; const float o0 = (v[0][i] - mean0) * rstd0 * g[e] + b[e], o1 = (v[1][i] - mean1) * rstd1 * g[e] + b[e];
            if (i < 16) { x0[i] = o0; x1[i] = o1; } else { y0[i - 16] = o0; y1[i - 16] = o1; } } }
    float a0, a1; MX6_AMAX(x0, y0, a0); MX6_AMAX(x1, y1, a1);
    mx6_store_block(qa, lane, x0, y0, a0); mx6_store_block(qb, lane, x1, y1, a1);
}

__device__ __forceinline__ void pretouch(Frame& F, const void* p, size_t bytes) {
    const unsigned* q = (const unsigned*)p; const size_t n = bytes / 128; unsigned acc = 0u;
#pragma unroll 4
    for (size_t i = (size_t)F.vcu * 512 + F.tid; i < n; i += (size_t)F.G * 512) acc ^= q[i * 32];
    asm volatile("" :: "v"(acc));
}
struct Args { const float* in[22]; float* out; unsigned char* ws; int ph_lo, ph_hi; };
constexpr int N_PHASES = 11;
__global__ void __launch_bounds__(NWAVES * 64, 2) mk_fwd(Args args) {
    extern __shared__ __attribute__((aligned(16))) unsigned char lds[];
    Frame F;
    F.lds = (LAS unsigned char*)lds;
    F.MISC = (volatile LAS unsigned*)(F.lds + MISC_OFF);
    F.tid = threadIdx.x; F.lane = F.tid & 63; F.wave = __builtin_amdgcn_readfirstlane(F.tid >> 6);
    F.G = gridDim.x; { const int bx = blockIdx.x; F.vcu = (F.G % 8 == 0) ? (bx % 8) * (F.G / 8) + bx / 8 : bx; }
    F.ws = args.ws; F.out = args.out; F.ctl = (unsigned*)(args.ws + WS_CTL);
#pragma unroll
    for (int i = 0; i < 22; ++i) F.in[i] = args.in[i];
    for (int u = F.tid; u < (LDS_BYTES - LDSCTL_OFF) / 4; u += NWAVES * 64) ((LAS unsigned*)(F.lds + LDSCTL_OFF))[u] = 0u;
    __syncthreads();
    const int lo = args.ph_lo, hi = args.ph_hi;
    XcdBarrier bar; bar.bar = F.ctl + CW_BAR; bar.x = 0; bar.st = nullptr;
    if (hi - lo > 1) bar = xcd_barrier_post(F.ctl + CW_BAR, F.MISC + 8);
#define IN(k) (lo <= (k) && (k) < hi)
#define SEAM(k) do { if (IN(k) && IN((k) + 1)) xcd_barrier(bar); } while (0)
    const int gw = F.vcu * NWAVES + F.wave, NGW = F.G * NWAVES;
    bf16* xb = (bf16*)(F.ws + WS_XB); bf16* proj = (bf16*)(F.ws + WS_PROJ); bf16* ygb = (bf16*)(F.ws + WS_YG); unsigned char* mix8 = (unsigned char*)(F.ws + WS_MIX);   unsigned char* act8 = (unsigned char*)(F.ws + WS_ACT);

    if (IN(0)) { p0_prologue(F); } SEAM(0);
    if (IN(1)) {
        const int c = (int)blockIdx.x; const bool g256 = (F.G == 256);
        pg8::ListOrder Sb, Sf;
        if (g256) { Sb.init(M, NPROJ - NP8, c, 256, c < 64 ? 2 : 1); Sf.init(M, NP8, c, 192, c < 64 ? 1 : 3); }
        else { Sb.init(M, NPROJ - NP8, c, F.G, 1 << 20); Sf.init(M, NP8, c, F.G, 1 << 20); }
        { pg8::Gemm g{xb, (const bf16*)(F.ws + WS_WIN) + (size_t)NP8 * DM, M, NPROJ - NP8, DM};
          pg8::EpiProj E{proj, NPROJ, (bf16*)(F.ws + WS_KIPACK), KI_OFF, SEQ, NP8, 1.f};
          pg8::gemm_phase<pg8::EpiProj, pg8::ListOrder, true, true, false>(F.lds + RING_OFF, g, Sb, E); }
        { pg8::Gemm g{(const bf16*)(F.ws + WS_MIX + 32 * MiB), (const bf16*)(F.ws + WS_WIN8), M, NP8, DM / 2};
          pg8::EpiProj E{proj, NPROJ, (bf16*)(F.ws + WS_KIPACK), KI_OFF, SEQ, 0, 1.f / (SC_X * SC_WIN)};
          pg8::gemm_phase<pg8::EpiProj, pg8::ListOrder, true, true, true>(F.lds + RING_OFF, g, Sf, E); }
    } SEAM(1);
    if (IN(2)) {
        { const int g = (F.vcu >> 2) & (NG - 1); LAS fl4* tInv = (LAS fl4*)(F.lds + RING_OFF); LAS fl4* tW = tInv + 2 * 8 * 64;
          for (int i = F.tid; i < 1024; i += NWAVES * 64) { tInv[i] = ((const fl4*)(F.ws + WS_TABINV))[g * 1024 + i]; tW[i] = ((const fl4*)(F.ws + WS_TABW))[g * 1024 + i]; }
          const int ib = F.vcu & 7;
          { const v4u* ksrc = (const v4u*)(F.ws + WS_KIPACK + (size_t)ib * 64 * 4096); LAS v4u* kdst = (LAS v4u*)(F.lds + RING_OFF + 32768);
#pragma unroll 4
            for (int i = F.tid; i < IDX_NLDS * 256; i += NWAVES * 64) kdst[i] = ksrc[i]; }
          LDS_WAIT(); __syncthreads();
          if ((F.wave & 2) == 0) { const int bb = 2 * (F.vcu & 3) + (F.wave & 1), half = F.wave >> 2;
              if (F.vcu < 4 * NG) ssm_mfma_task(F, bb, g, tInv, tW, ygb, 0, half ? SEQ / 64 : 0, half ? SEQ / 32 : SEQ / 64); }
          { LAS unsigned* ctr = (LAS unsigned*)(F.lds + MISC_OFF + 64); LAS unsigned* ctr2 = (LAS unsigned*)(F.lds + MISC_OFF + 68); const int ic = F.vcu >> 3, inb = (F.G - ib + 7) >> 3, npb = (SEQ / 2 + inb - 1) / inb;
            const LAS bf16* kl = (const LAS bf16*)(F.lds + RING_OFF + 32768) + F.lane * 8;
#pragma unroll 1
            for (int pass = 0; pass < 3; ++pass) {
                if (pass == 1) {
                    for (;;) { unsigned m = 0; if (F.lane == 0) m = __hip_atomic_fetch_add(ctr, 1u, __ATOMIC_RELAXED, __HIP_MEMORY_SCOPE_WORKGROUP);
                        m = __builtin_amdgcn_readfirstlane(m); if ((int)m >= npb) break;
                        const int k = (int)m * inb + ((m & 1u) ? inb - 1 - ic : ic); if (k >= SEQ / 2) continue;
                        int ibo; asm volatile("s_mov_b32 %0, %1" : "=s"(ibo) : "s"(ib));
                        idx_mfma_pair(F, ibo, 1023 - k, (unsigned*)(F.ws + WS_MASK), kl); }
                } else if (pass == 2 || F.wave == 7) {
                    for (;;) { unsigned m = 0; if (F.lane == 0) m = __hip_atomic_fetch_add(ctr2, 1u, __ATOMIC_RELAXED, __HIP_MEMORY_SCOPE_WORKGROUP);
                        m = __builtin_amdgcn_readfirstlane(m); const int it = (int)m * F.G + F.vcu; if (it >= P2W_ITEMS) break;
                        p2_weight_item(F, it); } }
            } } }
    } SEAM(2);
    if (IN(3)) {
        const unsigned* maskw = (const unsigned*)(F.ws + WS_MASK);
#pragma unroll 1
        for (int pi = F.vcu; pi < 256; pi += F.G) { const int b = pi >> 5, h = (pi >> 2) & 7, qp = pi & 3, c = h >> 2;
#pragma unroll 1
            for (int half = 0; half < 2; ++half) { const int qb = half ? qp : 7 - qp; const size_t row0 = (size_t)b * SEQ + qb * 256;
                att::attn_mask_body(proj + row0 * NPROJ + Q_OFF + h * HD, proj + (size_t)b * SEQ * NPROJ + K_OFF + c * HD, proj + (size_t)b * SEQ * NPROJ + V_OFF + c * HD,
                                    maskw + row0 * 64, mix8 + row0 * 2048 + 1024 + h * HD, 256 * (qb + 1), exp2f(-(float)(h + 1)) / att::SCALE, (char*)lds + RING_OFF);
                __syncthreads(); } }
    }
    if (IN(4)) { pg8::Gemm g{ygb, (const bf16*)(F.ws + WS_WGLU), M, SSMW, SSMW}; pg8::StaticOrder S; S.init(M, SSMW, F.G, (int)blockIdx.x);
        pg8::EpiGlu E{ygb, mix8, SSMW, 2048, F.in[I_BGLU], SC_MIX};
        pg8::gemm_phase<pg8::EpiGlu, pg8::StaticOrder, true, true>(F.lds + RING_OFF, g, S, E); } SEAM(4);
    if (IN(5)) { pg8::Gemm g{(const bf16*)mix8, (const bf16*)(F.ws + WS_WOUT), M, DM, 2048 / 2}; pg8::StaticOrder S; S.init(M, DM, F.G, (int)blockIdx.x);
        pg8::EpiRes<true, true> E{xb, F.out, DM, DN_ALPHA, 1.f / (SC_MIX * SC_WOUT)};
        pg8::gemm_phase<pg8::EpiRes<true, true>, pg8::StaticOrder, true, true, true>(F.lds + RING_OFF, g, S, E); } SEAM(5);
    if (IN(6)) { unsigned* q8 = (unsigned*)(F.ws + WS_MIX + 32 * MiB); const bf16* r1b = (const bf16*)F.out;
        f32x4 g8[8], b8[8];
#pragma unroll
        for (int j = 0; j < 8; ++j) { g8[j] = ((const f32x4*)(F.in[I_LN1G] + 32 * F.lane))[j]; b8[j] = ((const f32x4*)(F.in[I_LN1B] + 32 * F.lane))[j]; }
        for (int m = gw; m < M; m += 2 * NGW) { const int m2 = (m + NGW < M) ? m + NGW : m;
            ln_row2_mx6(r1b + (size_t)m * DM, r1b + (size_t)m2 * DM, g8, b8, F.lane, (unsigned char*)q8 + (size_t)m * DM, (unsigned char*)q8 + (size_t)m2 * DM,
                        (float2*)(F.ws + WS_RSTAT) + m, (float2*)(F.ws + WS_RSTAT) + m2); }
        pretouch(F, F.ws + WS_WUG, (size_t)NUG * DM); } SEAM(6);
    if (IN(7)) { pg8::Gemm g{(const bf16*)(F.ws + WS_MIX + 32 * MiB), (const bf16*)(F.ws + WS_WUG), M, NUG, DM / 2}; pg8::StaticOrder S; S.init(M, NUG, F.G, (int)blockIdx.x);
        pg8::EpiFfn E{act8, (float*)(F.ws + WS_PEND_UP), (float*)(F.ws + WS_PEND_G), (float*)(F.ws + WS_HALO), F.in[I_CONVW], F.in[I_CONVB], DFF, 1.f, SC_ACT};
        pg8::gemm_phase<pg8::EpiFfn, pg8::StaticOrder, true, true, true, true>(F.lds + RING_OFF, g, S, E); } SEAM(7);
    if (IN(8)) { const float* pu = (const float*)(F.ws + WS_PEND_UP); const float* pg = (const float*)(F.ws + WS_PEND_G); const float* ph = (const float*)(F.ws + WS_HALO);
        const float* cw = F.in[I_CONVW]; const float* cb = F.in[I_CONVB];
        for (int idx = F.vcu * 512 + F.tid; idx < 512 * (DFF / 4); idx += F.G * 512) { const int r2 = idx / (DFF / 4), f = (idx % (DFF / 4)) * 4, rb = r2 >> 1, rho = r2 & 1; const bool first = (rb & 31) == 0;
            const f32x4 x0 = *(const f32x4*)(pu + (size_t)r2 * DFF + f), gt = *(const f32x4*)(pg + (size_t)r2 * DFF + f); const f32x4 z = {0.f, 0.f, 0.f, 0.f};
            f32x4 h1, h2;
            if (rho == 0) { h1 = first ? z : *(const f32x4*)(ph + (size_t)((rb - 1) * 2 + 1) * DFF + f); h2 = first ? z : *(const f32x4*)(ph + (size_t)((rb - 1) * 2) * DFF + f); }
            else { h1 = *(const f32x4*)(pu + (size_t)(rb * 2) * DFF + f); h2 = first ? z : *(const f32x4*)(ph + (size_t)((rb - 1) * 2 + 1) * DFF + f); }
            const f32x4 hc = *(const f32x4*)(cb + f) + *(const f32x4*)(cw + f) * h2 + *(const f32x4*)(cw + DFF + f) * h1 + *(const f32x4*)(cw + 2 * DFF + f) * x0;
            *(unsigned*)(act8 + (size_t)(rb * 64 + rho) * DFF + f) = pk4_fp8(gelu_erf(hc[0]) * gt[0] * SC_ACT, gelu_erf(hc[1]) * gt[1] * SC_ACT, gelu_erf(hc[2]) * gt[2] * SC_ACT, gelu_erf(hc[3]) * gt[3] * SC_ACT); } } SEAM(8);
    if (IN(9)) { pg8::Gemm g{(const bf16*)act8, (const bf16*)(F.ws + WS_WDOWN), M, DM, DFF / 2}; pg8::StaticOrder S; S.init(M, DM, F.G, (int)blockIdx.x);
        pg8::EpiDownLN E{(const bf16*)F.out, (bf16*)(F.ws + WS_MIX), (const pg8::f32x2*)(F.ws + WS_RSTAT), F.in[I_LN1G], F.in[I_LN1B], DM, DN_ALPHA, 1.f / (SC_ACT * SC_WDN)};
        pg8::gemm_phase<pg8::EpiDownLN, pg8::StaticOrder, true, true, true>(F.lds + RING_OFF, g, S, E); } SEAM(9);
    if (IN(10)) { const bf16* r2b = (const bf16*)(F.ws + WS_MIX);
        for (int m = gw; m < M; m += 2 * NGW) { const int m2 = (m + NGW < M) ? m + NGW : m;
            ln_row2<false, true>(r2b + (size_t)m * DM, r2b + (size_t)m2 * DM, F.out + (size_t)m * DM, F.out + (size_t)m2 * DM, F.in[I_LN2G], F.in[I_LN2B], F.lane); }
    }
#undef IN
#undef SEAM
}

#ifndef MK_ONE_LAUNCH
#define MK_ONE_LAUNCH 1
#endif
extern "C" void kernel_launch(void* const* d_in, const int* in_sizes, int n_in, void* d_out, int out_size, void* d_ws, size_t ws_size, hipStream_t stream) {
    static int grid = 0;
    if (grid == 0) {
        if (n_in != 22 || in_sizes[0] != M * DM || out_size != M * DM || ws_size < WS_END) { fprintf(stderr, "kernel_launch: shape/workspace mismatch (n_in %d, in0 %d, out %d, ws %zu, need %zu)\n", n_in, n_in > 0 ? in_sizes[0] : -1, out_size, ws_size, (size_t)WS_END); grid = -1; return; }
        int dev = 0, cus = 0, per_cu = 0;
        if (hipGetDevice(&dev) != hipSuccess || hipDeviceGetAttribute(&cus, hipDeviceAttributeMultiprocessorCount, dev) != hipSuccess) { grid = -1; return; }
        if (hipFuncSetAttribute((const void*)mk_fwd, hipFuncAttributeMaxDynamicSharedMemorySize, LDS_BYTES) != hipSuccess) { fprintf(stderr, "kernel_launch: hipFuncSetAttribute failed\n"); grid = -1; return; }
        if (hipOccupancyMaxActiveBlocksPerMultiprocessor(&per_cu, (const void*)mk_fwd, NWAVES * 64, LDS_BYTES) != hipSuccess || per_cu < 1) fprintf(stderr, "kernel_launch: occupancy query reports %d\n", per_cu);
        (void)hipGetLastError();
        grid = cus;
    }
    if (grid < 0) return;
    if (hipMemsetAsync((char*)d_ws + WS_CTL, 0, CTL_ZERO_BYTES, stream) != hipSuccess) return;
    Args a{};
    for (int i = 0; i < 22; ++i) a.in[i] = (const float*)d_in[i];
    a.out = (float*)d_out; a.ws = (unsigned char*)d_ws;
#if MK_ONE_LAUNCH
    a.ph_lo = 0; a.ph_hi = N_PHASES;
    hipLaunchKernelGGL(mk_fwd, dim3(grid), dim3(NWAVES * 64), LDS_BYTES, stream, a);
#else
    for (int p = 0; p < N_PHASES; ++p) { a.ph_lo = p; a.ph_hi = p + 1; hipLaunchKernelGGL(mk_fwd, dim3(grid), dim3(NWAVES * 64), LDS_BYTES, stream, a); }
#endif
}
```

```cpp
#include <hip/hip_runtime.h>
#include <cstdio>
#include <cstdint>
namespace pg8 {
#define PG8_LAS __attribute__((address_space(3)))
typedef unsigned short bf16_t;
typedef short bf16x8 __attribute__((ext_vector_type(8)));
typedef float f32x4 __attribute__((ext_vector_type(4)));
typedef unsigned u32x4 __attribute__((ext_vector_type(4)));
typedef int v8i32 __attribute__((ext_vector_type(8)));
constexpr int BM = 256, BK = 64, HALF = 128, HTB = HALF * BK * 2  , STAGE_BYTES = 8 * HTB, NXCD = 8, WGM = 8;

__host__ __device__ __forceinline__ int lds_byte(int r, int c) { const int st = (r >> 4) * 2 + (c >> 5), rr = r & 15, cc = c & 31, ob = rr * 64 + cc * 2; return st * 1024 + (ob ^ (((ob >> 9) & 1) << 5)); }
__host__ __device__ __forceinline__ void stage_rc(int b, int& R, int& C) { const int st = b / 1024, sb = b % 1024, swz = sb ^ (((sb >> 9) & 1) << 5); R = (st >> 1) * 16 + swz / 64; C = (st & 1) * 32 + (swz % 64) / 2; }
__host__ __device__ __forceinline__ int perm32(int rho) { const int n = rho >> 4, i = rho & 15; return 8 * (i >> 2) + 4 * n + (i & 3); }

struct Unit { int pm, pn; };
struct Gemm { const bf16_t* A; const bf16_t* Bt; int M, N, K; };

struct DynOrder {
    static constexpr bool DYNAMIC = true;
    int nMx, nN, G, c; unsigned* ctr; PG8_LAS unsigned* slot;
    __device__ void init(int M, int N, int G_, int c_, unsigned* ctr0, PG8_LAS unsigned* slot_) { nMx = M / BM / NXCD; nN = N / BM; G = G_; c = c_; ctr = ctr0 + (c_ % NXCD) * 32; slot = slot_; }
    __device__ __forceinline__ bool next(int i, Unit& u) const {
        int e;
        if (i < 2) e = i * (G / NXCD) + c / NXCD;
        else e = __builtin_amdgcn_readfirstlane((int)slot[i & 1]);
        if (e >= nMx * nN) return false;
        u.pm = nMx * (c % NXCD) + e % nMx; u.pn = e / nMx; return true;
    }
    __device__ __forceinline__ void pull(unsigned& v) const {
        unsigned zero = 0u, one = 1u;
        asm volatile("s_nop 4\n\tglobal_atomic_add %0, %1, %2, %3 sc0" : "=v"(v) : "v"(zero), "v"(one), "s"(ctr) : "memory");
    }
    __device__ __forceinline__ void publish(int i, unsigned v) const { slot[i & 1] = v + 2u * (unsigned)(G / NXCD); }
    __device__ __forceinline__ void a_ready(const Unit&) const {}
    __device__ __forceinline__ void done(const Unit&) const {}
};
struct StaticOrder {
    static constexpr bool DYNAMIC = false;
    int nM, nN, nwg, G, c;
    __host__ __device__ void init(int M, int N, int G_, int c_) { nM = M / BM; nN = N / BM; nwg = nM * nN; G = G_; c = c_; }
    __host__ __device__ bool next(int i, Unit& u) const {
        const long L = (long)i * G + c; if (L >= nwg) return false;
        int wgid = (int)L; { const int q = nwg / NXCD, r = nwg % NXCD, xcd = wgid % NXCD, off = wgid / NXCD; wgid = (xcd < r ? xcd * (q + 1) : r * (q + 1) + (xcd - r) * q) + off; }
        const int nig = WGM * nN, gid = wgid / nig, fm = gid * WGM, gsz = (nM - fm) < WGM ? (nM - fm) : WGM;
        u.pm = fm + ((wgid % nig) % gsz); u.pn = (wgid % nig) / gsz; return true;
    }
    __device__ __forceinline__ void a_ready(const Unit&) const {}
    __device__ __forceinline__ void done(const Unit&) const {}
};

struct ListOrder {
    static constexpr bool DYNAMIC = false;
    int nM, nN, nwg, L0, dL, cnt;
    __host__ __device__ void init(int M, int N, int L0_, int dL_, int cnt_) { nM = M / BM; nN = N / BM; nwg = nM * nN; L0 = L0_; dL = dL_; cnt = cnt_; }
    __host__ __device__ bool next(int i, Unit& u) const {
        if (i >= cnt) return false; const int L = L0 + i * dL; if (L >= nwg) return false;
        int wgid = L; { const int q = nwg / NXCD, r = nwg % NXCD, xcd = wgid % NXCD, off = wgid / NXCD; wgid = (xcd < r ? xcd * (q + 1) : r * (q + 1) + (xcd - r) * q) + off; }
        const int nig = WGM * nN, gid = wgid / nig, fm = gid * WGM, gsz = (nM - fm) < WGM ? (nM - fm) : WGM;
        u.pm = fm + ((wgid % nig) % gsz); u.pn = (wgid % nig) / gsz; return true;
    }
    __device__ __forceinline__ void a_ready(const Unit&) const {}
    __device__ __forceinline__ void done(const Unit&) const {}
};

__device__ __forceinline__ unsigned cvt_pk_bf16(float lo, float hi) { unsigned r; asm volatile("v_cvt_pk_bf16_f32 %0, %1, %2" : "=v"(r) : "v"(lo), "v"(hi)); return r; }
typedef float f32x2 __attribute__((ext_vector_type(2)));
__device__ __forceinline__ f32x2 gelu_pk(f32x2 v) {
    f32x2 vc; vc.x = __builtin_amdgcn_fmed3f(v.x, -4.6f, 4.6f); vc.y = __builtin_amdgcn_fmed3f(v.y, -4.6f, 4.6f);
    const f32x2 w = vc * vc;
    f32x2 r = w * 7.3846917937e-14f + (-9.6073152826e-12f);
    r = r * w + 5.6255834838e-10f; r = r * w + (-1.9781858177e-08f); r = r * w + 4.7227388803e-07f; r = r * w + (-8.2408235147e-06f); r = r * w + 1.1056416036e-04f;
    r = r * w + (-1.1755027258e-03f); r = r * w + 9.9585457053e-03f; r = r * w + (-6.6482846440e-02f); r = r * w + 3.9894164923e-01f;
    return v * (vc * r + 0.5f);
}

template <int ACT  > struct EpiBf16 {
    static constexpr bool PERM = true, AFTER_DRAIN = false; static_assert(ACT == 0 || ACT == 1, "EpiBf16: ACT is 0 (none) or 1 (gelu_pk)");
    bf16_t* O; int ldc; const float* bias; int split_cols; size_t split_stride; float scale0;
    __device__ __forceinline__ void operator()(const f32x4 (&acc)[2][2][4][2], const Unit& u, int wr, int wc, int fr, int fq) const {
        const int row0 = u.pm * BM + wr * 64 + fr; int colt = u.pn * BM; bf16_t* base = O;
        float sc = 1.f; if (split_cols) { const int t = colt / split_cols; base += (size_t)t * split_stride; colt -= t * split_cols; if (t == 0) sc = scale0; }
        const int col0 = colt + wc * 32 + 8 * fq, bcol0 = u.pn * BM + wc * 32 + 8 * fq;
        f32x4 bv[2][2];
#pragma unroll
        for (int bj = 0; bj < 2; ++bj)
#pragma unroll
            for (int n = 0; n < 2; ++n) bv[bj][n] = bias ? *(const f32x4*)(bias + bcol0 + bj * HALF + 4 * n) : (f32x4){0.f, 0.f, 0.f, 0.f};
#pragma unroll
        for (int ai = 0; ai < 2; ++ai)
#pragma unroll
            for (int m = 0; m < 4; ++m) { bf16_t* rowp = base + (size_t)(row0 + ai * HALF + m * 16) * ldc + col0;
#pragma unroll
                for (int bj = 0; bj < 2; ++bj) { f32x4 v0 = acc[ai][bj][m][0] + bv[bj][0], v1 = acc[ai][bj][m][1] + bv[bj][1];
                    if (ACT == 1) { f32x2 a = gelu_pk((f32x2){v0[0], v0[1]}), b = gelu_pk((f32x2){v0[2], v0[3]}), c = gelu_pk((f32x2){v1[0], v1[1]}), d = gelu_pk((f32x2){v1[2], v1[3]});
                        v0 = (f32x4){a.x, a.y, b.x, b.y}; v1 = (f32x4){c.x, c.y, d.x, d.y}; }
                    v0 = v0 * sc; v1 = v1 * sc; u32x4 w; w.x = cvt_pk_bf16(v0[0], v0[1]); w.y = cvt_pk_bf16(v0[2], v0[3]); w.z = cvt_pk_bf16(v1[0], v1[1]); w.w = cvt_pk_bf16(v1[2], v1[3]);
                    *(u32x4*)(rowp + bj * HALF) = w; } }
    }
};

__device__ __forceinline__ float bf2f(unsigned short b) { return __uint_as_float(((unsigned)b) << 16); }
__device__ __forceinline__ float bflo(unsigned w) { return __uint_as_float(w << 16); }
__device__ __forceinline__ float bfhi(unsigned w) { return __uint_as_float(w & 0xffff0000u); }
__device__ __forceinline__ float dpp_ror1(float x) { return __builtin_bit_cast(float, __builtin_amdgcn_update_dpp(0, __builtin_bit_cast(int, x), 0x121, 0xf, 0xf, false)); }
__device__ __forceinline__ float dpp_ror2(float x) { return __builtin_bit_cast(float, __builtin_amdgcn_update_dpp(0, __builtin_bit_cast(int, x), 0x122, 0xf, 0xf, false)); }
__device__ __forceinline__ float clamp448(float v) { return __builtin_amdgcn_fmed3f(v, -448.f, 448.f); }
__device__ __forceinline__ unsigned pk4_fp8(float a, float b, float c, float d) {
    int w = 0; w = __builtin_amdgcn_cvt_pk_fp8_f32(clamp448(a), clamp448(b), w, false); w = __builtin_amdgcn_cvt_pk_fp8_f32(clamp448(c), clamp448(d), w, true); return (unsigned)w; }
__device__ __forceinline__ float sigmoidf_fast(float v) { return __builtin_amdgcn_rcpf(1.0f + __builtin_amdgcn_exp2f(-1.4426950408889634f * v)); }

struct EpiProj {
    static constexpr bool PERM = true, AFTER_DRAIN = false;
    bf16_t* O; int ldc; bf16_t* kipack; int kcol0; int seq; int col_off; float ascale;
    __device__ __forceinline__ void operator()(const f32x4 (&acc)[2][2][4][2], const Unit& u, int wr, int wc, int fr, int fq) const {
        const int row0 = u.pm * BM + wr * 64 + fr, col0 = col_off + u.pn * BM + wc * 32 + 8 * fq;
        const bool kt_tile = (col_off + u.pn * BM == kcol0) && (wc < 2);
#pragma unroll
        for (int ai = 0; ai < 2; ++ai)
#pragma unroll
            for (int m = 0; m < 4; ++m) { const int row = row0 + ai * HALF + m * 16; bf16_t* rowp = O + (size_t)row * ldc + col0;
#pragma unroll
                for (int bj = 0; bj < 2; ++bj) { const f32x4 v0 = acc[ai][bj][m][0] * ascale, v1 = acc[ai][bj][m][1] * ascale;
                    u32x4 w; w.x = cvt_pk_bf16(v0[0], v0[1]); w.y = cvt_pk_bf16(v0[2], v0[3]); w.z = cvt_pk_bf16(v1[0], v1[1]); w.w = cvt_pk_bf16(v1[2], v1[3]);
                    *(u32x4*)(rowp + bj * HALF) = w;
                    if (bj == 0 && kt_tile) { const int b = row / seq, t = row % seq, d0 = wc * 32 + 8 * fq;
                        *(u32x4*)(kipack + ((size_t)((b * (seq / 32) + (t >> 5)) * 4 + (d0 >> 4)) * 64 + (t & 31) + 32 * ((d0 >> 3) & 1)) * 8) = w; } } }
    }
};
struct EpiGlu {
    static constexpr bool PERM = true, AFTER_DRAIN = false;
    const bf16_t* yg; unsigned char* O; int ldy, ldo; const float* bias; float oscale;
    __device__ __forceinline__ void operator()(const f32x4 (&acc)[2][2][4][2], const Unit& u, int wr, int wc, int fr, int fq) const {
        const int row0 = u.pm * BM + wr * 64 + fr, col0 = u.pn * BM + wc * 32 + 8 * fq;
        f32x4 bv[2][2];
#pragma unroll
        for (int bj = 0; bj < 2; ++bj)
#pragma unroll
            for (int n = 0; n < 2; ++n) bv[bj][n] = *(const f32x4*)(bias + col0 + bj * HALF + 4 * n);
#pragma unroll
        for (int ai = 0; ai < 2; ++ai)
#pragma unroll
            for (int m = 0; m < 4; ++m) { const size_t row = (size_t)(row0 + ai * HALF + m * 16);
#pragma unroll
                for (int bj = 0; bj < 2; ++bj) { const int c = col0 + bj * HALF;
                    const u32x4 yv = *(const u32x4*)(yg + row * ldy + c);
                    const f32x4 v0 = acc[ai][bj][m][0] + bv[bj][0], v1 = acc[ai][bj][m][1] + bv[bj][1];
                    float o[8];
                    o[0] = bflo(yv.x) * sigmoidf_fast(v0[0]); o[1] = bfhi(yv.x) * sigmoidf_fast(v0[1]); o[2] = bflo(yv.y) * sigmoidf_fast(v0[2]); o[3] = bfhi(yv.y) * sigmoidf_fast(v0[3]);
                    o[4] = bflo(yv.z) * sigmoidf_fast(v1[0]); o[5] = bfhi(yv.z) * sigmoidf_fast(v1[1]); o[6] = bflo(yv.w) * sigmoidf_fast(v1[2]); o[7] = bfhi(yv.w) * sigmoidf_fast(v1[3]);
                    typedef unsigned u32x2v __attribute__((ext_vector_type(2))); const float os = oscale;
                    u32x2v w; w.x = pk4_fp8(o[0] * os, o[1] * os, o[2] * os, o[3] * os); w.y = pk4_fp8(o[4] * os, o[5] * os, o[6] * os, o[7] * os);
                    *(u32x2v*)(O + row * ldo + c) = w; } }
    }
};
template <bool RES_BF16, bool OUT_BF16 = false> struct EpiRes {
    static constexpr bool PERM = false, AFTER_DRAIN = false;
    const void* res; float* out; int ldc; float alpha; float ascale;
    __device__ __forceinline__ void operator()(const f32x4 (&acc)[2][2][4][2], const Unit& u, int wr, int wc, int fr, int fq) const {
        typedef unsigned u32x2v __attribute__((ext_vector_type(2)));
        const int row0 = u.pm * BM + wr * 64 + fr, col0 = u.pn * BM + wc * 32 + 4 * fq;
#pragma unroll
        for (int ai = 0; ai < 2; ++ai)
#pragma unroll
            for (int m = 0; m < 4; ++m) { const size_t off = (size_t)(row0 + ai * HALF + m * 16) * ldc + col0;
#pragma unroll
                for (int bj = 0; bj < 2; ++bj)
#pragma unroll
                    for (int n = 0; n < 2; ++n) { const size_t o2 = off + bj * HALF + n * 16; f32x4 r;
                        if constexpr (RES_BF16) { const u32x2v w = *(const u32x2v*)((const bf16_t*)res + o2); r = (f32x4){bflo(w.x), bfhi(w.x), bflo(w.y), bfhi(w.y)}; }
                        else r = *(const f32x4*)((const float*)res + o2);
                        const f32x4 o = r * alpha + acc[ai][bj][m][n] * ascale;
                        if constexpr (OUT_BF16) { u32x2v w; w.x = cvt_pk_bf16(o[0], o[1]); w.y = cvt_pk_bf16(o[2], o[3]); *(u32x2v*)((bf16_t*)out + o2) = w; }
                        else *(f32x4*)(out + o2) = o; } }
    }
};
struct EpiDownLN {
    static constexpr bool PERM = false, AFTER_DRAIN = false;
    const bf16_t* r1; bf16_t* out; const f32x2* rstat; const float* gam; const float* bet; int ldc; float alpha, ascale;
    __device__ __forceinline__ void operator()(const f32x4 (&acc)[2][2][4][2], const Unit& u, int wr, int wc, int fr, int fq) const {
        typedef unsigned u32x2v __attribute__((ext_vector_type(2)));
        const int row0 = u.pm * BM + wr * 64 + fr, col0 = u.pn * BM + wc * 32 + 4 * fq;
        f32x4 gv[2][2], bv[2][2];
#pragma unroll
        for (int bj = 0; bj < 2; ++bj)
#pragma unroll
            for (int n = 0; n < 2; ++n) { gv[bj][n] = *(const f32x4*)(gam + col0 + bj * HALF + n * 16) * alpha; bv[bj][n] = *(const f32x4*)(bet + col0 + bj * HALF + n * 16) * alpha; }
#pragma unroll
        for (int ai = 0; ai < 2; ++ai)
#pragma unroll
            for (int m = 0; m < 4; ++m) { const int row = row0 + ai * HALF + m * 16; const f32x2 st = rstat[row]; const size_t off = (size_t)row * ldc + col0;
#pragma unroll
                for (int bj = 0; bj < 2; ++bj)
#pragma unroll
                    for (int n = 0; n < 2; ++n) { const size_t o2 = off + bj * HALF + n * 16; const u32x2v w0 = *(const u32x2v*)(r1 + o2);
                        const f32x4 r = {bflo(w0.x), bfhi(w0.x), bflo(w0.y), bfhi(w0.y)};
                        const f32x4 o = (r - st.x) * st.y * gv[bj][n] + bv[bj][n] + acc[ai][bj][m][n] * ascale;
                        u32x2v w; w.x = cvt_pk_bf16(o[0], o[1]); w.y = cvt_pk_bf16(o[2], o[3]); *(u32x2v*)(out + o2) = w; } }
    }
};
struct EpiFfn {
    static constexpr bool PERM = true, AFTER_DRAIN = false;
    unsigned char* act; float* pend_up; float* pend_gate; float* halo_up; const float* cw; const float* cb; int ldc; float ascale, oscale;
    __device__ __forceinline__ void operator()(const f32x4 (&acc)[2][2][4][2], const Unit& u, int wr, int wc, int fr, int fq) const {
        const int f0 = u.pn * HALF + wc * 32 + 8 * fq;
        float c0[8], c1[8], c2[8], cbv[8];
        { const f32x4 a0 = *(const f32x4*)(cw + f0), a1 = *(const f32x4*)(cw + f0 + 4), b0 = *(const f32x4*)(cw + ldc + f0), b1 = *(const f32x4*)(cw + ldc + f0 + 4);
          const f32x4 d0 = *(const f32x4*)(cw + 2 * ldc + f0), d1 = *(const f32x4*)(cw + 2 * ldc + f0 + 4), e0 = *(const f32x4*)(cb + f0), e1 = *(const f32x4*)(cb + f0 + 4);
#pragma unroll
          for (int j = 0; j < 4; ++j) { c0[j] = a0[j] * ascale; c0[4 + j] = a1[j] * ascale; c1[j] = b0[j] * ascale; c1[4 + j] = b1[j] * ascale; c2[j] = d0[j] * ascale; c2[4 + j] = d1[j] * ascale; cbv[j] = e0[j]; cbv[4 + j] = e1[j]; } }
        const float gs = ascale * oscale;
#pragma unroll
        for (int ai = 0; ai < 2; ++ai) {
            const int rb = u.pm * 4 + ai * 2 + wr;
#pragma unroll
            for (int m = 0; m < 4; ++m) {
                const size_t row = (size_t)(rb * 64 + m * 16 + fr);
                float a[8];
#pragma unroll
                for (int n = 0; n < 2; ++n)
#pragma unroll
                    for (int j = 0; j < 4; ++j) { const int e = 4 * n + j;
                        const float x0 = acc[ai][0][m][n][j];
                        float h1 = dpp_ror1(x0), h2 = dpp_ror2(x0);
                        if (m > 0) { const float xm = acc[ai][0][m - 1][n][j]; const float q1 = dpp_ror1(xm), q2 = dpp_ror2(xm); h1 = fr >= 1 ? h1 : q1; h2 = fr >= 2 ? h2 : q2; }
                        a[e] = cbv[e] + c0[e] * h2 + c1[e] * h1 + c2[e] * x0; }
                const f32x2 g0 = gelu_pk((f32x2){a[0], a[1]}), g1 = gelu_pk((f32x2){a[2], a[3]}), g2 = gelu_pk((f32x2){a[4], a[5]}), g3 = gelu_pk((f32x2){a[6], a[7]});
                const f32x4 gr0 = acc[ai][1][m][0], gr1 = acc[ai][1][m][1];
                const f32x2 o0 = g0 * (f32x2){gr0[0], gr0[1]} * gs, o1 = g1 * (f32x2){gr0[2], gr0[3]} * gs, o2 = g2 * (f32x2){gr1[0], gr1[1]} * gs, o3 = g3 * (f32x2){gr1[2], gr1[3]} * gs;
                typedef unsigned u32x2v __attribute__((ext_vector_type(2)));
                u32x2v w; w.x = pk4_fp8(o0.x, o0.y, o1.x, o1.y); w.y = pk4_fp8(o2.x, o2.y, o3.x, o3.y);
                if (m == 0) {
                    if (fr >= 2) *(u32x2v*)(act + row * ldc + f0) = w;
                    else { float* pu = pend_up + (size_t)(rb * 2 + fr) * ldc + f0; float* pg = pend_gate + (size_t)(rb * 2 + fr) * ldc + f0;
                        *(f32x4*)pu = acc[ai][0][m][0] * ascale; *(f32x4*)(pu + 4) = acc[ai][0][m][1] * ascale; *(f32x4*)pg = gr0 * ascale; *(f32x4*)(pg + 4) = gr1 * ascale; }
                } else {
                    *(u32x2v*)(act + row * ldc + f0) = w;
                    if (m == 3 && fr >= 14) { float* ph = halo_up + (size_t)(rb * 2 + (fr - 14)) * ldc + f0; *(f32x4*)ph = acc[ai][0][m][0] * ascale; *(f32x4*)(ph + 4) = acc[ai][0][m][1] * ascale; }
                }
            }
        }
    }
};
template <class Epi, class Sched, bool ALIGN_EPI = false, bool SP2 = false, bool F8 = false, bool F6 = false>
__device__ __forceinline__ void gemm_phase(PG8_LAS unsigned char* lds, const Gemm g, const Sched& S, const Epi& E) {
    const int tid = threadIdx.x, wid = __builtin_amdgcn_readfirstlane(tid >> 6), lane = tid & 63, wr = wid >> 2, wc = wid & 3, fr = lane & 15, fq = lane >> 4;
    const int K = g.K, nt = K / BK;
    unsigned voffA[2], voffB[2];
#pragma unroll
    for (int i = 0; i < 2; ++i) { int R, C; stage_rc(tid * 16 + i * 8192, R, C); const int Rb = Epi::PERM ? ((R & ~31) + perm32(R & 31)) : R;
        voffA[i] = (unsigned)(R * K + C) * 2u; voffB[i] = (unsigned)(Rb * K + C) * 2u; }
    const size_t kstep = (size_t)(BK * 2);
    const size_t hstep = (size_t)HALF * K * 2;
    const size_t tstep = 2 * hstep;
    const unsigned ldsw = (unsigned)wid * 1024u;
    const int aoff = lds_byte(wr * 64 + fr, fq * 8), boff = lds_byte(wc * 32 + fr, fq * 8);
#define PG8_SA(b, h) (((b) * 2 + (h)) * HTB)
#define PG8_SB(b, h) ((4 + (b) * 2 + (h)) * HTB)
#define PG8_STAGE(bufoff, gbase, voff) do { _Pragma("unroll") for (int _i = 0; _i < 2; ++_i) \
        __builtin_amdgcn_global_load_lds((const unsigned*)((const char*)(gbase) + (voff)[_i]), (PG8_LAS unsigned*)(lds + (bufoff) + ldsw + _i * 8192), 16, 0, 0); } while (0)
#define PG8_LDA(dst, b, h) do { _Pragma("unroll") for (int m = 0; m < 4; ++m) _Pragma("unroll") for (int k = 0; k < 2; ++k) dst[m][k] = *(const PG8_LAS bf16x8*)(lds + PG8_SA(b, h) + aoff + m * 2048 + k * 1024); } while (0)
#define PG8_LDB(dst, b, h) do { _Pragma("unroll") for (int n = 0; n < 2; ++n) _Pragma("unroll") for (int k = 0; k < 2; ++k) dst[n][k] = *(const PG8_LAS bf16x8*)(lds + PG8_SB(b, h) + boff + n * 2048 + k * 1024); } while (0)
#define PG8_CAT(lo, hi) __builtin_bit_cast(v8i32, __builtin_shufflevector(lo, hi, 0, 1, 2, 3, 4, 5, 6, 7, 8, 9, 10, 11, 12, 13, 14, 15))
#define PG8_MMA(ai, bj, At, Bt) do { __builtin_amdgcn_s_setprio(1); _Pragma("unroll") for (int m = 0; m < 4; ++m) _Pragma("unroll") for (int n = 0; n < 2; ++n) { \
        if constexpr (F8 && F6) { const v8i32 cb_ = PG8_CAT(Bt[n][0], Bt[n][1]), ca_ = PG8_CAT(At[m][0], At[m][1]); \
            asm volatile("s_nop 3\n\tv_mfma_scale_f32_16x16x128_f8f6f4 %0, %1, %2, %0, %3, %4 op_sel_hi:[0,0,0] cbsz:2 blgp:2" : "+v"(acc[ai][bj][m][n]) \
                         : "v"(__builtin_shufflevector(cb_, cb_, 0, 1, 2, 3, 4, 5)), "v"(__builtin_shufflevector(ca_, ca_, 0, 1, 2, 3, 4, 5)), "v"(cb_[6]), "v"(ca_[6])); } \
        else if constexpr (F8) asm volatile("v_mfma_scale_f32_16x16x128_f8f6f4 %0, %1, %2, %0, %3, %3 op_sel_hi:[0,0,0]" : "+v"(acc[ai][bj][m][n]) : "v"(PG8_CAT(Bt[n][0], Bt[n][1])), "v"(PG8_CAT(At[m][0], At[m][1])), "v"(f8scale)); \
        else { _Pragma("unroll") for (int k = 0; k < 2; ++k) acc[ai][bj][m][n] = __builtin_amdgcn_mfma_f32_16x16x32_bf16(Bt[n][k], At[m][k], acc[ai][bj][m][n], 0, 0, 0); } } __builtin_amdgcn_s_setprio(0); } while (0)
#define PG8_WAIT_V(n) asm volatile("s_waitcnt vmcnt(" #n ")" ::: "memory")
#define PG8_WAIT_L(n) asm volatile("s_waitcnt lgkmcnt(" #n ")" ::: "memory")
#define PG8_BAR __builtin_amdgcn_s_barrier()
#define PG8_SCHED __builtin_amdgcn_sched_barrier(0)
    Unit cur, nxt; int ui = 0;
    if (!S.next(0, cur)) return;
    const int f8scale = 0x7F7F7F7F;
    f32x4 acc[2][2][4][2];
#pragma unroll
    for (int a = 0; a < 2; ++a)
#pragma unroll
        for (int b = 0; b < 2; ++b)
#pragma unroll
            for (int m = 0; m < 4; ++m)
#pragma unroll
                for (int n = 0; n < 2; ++n) acc[a][b][m][n] = (f32x4){0.f, 0.f, 0.f, 0.f};
    bf16x8 At[4][2], B0[2][2], B1[2][2];
    const char* cA = (const char*)g.A + (size_t)cur.pm * tstep; const char* cB = (const char*)g.Bt + (size_t)cur.pn * tstep;
    S.a_ready(cur);
    if constexpr (SP2) {
        PG8_STAGE(PG8_SB(0, 0), cB, voffB); PG8_STAGE(PG8_SB(0, 1), cB + hstep, voffB); PG8_STAGE(PG8_SA(0, 0), cA, voffA); PG8_STAGE(PG8_SA(0, 1), cA + hstep, voffA);
        if (wr == 1) PG8_BAR;
        PG8_WAIT_V(2); PG8_BAR;
        PG8_STAGE(PG8_SB(1, 0), cB + kstep, voffB); PG8_STAGE(PG8_SA(1, 0), cA + kstep, voffA); PG8_STAGE(PG8_SB(1, 1), cB + hstep + kstep, voffB);
        PG8_WAIT_V(6); PG8_BAR;
    } else {
        PG8_STAGE(PG8_SB(0, 0), cB, voffB); PG8_STAGE(PG8_SA(0, 0), cA, voffA); PG8_STAGE(PG8_SB(0, 1), cB + hstep, voffB); PG8_STAGE(PG8_SA(0, 1), cA + hstep, voffA);
        if (wr == 1) PG8_BAR;
        PG8_WAIT_V(4); PG8_BAR;
        PG8_STAGE(PG8_SB(1, 0), cB + kstep, voffB); PG8_STAGE(PG8_SA(1, 0), cA + kstep, voffA); PG8_STAGE(PG8_SB(1, 1), cB + hstep + kstep, voffB);
        PG8_WAIT_V(6); PG8_BAR;
    }
    for (;;) {
        const bool has_next = S.next(ui + 1, nxt);
        unsigned pullv = 0u;
        if constexpr (Sched::DYNAMIC) { if (wid == 0 && lane == 0) S.pull(pullv); }
        const char* nA = has_next ? (const char*)g.A + (size_t)nxt.pm * tstep : cA; const char* nB = has_next ? (const char*)g.Bt + (size_t)nxt.pn * tstep : cB;
        for (int t = 0; t < nt; t += 2) {
            const bool last = (t == nt - 2);
            const char* a1 = cA + (size_t)(t + 1) * kstep;
            const char* a2 = last ? nA : cA + (size_t)(t + 2) * kstep; const char* b2 = last ? nB : cB + (size_t)(t + 2) * kstep;
            const char* a3 = a2 + kstep; const char* b3 = b2 + kstep;
            if (last && has_next) S.a_ready(nxt);
            if constexpr (SP2) {
            PG8_LDB(B0, 0, 0); PG8_LDB(B1, 0, 1); PG8_SCHED; PG8_LDA(At, 0, 0); PG8_STAGE(PG8_SA(1, 1), a1 + hstep, voffA);
            PG8_WAIT_V(8); PG8_WAIT_L(0); PG8_BAR; PG8_MMA(0, 0, At, B0); PG8_MMA(0, 1, At, B1); PG8_BAR; PG8_SCHED;
            PG8_LDA(At, 0, 1); PG8_STAGE(PG8_SB(0, 0), b2, voffB); PG8_STAGE(PG8_SB(0, 1), b2 + hstep, voffB); PG8_STAGE(PG8_SA(0, 0), a2, voffA);
            PG8_WAIT_V(8); PG8_WAIT_L(0); PG8_BAR; PG8_MMA(1, 0, At, B0); PG8_MMA(1, 1, At, B1); PG8_BAR; PG8_SCHED;
            PG8_LDB(B0, 1, 0); PG8_LDB(B1, 1, 1); PG8_SCHED; PG8_LDA(At, 1, 0); PG8_STAGE(PG8_SA(0, 1), a2 + hstep, voffA);
            PG8_WAIT_V(8); PG8_WAIT_L(0); PG8_BAR; PG8_MMA(0, 0, At, B0); PG8_MMA(0, 1, At, B1); PG8_BAR; PG8_SCHED;
            PG8_LDA(At, 1, 1); PG8_STAGE(PG8_SB(1, 0), b3, voffB); PG8_STAGE(PG8_SB(1, 1), b3 + hstep, voffB); PG8_STAGE(PG8_SA(1, 0), a3, voffA);
            PG8_WAIT_V(8); PG8_WAIT_L(0); PG8_BAR; PG8_MMA(1, 0, At, B0); PG8_MMA(1, 1, At, B1); PG8_BAR; PG8_SCHED;
            } else {
            PG8_LDB(B0, 0, 0); PG8_SCHED; PG8_LDA(At, 0, 0); PG8_STAGE(PG8_SA(1, 1), a1 + hstep, voffA);
            PG8_WAIT_L(8); PG8_BAR; PG8_WAIT_L(0); PG8_MMA(0, 0, At, B0); PG8_BAR; PG8_SCHED;
            PG8_LDB(B1, 0, 1); PG8_STAGE(PG8_SB(0, 0), b2, voffB);
            PG8_BAR; PG8_WAIT_L(0); PG8_MMA(0, 1, At, B1); PG8_BAR;
            PG8_LDA(At, 0, 1); PG8_STAGE(PG8_SA(0, 0), a2, voffA);
            PG8_BAR; PG8_WAIT_L(0); PG8_MMA(1, 0, At, B0); PG8_BAR; PG8_SCHED;
            PG8_STAGE(PG8_SB(0, 1), b2 + hstep, voffB);
            PG8_WAIT_V(6); PG8_BAR; PG8_MMA(1, 1, At, B1); PG8_BAR;
            PG8_LDB(B0, 1, 0); PG8_SCHED; PG8_LDA(At, 1, 0); PG8_STAGE(PG8_SA(0, 1), a2 + hstep, voffA);
            PG8_WAIT_L(8); PG8_BAR; PG8_WAIT_L(0); PG8_MMA(0, 0, At, B0); PG8_BAR; PG8_SCHED;
            PG8_LDB(B1, 1, 1); PG8_STAGE(PG8_SB(1, 0), b3, voffB);
            PG8_BAR; PG8_WAIT_L(0); PG8_MMA(0, 1, At, B1); PG8_BAR;
            PG8_LDA(At, 1, 1); PG8_STAGE(PG8_SA(1, 0), a3, voffA);
            PG8_BAR; PG8_WAIT_L(0); PG8_MMA(1, 0, At, B0); PG8_BAR; PG8_SCHED;
            PG8_STAGE(PG8_SB(1, 1), b3 + hstep, voffB);
            PG8_WAIT_V(6); PG8_BAR; PG8_MMA(1, 1, At, B1); PG8_BAR;
            }
        }
        if constexpr (Sched::DYNAMIC) { if (wid == 0 && lane == 0) S.publish(ui + 2, pullv); PG8_WAIT_L(0); }
        if constexpr (ALIGN_EPI) { if (wr == 0) PG8_BAR; }
        if constexpr (F8) asm volatile("s_nop 15\n\ts_nop 15" ::: "memory");
        if constexpr (!Epi::AFTER_DRAIN) { E(acc, cur, wr, wc, fr, fq); S.done(cur); }
        if (!has_next) break;
#pragma unroll
        for (int a = 0; a < 2; ++a)
#pragma unroll
            for (int b = 0; b < 2; ++b)
#pragma unroll
                for (int m = 0; m < 4; ++m)
#pragma unroll
                    for (int n = 0; n < 2; ++n) acc[a][b][m][n] = (f32x4){0.f, 0.f, 0.f, 0.f};
        cur = nxt; cA = nA; cB = nB; ++ui;
        if constexpr (ALIGN_EPI) { if (wr == 1) PG8_BAR; }
    }
    PG8_WAIT_V(0);
    if constexpr (!ALIGN_EPI) { if (wr == 0) PG8_BAR; }
    PG8_BAR;
    if constexpr (Epi::AFTER_DRAIN) { E.fused(acc, cur, wr, wc, fr, fq, lds, wid, lane); S.done(cur); }
#undef PG8_SA
#undef PG8_SB
#undef PG8_STAGE
#undef PG8_LDA
#undef PG8_LDB
#undef PG8_MMA
#undef PG8_CAT
#undef PG8_WAIT_V
#undef PG8_WAIT_L
#undef PG8_BAR
#undef PG8_SCHED
}
}

constexpr int NWAVES = 8;
constexpr int NB = 8, SEQ = 2048, DM = 2048, M = NB * SEQ;
constexpr int N_IN = 3664, NPROJ = 3840, NP8 = 2560;
constexpr int U_OFF = 0, Q_OFF = 1024, K_OFF = 2048, V_OFF = 2304, QI_OFF = 2560, KI_OFF = 3584, WI_OFF = 3648;
constexpr int SSMW = 1024, NG = 64, GCH = 16, NST = 64;
constexpr int NH = 8, HD = 128, NKV = 2, NIH = 16, IDIM = 64, TOPK = 256;
constexpr int DFF = 5632, NUG = 2 * DFF;
constexpr float LN_EPS = 1e-5f;
constexpr float DN_ALPHA = 1.189207115002721f;
constexpr float IDX_W_SCALE = 0.03125f;
constexpr float ATT_SCALE = 0.08838834764831845f;
constexpr float SC_H1 = 32.f, SC_WUG = 2048.f, SC_ACT = 8.f, SC_WDN = 4096.f, SC_MIX = 8.f, SC_WOUT = 4096.f, SC_X = 32.f, SC_WIN = 2048.f;

constexpr size_t MiB = 1u << 20;
constexpr size_t WS_CTL = 0, CTL_ZERO_BYTES = 65536;
constexpr size_t WS_WIN = 2 * MiB, WS_WGLU = 17 * MiB, WS_WOUT = 19 * MiB, WS_WUG = 27 * MiB, WS_WDOWN = 71 * MiB;
constexpr size_t WS_TABA = 93 * MiB, WS_TABB = 93 * MiB + 65536;
constexpr size_t WS_TABINV = 94 * MiB, WS_TABW = 95 * MiB, WS_CA = 96 * MiB, WS_BCAT = 96 * MiB + 524288, WS_TABA32 = 96 * MiB + 786432;
constexpr size_t WS_KIPACK = 97 * MiB;
constexpr size_t WS_MASK = 100 * MiB;
constexpr size_t WS_XB = 104 * MiB;
constexpr size_t WS_MIX = 168 * MiB;
constexpr size_t WS_PROJ = 232 * MiB;
constexpr size_t WS_YG = 352 * MiB;
constexpr size_t WS_ACT = 232 * MiB;
constexpr size_t WS_PEND_UP = 408 * MiB, WS_PEND_G = 420 * MiB, WS_HALO = 432 * MiB, WS_WIN8 = 444 * MiB, WS_RSTAT = 450 * MiB, WS_END = 451 * MiB;
static_assert(WS_WIN + (size_t)NPROJ * DM * 2 <= WS_WGLU && WS_WUG + (size_t)NUG * DM * 2 <= WS_WDOWN && WS_WDOWN + (size_t)DM * DFF * 2 <= WS_TABA, "ws map");
static_assert(WS_PROJ + (size_t)M * NPROJ * 2 <= WS_YG && WS_YG + (size_t)M * SSMW * 2 <= WS_PEND_UP && WS_ACT + (size_t)M * DFF * 2 <= WS_PEND_UP && (size_t)512 * DFF * 4 <= 12 * MiB && WS_WIN8 + (size_t)NP8 * DM <= WS_RSTAT && WS_RSTAT + (size_t)M * 8 <= WS_END, "ws map 2");
constexpr int CW_BAR = 4096;
constexpr int CW_DYN7 = 12288;
constexpr int CW_XCHK = 8192;

constexpr int RING_OFF = 0, RING_BYTES = 131072;
constexpr int LDS_BYTES = 163840;
constexpr int LDSCTL_OFF = LDS_BYTES - 1024, MISC_OFF = LDSCTL_OFF + 320;

#define GAS __attribute__((address_space(1)))
#define LAS __attribute__((address_space(3)))
typedef unsigned short bf16;
typedef unsigned v4u __attribute__((ext_vector_type(4)));
typedef unsigned v2u __attribute__((ext_vector_type(2)));
typedef float f32x4 __attribute__((ext_vector_type(4)));
typedef float fl4 __attribute__((ext_vector_type(4)));
#define LDS_WAIT() asm volatile("s_waitcnt lgkmcnt(0)" ::: "memory")
#define VM_WAIT() asm volatile("s_waitcnt vmcnt(0)" ::: "memory")
__device__ __forceinline__ unsigned f2bf(float f) { unsigned u = __builtin_bit_cast(unsigned, f); return (u + 0x7fffu + ((u >> 16) & 1u)) >> 16; }
__device__ __forceinline__ unsigned pk2(float lo, float hi) { return f2bf(lo) | (f2bf(hi) << 16); }
__device__ __forceinline__ float bflo(unsigned w) { return __uint_as_float(w << 16); }
__device__ __forceinline__ float bfhi(unsigned w) { return __uint_as_float(w & 0xffff0000u); }
__device__ __forceinline__ float bf2f(bf16 b) { return __uint_as_float(((unsigned)b) << 16); }
__device__ __forceinline__ unsigned pk4_fp8(float a, float b, float c, float d) {
    int w = 0; w = __builtin_amdgcn_cvt_pk_fp8_f32(__builtin_amdgcn_fmed3f(a, -448.f, 448.f), __builtin_amdgcn_fmed3f(b, -448.f, 448.f), w, false);
    w = __builtin_amdgcn_cvt_pk_fp8_f32(__builtin_amdgcn_fmed3f(c, -448.f, 448.f), __builtin_amdgcn_fmed3f(d, -448.f, 448.f), w, true); return (unsigned)w; }
#define XB_TMO      128
#define XB_XCNT(j)  (256  + 64 * (j))
#define XB_XSUB(j)  (1280 + 64 * (j))
#define XB_XGEN(j)  (2304 + 64 * (j))
#define XB_TOP      3328
#define XB_TOPGEN   3392
#define XCD_BAR_WORDS 3456
#define XB_SPIN_CAP (1u << 18)

__device__ __forceinline__ unsigned xb_ld(unsigned* p)              { return __hip_atomic_load(p, __ATOMIC_RELAXED, __HIP_MEMORY_SCOPE_AGENT); }
__device__ __forceinline__ unsigned xb_add(unsigned* p, unsigned v) { return __hip_atomic_fetch_add(p, v, __ATOMIC_RELAXED, __HIP_MEMORY_SCOPE_AGENT); }
__device__ __forceinline__ unsigned xb_xcc_id() { return (unsigned)__builtin_amdgcn_s_getreg((3 << 11) | 20) & 0xFu; }
#define XB_SPIN(cond, bar) do { unsigned _sp = 0; while (cond) { __builtin_amdgcn_s_sleep(1); \
    if ((++_sp & 255u) == 0u) { if (xb_ld(&(bar)[XB_TMO])) break; if (_sp > XB_SPIN_CAP) { atomicAdd(&(bar)[XB_TMO], 1u); break; } } } } while (0)

struct XcdBarrier {
    unsigned* bar; unsigned x;
    volatile LAS unsigned* st;
};

__device__ __forceinline__ XcdBarrier xcd_barrier_post(unsigned* bar, volatile LAS unsigned* st) {
    XcdBarrier b; b.bar = bar; b.x = xb_xcc_id(); b.st = st;
    if (threadIdx.x == 0) (void)xb_add(&bar[XB_XCNT(b.x)], 1u);
    return b;
}
__device__ __forceinline__ void xcd_barrier_complete(unsigned* bar, unsigned x, unsigned& nloc, unsigned& nx) {
    const unsigned G = gridDim.x * gridDim.y * gridDim.z;
    unsigned sum, cnt, mine, sp = 0u;
    for (;;) {
        sum = 0u; cnt = 0u; mine = 0u;
#pragma unroll
        for (unsigned j = 0; j < 16; ++j) { const unsigned c = xb_ld(&bar[XB_XCNT(j)]); sum += c; cnt += (c > 0u) ? 1u : 0u; mine = (j == x) ? c : mine; }
        if (sum == G) break;
        __builtin_amdgcn_s_sleep(1);
        if ((++sp & 255u) == 0u) { if (xb_ld(&bar[XB_TMO])) break; if (sp > XB_SPIN_CAP) { atomicAdd(&bar[XB_TMO], 1u); break; } }
    }
    nloc = mine > 0u ? mine : 1u; nx = cnt > 0u ? cnt : 1u;
}

__device__ __forceinline__ void xcd_barrier(const XcdBarrier& b, const bool local = false) {
    asm volatile("s_waitcnt vmcnt(0)" ::: "memory");
    __syncthreads();
    if (threadIdx.x == 0) {
        unsigned* bar = b.bar;
        __builtin_amdgcn_s_waitcnt(0);
        unsigned nloc = b.st[0], nx = b.st[1];
        if (nloc == 0u) { xcd_barrier_complete(bar, b.x, nloc, nx); b.st[0] = nloc; b.st[1] = nx; }
        const unsigned tgc = b.st[2]; if (!local) b.st[2] = tgc + 1u;
        const unsigned old = xb_add(&bar[XB_XSUB(b.x)], 1u);
        const unsigned gen = old / nloc;
        if (old + 1u == (gen + 1u) * nloc && local) {
            __builtin_amdgcn_fence(__ATOMIC_ACQUIRE, "agent");
            xb_add(&bar[XB_XGEN(b.x)], 1u);
            asm volatile("s_waitcnt vmcnt(0)" ::: "memory");
        } else if (old + 1u == (gen + 1u) * nloc) {
            __builtin_amdgcn_fence(__ATOMIC_RELEASE, "agent");
            asm volatile("s_waitcnt vmcnt(0)" ::: "memory");
            const unsigned og = xb_add(&bar[XB_TOP], 1u);
            const unsigned tg = og / nx;
            if (og + 1u == (tg + 1u) * nx) xb_add(&bar[XB_TOPGEN], 1u);
            else XB_SPIN(xb_ld(&bar[XB_TOPGEN]) == tg, bar);
            __builtin_amdgcn_fence(__ATOMIC_ACQUIRE, "agent");
            xb_add(&bar[XB_XGEN(b.x)], 1u);
            asm volatile("s_waitcnt vmcnt(0)" ::: "memory");
        } else {
            if (local) XB_SPIN(xb_ld(&bar[XB_XGEN(b.x)]) <= gen, bar); else XB_SPIN(xb_ld(&bar[XB_TOPGEN]) <= tgc, bar);
            __builtin_amdgcn_fence(__ATOMIC_ACQUIRE, "agent");
            asm volatile("s_waitcnt vmcnt(0)" ::: "memory");
        }
    }
    __syncthreads();
}

struct Frame {
    LAS unsigned char* lds;
    volatile LAS unsigned* MISC;
    unsigned* ctl;
    int tid, lane, wave, vcu, G;
    const float* in[22]; float* out; unsigned char* ws;
};
enum { I_X = 0, I_WIN, I_ARE, I_AIM, I_LOGDT, I_BRE, I_BIM, I_CRE, I_CIM, I_D, I_WGLU, I_BGLU, I_WOUT, I_LN1G, I_LN1B, I_WUP, I_WGATE, I_CONVW, I_CONVB, I_WDOWN, I_LN2G, I_LN2B };

__device__ __forceinline__ float wave_sum(float v) {
#pragma unroll
    for (int o = 1; o < 64; o <<= 1) v += __shfl_xor(v, o);
    return v;
}

typedef float v16f32 __attribute__((ext_vector_type(16)));
typedef unsigned v6u32 __attribute__((ext_vector_type(6)));
__device__ __forceinline__ void mx6_store_block(unsigned char* row, int b, v16f32 x, v16f32 y, float amax) {
    unsigned E = __float_as_uint(amax) >> 23; E = E < 3u ? 3u : E;
    const unsigned sb = E - 2u; const float inv = __uint_as_float((254u - sb) << 23);
    const v6u32 r = __builtin_amdgcn_cvt_scalef32_2xpk16_fp6_f32(x * inv, y * inv, 1.0f);
    unsigned char* p = row + (b >> 2) * 128 + (b & 3) * 16;
    *(v4u*)p = (v4u){r[0], r[1], r[2], r[3]}; *(v4u*)(p + 64) = (v4u){r[4], r[5], sb, 0u};
}
#define MX6_AMAX(x, y, am) do { am = 0.f; _Pragma("unroll") for (int i_ = 0; i_ < 16; ++i_) am = __builtin_fmaxf(__builtin_fmaxf(__builtin_fabsf(x[i_]), __builtin_fabsf(y[i_])), am); } while (0)
template <int MODE>
__device__ __forceinline__ void p2_mx6_item(const float* W, int K, int N, void* WT, int item, int lane) {
    const int nblk = N / 256, kb = item / nblk, nb = item % nblk, k0 = 32 * kb;
#pragma unroll 1
    for (int sub = 0; sub < 4; ++sub) { const int nn = nb * 256 + sub * 64 + lane; const float* wp = W + (size_t)k0 * N + nn;
        v16f32 x, y;
#pragma unroll
        for (int i = 0; i < 16; ++i) { x[i] = __builtin_nontemporal_load(&wp[(size_t)i * N]); y[i] = __builtin_nontemporal_load(&wp[(size_t)(16 + i) * N]); }
        float am; MX6_AMAX(x, y, am);
        const int R = MODE == 0 ? nn : (256 * (nn >> 7) + (nn & 127) + (MODE == 2 ? 128 : 0));
        mx6_store_block((unsigned char*)WT + (size_t)R * K, kb, x, y, am); }
}
template <int MODE, bool F8OUT>
__device__ __forceinline__ void p0_tr_item(const float* W, int K, int N, int noff, int nend, void* WT, int item, int lane, float sc) {
    const int nblk = (nend - noff) / 256, kb = item / nblk, nb = item % nblk, k0 = 32 * kb, n = noff + nb * 256 + lane * 4;
    constexpr int KS = F8OUT ? 16 : 8;
    const bool inb = n < N;
#pragma unroll
    for (int kk = 0; kk < 32; kk += KS) {
        f32x4 v[KS];
#pragma unroll
        for (int i = 0; i < KS; ++i) v[i] = inb ? __builtin_nontemporal_load((const f32x4*)(W + (size_t)(k0 + kk + i) * N + n)) : (f32x4){0.f, 0.f, 0.f, 0.f};
#pragma unroll
        for (int c = 0; c < 4; ++c) { const int nn = n + c; const int R = MODE == 0 ? nn : (256 * (nn >> 7) + (nn & 127) + (MODE == 2 ? 128 : 0));
            v4u o;
            if constexpr (F8OUT) { o.x = pk4_fp8(v[0][c] * sc, v[1][c] * sc, v[2][c] * sc, v[3][c] * sc); o.y = pk4_fp8(v[4][c] * sc, v[5][c] * sc, v[6][c] * sc, v[7][c] * sc);
                o.z = pk4_fp8(v[8][c] * sc, v[9][c] * sc, v[10][c] * sc, v[11][c] * sc); o.w = pk4_fp8(v[12][c] * sc, v[13][c] * sc, v[14][c] * sc, v[15][c] * sc);
                *(v4u*)((unsigned char*)WT + (size_t)R * K + k0 + kk) = o; }
            else { o.x = pk2(v[0][c], v[1][c]); o.y = pk2(v[2][c], v[3][c]); o.z = pk2(v[4][c], v[5][c]); o.w = pk2(v[6][c], v[7][c]);
                *(v4u*)((bf16*)WT + (size_t)R * K + k0 + kk) = o; } }
    }
}
__device__ __forceinline__ void p0_prologue(Frame& F) {
    LAS float* scr = (LAS float*)(F.lds + RING_OFF + F.wave * 16384);
    const int gw = F.vcu * NWAVES + F.wave, NGW = F.G * NWAVES;
    bf16* win_t = (bf16*)(F.ws + WS_WIN); bf16* wglu_t = (bf16*)(F.ws + WS_WGLU); bf16* wout_t = (bf16*)(F.ws + WS_WOUT); bf16* wug_t = (bf16*)(F.ws + WS_WUG); bf16* wdown_t = (bf16*)(F.ws + WS_WDOWN);
    constexpr int I_IN8 = (DM / 32) * (NP8 / 256), I_IN = (DM / 32) * ((NPROJ - NP8) / 256);
    if (F.wave < 7)
    for (int it = F.vcu * 7 + F.wave; it < I_IN8 + I_IN; it += F.G * 7) {
        int r = it;
        if (r < I_IN8) { p0_tr_item<0, true>(F.in[I_WIN], DM, N_IN, 0, NP8, F.ws + WS_WIN8, r, F.lane, SC_WIN); continue; } r -= I_IN8;
        p0_tr_item<0, false>(F.in[I_WIN], DM, N_IN, NP8, NPROJ, win_t, r, F.lane, 1.f);
    }
    if (F.wave == 7) {
    for (int gi = F.vcu + F.G * F.lane; gi < NG * NST; gi += F.G * 64) { const int g = gi >> 6;
        const double dt = exp((double)F.in[I_LOGDT][g]); const double are = (double)F.in[I_ARE][gi], aim = (double)F.in[I_AIM][gi];
        const double mag = exp(dt * are), ang = dt * aim; const double abr = mag * cos(ang), abi = mag * sin(ang);
        const double nr = abr - 1.0, ni = abi, den = are * are + aim * aim;
        const double fre = (nr * are + ni * aim) / den, fim = (ni * are - nr * aim) / den;
        float2* ta = (float2*)(F.ws + WS_TABA); float2* tb = (float2*)(F.ws + WS_TABB);
        ta[gi] = make_float2((float)abr, (float)abi);
#pragma unroll
        for (int h = 0; h < GCH; ++h) { const double br = (double)F.in[I_BRE][gi * GCH + h], bi = (double)F.in[I_BIM][gi * GCH + h];
            const float bbr = (float)(fre * br - fim * bi), bbi = (float)(fre * bi + fim * br);
            tb[gi * GCH + h] = make_float2(bbr, bbi);
            const int p = gi & 63; bf16* bcat = (bf16*)(F.ws + WS_BCAT);
            bcat[(size_t)(g * 128 + p) * 16 + h] = (bf16)f2bf(bbr); bcat[(size_t)(g * 128 + 64 + p) * 16 + h] = (bf16)f2bf(bbi); }
        { double pr = abr, pi = abi;
#pragma unroll
          for (int k = 0; k < 5; ++k) { const double t = pr * pr - pi * pi; pi = 2.0 * pr * pi; pr = t; }
          ((float2*)(F.ws + WS_TABA32))[gi] = make_float2((float)pr, (float)pi); } }
    for (int e = F.vcu * 64 + F.lane; e < NG * 2 * 8 * 64; e += F.G * 64) {
        const int ln = e & 63, rp = (e >> 6) & 7, pt = (e >> 9) & 1, g = e >> 10, hw = ln >> 5, jl = ln & 31;
        const double dt = exp((double)F.in[I_LOGDT][g]); float vi[4], vw[4];
#pragma unroll
        for (int k = 0; k < 2; ++k) { const int r = 2 * rp + k, cr = (r & 3) + 8 * (r >> 2) + 4 * hw;
            { const int p = pt * 32 + jl; const double are = (double)F.in[I_ARE][g * 64 + p], aim = (double)F.in[I_AIM][g * 64 + p], kk = -(double)cr; const float mg = expf((float)(kk * dt * are)), an = (float)(kk * dt * aim);
              vi[k] = mg * cosf(an); vi[2 + k] = mg * sinf(an); }
            { const int p = pt * 32 + cr; const double are = (double)F.in[I_ARE][g * 64 + p], aim = (double)F.in[I_AIM][g * 64 + p], kk = (double)jl; const float mg = expf((float)(kk * dt * are)), an = (float)(kk * dt * aim);
              vw[k] = mg * cosf(an); vw[2 + k] = mg * sinf(an); } }
        ((fl4*)(F.ws + WS_TABINV))[e] = (fl4){vi[0], vi[1], vi[2], vi[3]}; ((fl4*)(F.ws + WS_TABW))[e] = (fl4){vw[0], vw[1], vw[2], vw[3]};
    }
    for (int e = F.vcu * 64 + F.lane; e < NG * 4 * 2 * 64; e += F.G * 64) {
        const int ln = e & 63, s = (e >> 6) & 1, q = (e >> 7) & 3, g = e >> 9, ch = ln & 31, hw = ln >> 5; unsigned hv[8];
#pragma unroll
        for (int ee = 0; ee < 8; ++ee) { const int p = (q & 1) * 32 + 8 * (2 * s + (ee >> 2)) + 4 * hw + (ee & 3); float v = 0.f;
            if (ch < 16) v = (q < 2) ? F.in[I_CRE][(size_t)(g * 16 + ch) * 64 + p] : -F.in[I_CIM][(size_t)(g * 16 + ch) * 64 + p];
            hv[ee] = f2bf(v); }
        v4u w; w.x = hv[0] | (hv[1] << 16); w.y = hv[2] | (hv[3] << 16); w.z = hv[4] | (hv[5] << 16); w.w = hv[6] | (hv[7] << 16);
        ((v4u*)(F.ws + WS_CA))[e] = w; }
    }
    { const f32x4* xs = (const f32x4*)F.in[I_X]; v4u* xd = (v4u*)(F.ws + WS_XB); v2u* x8 = (v2u*)(F.ws + WS_MIX + 32 * MiB); LAS unsigned* xctr = (LAS unsigned*)(F.lds + MISC_OFF + 72);
      const int nchunk = (int)((size_t)M * DM / 8 / 256), cper = (nchunk + F.G - 1) / F.G;
      for (;;) { unsigned k = 0; if (F.lane == 0) k = __hip_atomic_fetch_add(xctr, 1u, __ATOMIC_RELAXED, __HIP_MEMORY_SCOPE_WORKGROUP);
          k = __builtin_amdgcn_readfirstlane(k); if ((int)k >= cper) break; const int ch = F.vcu * cper + (int)k; if (ch >= nchunk) break;
#pragma unroll
          for (int j = 0; j < 4; ++j) { const size_t i = (size_t)ch * 256 + j * 64 + F.lane; const f32x4 a = __builtin_nontemporal_load(&xs[2 * i]), b = __builtin_nontemporal_load(&xs[2 * i + 1]);
              v4u o; o.x = pk2(a[0], a[1]); o.y = pk2(a[2], a[3]); o.z = pk2(b[0], b[1]); o.w = pk2(b[2], b[3]); xd[i] = o;
              v2u o8; o8.x = pk4_fp8(a[0] * SC_X, a[1] * SC_X, a[2] * SC_X, a[3] * SC_X); o8.y = pk4_fp8(b[0] * SC_X, b[1] * SC_X, b[2] * SC_X, b[3] * SC_X); x8[i] = o8; } } }
}

constexpr int P2W_GLU = (SSMW / 32) * (SSMW / 256), P2W_OUT = (DM / 32) * (DM / 256), P2W_UP = (DM / 32) * (DFF / 256), P2W_DOWN = (DFF / 32) * (DM / 256);
constexpr int P2W_ITEMS = P2W_GLU + P2W_OUT + 2 * P2W_UP + P2W_DOWN;
__device__ __forceinline__ void p2_weight_item(Frame& F, int it) {
    int r = it;
    if (r < P2W_GLU) { p0_tr_item<0, false>(F.in[I_WGLU], SSMW, SSMW, 0, SSMW, F.ws + WS_WGLU, r, F.lane, 1.f); return; } r -= P2W_GLU;
    if (r < P2W_OUT) { p0_tr_item<0, true>(F.in[I_WOUT], DM, DM, 0, DM, F.ws + WS_WOUT, r, F.lane, SC_WOUT); return; } r -= P2W_OUT;
    if (r < P2W_UP) { p2_mx6_item<1>(F.in[I_WUP], DM, DFF, F.ws + WS_WUG, r, F.lane); return; } r -= P2W_UP;
    if (r < P2W_UP) { p2_mx6_item<2>(F.in[I_WGATE], DM, DFF, F.ws + WS_WUG, r, F.lane); return; } r -= P2W_UP;
    p0_tr_item<0, true>(F.in[I_WDOWN], DFF, DM, 0, DM, F.ws + WS_WDOWN, r, F.lane, SC_WDN);
}

typedef short bf16x8_t __attribute__((ext_vector_type(8)));
typedef float f32x16_t __attribute__((ext_vector_type(16)));
typedef float fl2 __attribute__((ext_vector_type(2)));
constexpr int IDX_NLDS = 30;
__device__ __forceinline__ void idx_mfma_pair(Frame& F, int b, int ti, unsigned* maskout, const LAS bf16* kl) {
    const int lane = F.lane, j = lane & 31, hw = lane >> 5, t0 = 2 * ti, th = t0 + hw;
    const bf16* proj = (const bf16*)(F.ws + WS_PROJ);
    const bf16* pb = proj + (size_t)(b * SEQ) * NPROJ;
    bf16x8_t qa[4];
    { const int q = (j >> 2) & 1, head = (j >> 3) * 4 + (j & 3); const bf16* qp = pb + (size_t)(t0 + q) * NPROJ + QI_OFF + head * IDIM + 8 * hw;
#pragma unroll
      for (int s = 0; s < 4; ++s) qa[s] = *(const bf16x8_t*)(qp + 16 * s); }
    float w[16];
    { const bf16* wp = pb + (size_t)th * NPROJ + WI_OFF; const v4u a = *(const v4u*)wp, c = *(const v4u*)(wp + 8);
      w[0] = bflo(a.x); w[1] = bfhi(a.x); w[2] = bflo(a.y); w[3] = bfhi(a.y); w[4] = bflo(a.z); w[5] = bfhi(a.z); w[6] = bflo(a.w); w[7] = bfhi(a.w);
      w[8] = bflo(c.x); w[9] = bfhi(c.x); w[10] = bflo(c.y); w[11] = bfhi(c.y); w[12] = bflo(c.z); w[13] = bfhi(c.z); w[14] = bflo(c.w); w[15] = bfhi(c.w);
#pragma unroll
      for (int r = 0; r < 16; ++r) w[r] *= IDX_W_SCALE; }
    const int kbnd = t0 >> 5;
    const float pen = (j > th - 32 * kbnd) ? -__builtin_inff() : 0.f;
    const int nkt = (t0 + 1) / 32 + 1;
    const float NEG = -__builtin_inff();
    float sc[64];
    const bf16* kp = (const bf16*)(F.ws + WS_KIPACK) + (size_t)(b * 64) * 4 * 64 * 8 + (size_t)lane * 8;
    typedef float f32x2_t __attribute__((ext_vector_type(2)));
    f32x2_t w2[8];
#pragma unroll
    for (int r = 0; r < 8; ++r) w2[r] = (f32x2_t){0.5f * w[2 * r], 0.5f * w[2 * r + 1]};
    bf16x8_t kA[2][4], kB[2][4];
#pragma unroll
    for (int t2 = 0; t2 < 2; ++t2)
#pragma unroll
        for (int s = 0; s < 4; ++s) kA[t2][s] = *(const LAS bf16x8_t*)(kl + (t2 * 4 + s) * 512);
    unsigned kl2a = (unsigned)(size_t)kl + 16 * 4096; asm volatile("" : "+v"(kl2a));
    const LAS bf16* kl2 = (const LAS bf16*)(size_t)kl2a;
#pragma unroll
    for (int kp2 = 0; kp2 < 32; ++kp2) {
        if (2 * kp2 < nkt) {
            if (2 * (kp2 + 1) < nkt) {
#pragma unroll
                for (int t2 = 0; t2 < 2; ++t2)
#pragma unroll
                    for (int s = 0; s < 4; ++s) { const bf16x8_t v = (2 * kp2 + 2 < 16) ? *(const LAS bf16x8_t*)(kl + ((2 * kp2 + 2 + t2) * 4 + s) * 512) : (2 * kp2 + 2 < IDX_NLDS) ? *(const LAS bf16x8_t*)(kl2 + ((2 * kp2 + 2 - 16 + t2) * 4 + s) * 512) : *(const bf16x8_t*)(kp + (size_t)((2 * kp2 + 2 + t2) * 4 + s) * 512);
                        if (kp2 & 1) kA[t2][s] = v; else kB[t2][s] = v; } }
            f32x16_t acc0 = {}, acc1 = {};
#pragma unroll
            for (int s = 0; s < 4; ++s) { acc0 = __builtin_amdgcn_mfma_f32_32x32x16_bf16(qa[s], (kp2 & 1) ? kB[0][s] : kA[0][s], acc0, 0, 0, 0);
                acc1 = __builtin_amdgcn_mfma_f32_32x32x16_bf16(qa[s], (kp2 & 1) ? kB[1][s] : kA[1][s], acc1, 0, 0, 0); }
            f32x2_t s0 = {0.f, 0.f}, s1 = {0.f, 0.f}; float a0 = 0.f, b0 = 0.f, a1 = 0.f, b1 = 0.f;
#pragma unroll
            for (int r = 0; r < 8; ++r) { const f32x2_t x0 = {acc0[2 * r], acc0[2 * r + 1]}, x1 = {acc1[2 * r], acc1[2 * r + 1]};
                s0 = x0 * w2[r] + s0; s1 = x1 * w2[r] + s1;
                a0 = fmaf(w2[r].x, fabsf(x0.x), a0); b0 = fmaf(w2[r].y, fabsf(x0.y), b0); a1 = fmaf(w2[r].x, fabsf(x1.x), a1); b1 = fmaf(w2[r].y, fabsf(x1.y), b1); }
            float v0 = (s0.x + s0.y) + (a0 + b0), v1 = (s1.x + s1.y) + (a1 + b1);
            if (2 * kp2 == kbnd) { v0 += pen; v1 = NEG; } else if (2 * kp2 + 1 == kbnd) v1 += pen;
            sc[2 * kp2] = v0; sc[2 * kp2 + 1] = v1;
        } else { sc[2 * kp2] = NEG; sc[2 * kp2 + 1] = NEG; }
    }
    float thr = -3.0e38f, tieval = 0.f; bool tie = false; int need = 0;
    bool act = th >= TOPK;
    if (__any(act)) {
        float mn = sc[0], mx = sc[0];
#pragma unroll
        for (int kt = 1; kt < 8; ++kt) mn = __builtin_amdgcn_fmed3f(mn, sc[kt], NEG);
#pragma unroll
        for (int kt = 1; kt < 64; ++kt) mx = __builtin_amdgcn_fmed3f(mx, sc[kt], __builtin_inff());
#define IDX_DPP_F(v, ctrl) __builtin_bit_cast(float, __builtin_amdgcn_update_dpp(0, __builtin_bit_cast(int, v), ctrl, 0xf, 0xf, false))
        mn = fminf(mn, IDX_DPP_F(mn, 0x128)); mn = fminf(mn, IDX_DPP_F(mn, 0x124)); mn = fminf(mn, IDX_DPP_F(mn, 0x122)); mn = fminf(mn, IDX_DPP_F(mn, 0x121));
        mx = fmaxf(mx, IDX_DPP_F(mx, 0x128)); mx = fmaxf(mx, IDX_DPP_F(mx, 0x124)); mx = fmaxf(mx, IDX_DPP_F(mx, 0x122)); mx = fmaxf(mx, IDX_DPP_F(mx, 0x121));
#undef IDX_DPP_F
        { const float a0 = __builtin_bit_cast(float, __builtin_amdgcn_readlane(__builtin_bit_cast(int, mn), 0)), a1 = __builtin_bit_cast(float, __builtin_amdgcn_readlane(__builtin_bit_cast(int, mn), 16));
          const float a2 = __builtin_bit_cast(float, __builtin_amdgcn_readlane(__builtin_bit_cast(int, mn), 32)), a3 = __builtin_bit_cast(float, __builtin_amdgcn_readlane(__builtin_bit_cast(int, mn), 48));
          const float b0 = __builtin_bit_cast(float, __builtin_amdgcn_readlane(__builtin_bit_cast(int, mx), 0)), b1 = __builtin_bit_cast(float, __builtin_amdgcn_readlane(__builtin_bit_cast(int, mx), 16));
          const float b2 = __builtin_bit_cast(float, __builtin_amdgcn_readlane(__builtin_bit_cast(int, mx), 32)), b3 = __builtin_bit_cast(float, __builtin_amdgcn_readlane(__builtin_bit_cast(int, mx), 48));
          mn = hw ? fminf(a2, a3) : fminf(a0, a1); mx = hw ? fmaxf(b2, b3) : fmaxf(b0, b1); }
        float lo = mn, hi = mx + fabsf(mx) * 1e-6f + 1e-30f;
        int chi = 0;
        float glo = (float)(th + 1) - ((float)TOPK - 0.5f), ghi = -((float)TOPK - 0.5f); int side = 0;
        const int ngrp = (nkt + 7) >> 3;
        for (int it = 0; it < 200; ++it) {
            if (!__any(act)) break;
            float mid = hi - ghi * (hi - lo) * __builtin_amdgcn_rcpf(ghi - glo);
            if (!(mid > lo && mid < hi)) mid = 0.5f * (lo + hi);
            const bool conv = !(mid > lo && mid < hi);
            unsigned ba = 0u, bb = 0u;
#pragma unroll
            for (int g8 = 0; g8 < 4; ++g8) if (g8 < ngrp) {
#pragma unroll
                for (int kt = 8 * g8; kt < 8 * g8 + 8; ++kt) ba = __builtin_amdgcn_alignbit(ba, __builtin_bit_cast(unsigned, sc[kt] - mid), 31); }
#pragma unroll
            for (int g8 = 4; g8 < 8; ++g8) if (g8 < ngrp) {
#pragma unroll
                for (int kt = 8 * g8; kt < 8 * g8 + 8; ++kt) bb = __builtin_amdgcn_alignbit(bb, __builtin_bit_cast(unsigned, sc[kt] - mid), 31); }
            int cl = 8 * ngrp - (__builtin_popcount(ba) + __builtin_popcount(bb));
            cl += __builtin_amdgcn_update_dpp(0, cl, 0x128, 0xf, 0xf, false);
            cl += __builtin_amdgcn_update_dpp(0, cl, 0x124, 0xf, 0xf, false);
            cl += __builtin_amdgcn_update_dpp(0, cl, 0x122, 0xf, 0xf, false);
            cl += __builtin_amdgcn_update_dpp(0, cl, 0x121, 0xf, 0xf, false);
            const int c0 = __builtin_amdgcn_readlane(cl, 0) + __builtin_amdgcn_readlane(cl, 16), c1 = __builtin_amdgcn_readlane(cl, 32) + __builtin_amdgcn_readlane(cl, 48);
            const int c = hw ? c1 : c0;
            if (act) {
                if (conv) { act = false; tie = true; tieval = lo; thr = hi; need = TOPK - chi; }
                else if (c == TOPK) { act = false; thr = mid; }
                else if (c > TOPK) { lo = mid; glo = (float)c - ((float)TOPK - 0.5f); if (side == 1) ghi *= 0.5f; side = 1; }
                else { hi = mid; chi = c; ghi = (float)c - ((float)TOPK - 0.5f); if (side == -1) glo *= 0.5f; side = -1; }
            }
        }
        if (act) { thr = hi; }
    }
    unsigned w0v = 0u, w1v = 0u;
    const bool anytie = __any(tie);
    int need0 = __builtin_amdgcn_readlane(need, 0), need1 = __builtin_amdgcn_readlane(need, 32);
    if (!anytie) {
#define IDX_WL(KT) if ((KT) < nkt) { const unsigned long long bal_ = __ballot(sc[KT] >= thr); const unsigned x0_ = (unsigned)bal_, x1_ = (unsigned)(bal_ >> 32); \
        asm volatile("s_nop 1\n\tv_writelane_b32 %0, %2, " #KT "\n\tv_writelane_b32 %1, %3, " #KT : "+v"(w0v), "+v"(w1v) : "s"(x0_), "s"(x1_)); }
        IDX_WL(0) IDX_WL(1) IDX_WL(2) IDX_WL(3) IDX_WL(4) IDX_WL(5) IDX_WL(6) IDX_WL(7) IDX_WL(8) IDX_WL(9) IDX_WL(10) IDX_WL(11) IDX_WL(12) IDX_WL(13) IDX_WL(14) IDX_WL(15) IDX_WL(16) IDX_WL(17) IDX_WL(18) IDX_WL(19) IDX_WL(20) IDX_WL(21) IDX_WL(22) IDX_WL(23) IDX_WL(24) IDX_WL(25) IDX_WL(26) IDX_WL(27) IDX_WL(28) IDX_WL(29) IDX_WL(30) IDX_WL(31) IDX_WL(32) IDX_WL(33) IDX_WL(34) IDX_WL(35) IDX_WL(36) IDX_WL(37) IDX_WL(38) IDX_WL(39) IDX_WL(40) IDX_WL(41) IDX_WL(42) IDX_WL(43) IDX_WL(44) IDX_WL(45) IDX_WL(46) IDX_WL(47) IDX_WL(48) IDX_WL(49) IDX_WL(50) IDX_WL(51) IDX_WL(52) IDX_WL(53) IDX_WL(54) IDX_WL(55) IDX_WL(56) IDX_WL(57) IDX_WL(58) IDX_WL(59) IDX_WL(60) IDX_WL(61) IDX_WL(62) IDX_WL(63)
#undef IDX_WL
    } else
#pragma unroll
    for (int kt = 0; kt < 64; ++kt) if (kt < nkt) {
        const unsigned long long bal = __ballot(sc[kt] >= thr);
        unsigned x0 = (unsigned)bal, x1 = (unsigned)(bal >> 32);
        if (anytie) {
            const unsigned long long be = __ballot(tie && sc[kt] == tieval);
            unsigned e0 = (unsigned)be, e1 = (unsigned)(be >> 32);
            while (__builtin_popcount(e0) > need0) e0 &= ~(0x80000000u >> __builtin_clz(e0));
            while (__builtin_popcount(e1) > need1) e1 &= ~(0x80000000u >> __builtin_clz(e1));
            need0 -= __builtin_popcount(e0); need1 -= __builtin_popcount(e1);
            x0 |= e0; x1 |= e1;
        }
        w0v = (lane == kt) ? x0 : w0v; w1v = (lane == kt) ? x1 : w1v;
    }
    maskout[(size_t)(b * SEQ + t0) * 64 + lane] = w0v;
    maskout[(size_t)(b * SEQ + t0 + 1) * 64 + lane] = w1v;
}


__device__ __forceinline__ bf16x8_t ssm_pack8(const f32x16_t& v, int base) {
    v4u w; w.x = pg8::cvt_pk_bf16(v[base + 0], v[base + 1]); w.y = pg8::cvt_pk_bf16(v[base + 2], v[base + 3]); w.z = pg8::cvt_pk_bf16(v[base + 4], v[base + 5]); w.w = pg8::cvt_pk_bf16(v[base + 6], v[base + 7]);
    return __builtin_bit_cast(bf16x8_t, w);
}
__device__ __forceinline__ void ssm_mfma_task(Frame& F, int b, int g, const LAS fl4* tInv, const LAS fl4* tW, bf16* ygo, int c_light, int c_begin, int c_end) {
    const int lane = F.lane, j = lane & 31, hw = lane >> 5;
    const bf16* pu = (const bf16*)(F.ws + WS_PROJ) + (size_t)(b * SEQ) * NPROJ + U_OFF + g * 16;
    bf16x8_t bc[4], ca[4][2], tri[2];
#pragma unroll
    for (int nt = 0; nt < 4; ++nt) bc[nt] = *(const bf16x8_t*)((const bf16*)(F.ws + WS_BCAT) + (size_t)((g * 128 + nt * 32 + j) * 16 + 8 * hw));
#pragma unroll
    for (int q = 0; q < 4; ++q)
#pragma unroll
        for (int s = 0; s < 2; ++s) ca[q][s] = *(const bf16x8_t*)((const bf16*)(F.ws + WS_CA) + (size_t)((((g * 4 + q) * 2 + s) * 64 + lane) * 8));
#pragma unroll
    for (int s = 0; s < 2; ++s) { v4u w;
        unsigned hv[8];
#pragma unroll
        for (int e = 0; e < 8; ++e) { const int i = 8 * (2 * s + (e >> 2)) + 4 * hw + (e & 3); hv[e] = (i <= j) ? 0x3F80u : 0u; }
        w.x = hv[0] | (hv[1] << 16); w.y = hv[2] | (hv[3] << 16); w.z = hv[4] | (hv[5] << 16); w.w = hv[6] | (hv[7] << 16);
        tri[s] = __builtin_bit_cast(bf16x8_t, w); }
    float2 a32[2];
#pragma unroll
    for (int pt = 0; pt < 2; ++pt) a32[pt] = ((const float2*)(F.ws + WS_TABA32))[g * 64 + pt * 32 + j];
    float dv[8];
#pragma unroll
    for (int k = 0; k < 8; ++k) dv[k] = F.in[I_D][g * 16 + (k & 3) + 8 * (k >> 2) + 4 * hw];
    float hcr[2] = {0.f, 0.f}, hci[2] = {0.f, 0.f};
    const bf16* pl = pu + (size_t)j * NPROJ;
    if (c_light < c_begin) {
        bf16x8_t ul = *(const bf16x8_t*)(pl + (size_t)c_light * 32 * NPROJ + 8 * hw);
#pragma unroll 1
        for (int c = c_light; c < c_begin; ++c) {
            const bf16x8_t ulc = ul;
            if (c + 1 < c_begin) ul = *(const bf16x8_t*)(pl + (size_t)(c + 1) * 32 * NPROJ + 8 * hw);
            f32x16_t d[4];
#pragma unroll
            for (int nt = 0; nt < 4; ++nt) { f32x16_t z = {}; d[nt] = __builtin_amdgcn_mfma_f32_32x32x16_bf16(ulc, bc[nt], z, 0, 0, 0); }
#pragma unroll
            for (int pt = 0; pt < 2; ++pt) { float sr = 0.f, si = 0.f;
                fl2 sr2 = {0.f, 0.f}, si2 = {0.f, 0.f};
#pragma unroll
                for (int rp = 0; rp < 8; ++rp) { const fl4 w = tInv[(pt * 8 + rp) * 64 + lane]; const fl2 wre = {w.x, w.y}, wim = {w.z, w.w};
                    const fl2 re = {d[pt][2 * rp], d[pt][2 * rp + 1]}, im = {d[2 + pt][2 * rp], d[2 + pt][2 * rp + 1]}; sr2 += wre * re - wim * im; si2 += wre * im + wim * re; }
                sr = sr2.x + sr2.y; si = si2.x + si2.y;
                sr += __shfl_xor(sr, 32); si += __shfl_xor(si, 32);
                sr += hcr[pt]; si += hci[pt];
                hcr[pt] = a32[pt].x * sr - a32[pt].y * si; hci[pt] = a32[pt].x * si + a32[pt].y * sr; }
        }
    }
    const bf16* pf = pl + (size_t)c_begin * 32 * NPROJ;
    bf16x8_t ua = *(const bf16x8_t*)(pf + 8 * hw);
#pragma unroll 1
    for (int c = c_begin; c < c_end; ++c) {
        const bf16x8_t uac = ua;
        if (c + 1 < c_end) { const bf16* pn = pl + (size_t)(c + 1) * 32 * NPROJ; ua = *(const bf16x8_t*)(pn + 8 * hw); }
        v2u uc0, uc1; { const v4u ud = __builtin_bit_cast(v4u, uac); const auto sx = __builtin_amdgcn_permlane32_swap(ud.x, ud.z, false, false), sy = __builtin_amdgcn_permlane32_swap(ud.y, ud.w, false, false);
            uc0.x = sx[0]; uc0.y = sy[0]; uc1.x = sx[1]; uc1.y = sy[1]; }
        f32x16_t d[4];
#pragma unroll
        for (int nt = 0; nt < 4; ++nt) { f32x16_t z = {}; d[nt] = __builtin_amdgcn_mfma_f32_32x32x16_bf16(uac, bc[nt], z, 0, 0, 0); }
#pragma unroll
        for (int pt = 0; pt < 2; ++pt) { float sr = 0.f, si = 0.f;
            fl2 sr2 = {0.f, 0.f}, si2 = {0.f, 0.f};
#pragma unroll
            for (int rp = 0; rp < 8; ++rp) { const fl4 w = tInv[(pt * 8 + rp) * 64 + lane]; const fl2 wre = {w.x, w.y}, wim = {w.z, w.w};
                const fl2 re = {d[pt][2 * rp], d[pt][2 * rp + 1]}, im = {d[2 + pt][2 * rp], d[2 + pt][2 * rp + 1]};
                fl2 xr = wre * re - wim * im, xi = wre * im + wim * re;
                if (rp == 0) { xr.x += (hw == 0) ? hcr[pt] : 0.f; xi.x += (hw == 0) ? hci[pt] : 0.f; }
                d[pt][2 * rp] = xr.x; d[pt][2 * rp + 1] = xr.y; d[2 + pt][2 * rp] = xi.x; d[2 + pt][2 * rp + 1] = xi.y; sr2 += xr; si2 += xi; }
            sr = sr2.x + sr2.y; si = si2.x + si2.y;
            sr += __shfl_xor(sr, 32); si += __shfl_xor(si, 32);
            hcr[pt] = a32[pt].x * sr - a32[pt].y * si; hci[pt] = a32[pt].x * si + a32[pt].y * sr; }
        f32x16_t st[4];
#pragma unroll
        for (int q = 0; q < 4; ++q) { f32x16_t z = {}; st[q] = __builtin_amdgcn_mfma_f32_32x32x16_bf16(ssm_pack8(d[q], 0), tri[0], z, 0, 0, 0);
            st[q] = __builtin_amdgcn_mfma_f32_32x32x16_bf16(ssm_pack8(d[q], 8), tri[1], st[q], 0, 0, 0); }
#pragma unroll
        for (int pt = 0; pt < 2; ++pt)
#pragma unroll
            for (int rp = 0; rp < 8; ++rp) { const fl4 w = tW[(pt * 8 + rp) * 64 + lane]; const fl2 wre = {w.x, w.y}, wim = {w.z, w.w};
                const fl2 sre = {st[pt][2 * rp], st[pt][2 * rp + 1]}, sim = {st[2 + pt][2 * rp], st[2 + pt][2 * rp + 1]};
                const fl2 hr = wre * sre - wim * sim, hi = wre * sim + wim * sre;
                st[pt][2 * rp] = hr.x; st[pt][2 * rp + 1] = hr.y; st[2 + pt][2 * rp] = hi.x; st[2 + pt][2 * rp + 1] = hi.y; }
        f32x16_t y = {};
#pragma unroll
        for (int q = 0; q < 4; ++q) { y = __builtin_amdgcn_mfma_f32_32x32x16_bf16(ca[q][0], ssm_pack8(st[q], 0), y, 0, 0, 0); y = __builtin_amdgcn_mfma_f32_32x32x16_bf16(ca[q][1], ssm_pack8(st[q], 8), y, 0, 0, 0); }
        float o[8];
        o[0] = y[0] + dv[0] * bflo(uc0.x); o[1] = y[1] + dv[1] * bfhi(uc0.x); o[2] = y[2] + dv[2] * bflo(uc0.y); o[3] = y[3] + dv[3] * bfhi(uc0.y);
        o[4] = y[4] + dv[4] * bflo(uc1.x); o[5] = y[5] + dv[5] * bfhi(uc1.x); o[6] = y[6] + dv[6] * bflo(uc1.y); o[7] = y[7] + dv[7] * bfhi(uc1.y);
        const pg8::f32x2 g0 = pg8::gelu_pk((pg8::f32x2){o[0], o[1]}), g1 = pg8::gelu_pk((pg8::f32x2){o[2], o[3]}), g2 = pg8::gelu_pk((pg8::f32x2){o[4], o[5]}), g3 = pg8::gelu_pk((pg8::f32x2){o[6], o[7]});
        const unsigned w0x = pg8::cvt_pk_bf16(g0.x, g0.y), w0y = pg8::cvt_pk_bf16(g1.x, g1.y), w1x = pg8::cvt_pk_bf16(g2.x, g2.y), w1y = pg8::cvt_pk_bf16(g3.x, g3.y);
        const auto sx = __builtin_amdgcn_permlane32_swap(w0x, w1x, false, false), sy = __builtin_amdgcn_permlane32_swap(w0y, w1y, false, false);
        v4u wo; wo.x = sx[0]; wo.y = sy[0]; wo.z = sx[1]; wo.w = sy[1];
        *(v4u*)(ygo + (size_t)(b * SEQ + c * 32 + j) * SSMW + g * 16 + 8 * hw) = wo;
    }
}


namespace att {
using bf16x8 = __attribute__((ext_vector_type(8))) short;
using s16x4  = __attribute__((ext_vector_type(4))) short;
using f32x16 = __attribute__((ext_vector_type(16))) float;
using u32x4  = __attribute__((ext_vector_type(4))) unsigned;
constexpr int D = 128, NW = 8, QBLK = 32, KVBLK = 64;
constexpr float SCALE = 0.088388347648318440f;
constexpr float THR = 8.f;
constexpr int LDK = NPROJ;
constexpr int SHM_V = KVBLK * D * 2, SHM_K = KVBLK * D * 2, SHM_ATTN = 2 * SHM_V + 2 * SHM_K + NW * 64 * 4;
#define KSWZ(row, colB) ((row) * 256 + ((colB) ^ (((row) & 7) << 4)))
#define SBAR() __builtin_amdgcn_sched_barrier(0)
__device__ __forceinline__ int crow(int r, int hi) { return (r & 3) + 8 * (r >> 2) + 4 * hi; }
__device__ __forceinline__ unsigned cvtpk(float lo, float hi) { unsigned r; asm volatile("v_cvt_pk_bf16_f32 %0, %1, %2" : "=v"(r) : "v"(lo), "v"(hi)); return r; }

__device__ __forceinline__ void partialSM(f32x16& p0, f32x16& p1, float& m_reg, float& mn, float& alpha, float base) {
  constexpr float C = SCALE * 1.4426950408889634f;
  float pm0 = p0[0], pm1 = p0[1], pm2 = p0[2], pm3 = p0[3];
#define MX3(a, b, c) __builtin_fmaxf(__builtin_fmaxf(a, b), c)
  pm0 = MX3(pm0, p0[4], p0[8]); pm1 = MX3(pm1, p0[5], p0[9]); pm2 = MX3(pm2, p0[6], p0[10]); pm3 = MX3(pm3, p0[7], p0[11]);
  pm0 = MX3(pm0, p0[12], p1[0]); pm1 = MX3(pm1, p0[13], p1[1]); pm2 = MX3(pm2, p0[14], p1[2]); pm3 = MX3(pm3, p0[15], p1[3]);
  pm0 = MX3(pm0, p1[4], p1[8]); pm1 = MX3(pm1, p1[5], p1[9]); pm2 = MX3(pm2, p1[6], p1[10]); pm3 = MX3(pm3, p1[7], p1[11]);
  pm0 = MX3(pm0, p1[12], p1[13]); pm1 = MX3(pm1, p1[14], p1[15]);
  float pmax = MX3(pm0, pm1, pm2); pmax = fmaxf(pmax, pm3);
#undef MX3
  pmax += base;
  { auto rr = __builtin_amdgcn_permlane32_swap(__float_as_uint(pmax), __float_as_uint(pmax), false, false);
    pmax = fmaxf(__uint_as_float(rr[0]), __uint_as_float(rr[1])); }
  if (__builtin_expect(__all(pmax - m_reg <= THR / SCALE), 1)) { mn = m_reg; alpha = 1.f; }
  else { mn = fmaxf(m_reg, pmax); alpha = __builtin_amdgcn_exp2f((m_reg - mn) * C); m_reg = mn; }
  float mnC = (base - mn) * C;
  for (int r = 0; r < 16; ++r) p0[r] = fmaf(p0[r], C, mnC); for (int r = 0; r < 16; ++r) p1[r] = fmaf(p1[r], C, mnC);
  for (int r = 0; r < 16; ++r) p0[r] = __builtin_amdgcn_exp2f(p0[r]);
}
__device__ __forceinline__ void finishSM(f32x16& p0, f32x16& p1, float alpha, float& l_reg, bf16x8& pa0, bf16x8& pa1, bf16x8& pa2, bf16x8& pa3) {
  for (int r = 0; r < 16; ++r) p1[r] = __builtin_amdgcn_exp2f(p1[r]);
  float ps = 0; for (int r = 0; r < 16; ++r) ps += p0[r]; for (int r = 0; r < 16; ++r) ps += p1[r];
  { auto rr = __builtin_amdgcn_permlane32_swap(__float_as_uint(ps), __float_as_uint(ps), false, false);
    ps = __uint_as_float(rr[0]) + __uint_as_float(rr[1]); }
  l_reg = l_reg * alpha + ps;
#define PK4(P, BASE, OUT) do { unsigned a0 = cvtpk(P[BASE + 0], P[BASE + 1]), a1 = cvtpk(P[BASE + 2], P[BASE + 3]);   \
    unsigned b0 = cvtpk(P[BASE + 4], P[BASE + 5]), b1 = cvtpk(P[BASE + 6], P[BASE + 7]);                              \
    auto r0 = __builtin_amdgcn_permlane32_swap(a0, b0, false, false); auto r1 = __builtin_amdgcn_permlane32_swap(a1, b1, false, false); \
    u32x4 w = {r0[0], r1[0], r0[1], r1[1]}; OUT = *reinterpret_cast<bf16x8*>(&w); } while (0)
  PK4(p0, 0, pa0); PK4(p0, 8, pa1); PK4(p1, 0, pa2); PK4(p1, 8, pa3);
#undef PK4
}
__device__ __forceinline__ void qkt(f32x16& p0, f32x16& p1, const bf16* Ks, const bf16x8* qr, int r32, int hi, float slopeS, v2u mw) {
  p0 = f32x16{}; p1 = f32x16{};
  for (int d0 = 0; d0 < 8; ++d0) { int cb = (d0 * 16 + hi * 8) * 2;
    bf16x8 b0 = *reinterpret_cast<const bf16x8*>((const char*)Ks + KSWZ(r32, cb));
    bf16x8 b1 = *reinterpret_cast<const bf16x8*>((const char*)Ks + KSWZ(32 + r32, cb));
    p0 = __builtin_amdgcn_mfma_f32_32x32x16_bf16(b0, qr[d0], p0, 0, 0, 0);
    p1 = __builtin_amdgcn_mfma_f32_32x32x16_bf16(b1, qr[d0], p1, 0, 0, 0); }
  const unsigned s0 = mw.x >> (4 * hi), s1 = mw.y >> (4 * hi); const float NEG = -__builtin_inff();
#pragma unroll
  for (int r = 0; r < 16; ++r) { const int cr = (r & 3) + 8 * (r >> 2);
    const unsigned m0 = (unsigned)(((int)(s0 << (31 - cr))) >> 31), m1 = (unsigned)(((int)(s1 << (31 - cr))) >> 31);
    p0[r] = __uint_as_float((m0 & __float_as_uint(fmaf(slopeS, (float)cr, p0[r]))) | (~m0 & 0xFF800000u));
    p1[r] = __uint_as_float((m1 & __float_as_uint(fmaf(slopeS, (float)(32 + cr), p1[r]))) | (~m1 & 0xFF800000u)); }
  (void)NEG;
}
__device__ __forceinline__ int v_st(int k, int c) { const int kk = (k & ~0xC) | ((k & 4) << 1) | ((k & 8) >> 1); return ((kk >> 3) * 4 + (c >> 5)) * 512 + ((kk & 7) * 32 + (c & 31)) * 2; }
__device__ __forceinline__ int v_rd_base(int lane) { return ((lane & 3) << 3) | (((lane >> 2) & 3) << 6) | (((lane >> 4) & 1) << 5) | (((lane >> 5) & 1) << 8); }
constexpr int v_rd_off(int d0, int ks, int half) { return d0 * 512 + ks * 4096 + half * 2048; }
template <int OFF> __device__ __forceinline__ s16x4 tr_read(int vb) {
  s16x4 r; asm volatile("ds_read_b64_tr_b16 %0, %1 offset:%2" : "=&v"(r) : "v"(vb), "i"(OFF) : "memory"); return r;
}
template <int D0> __device__ __forceinline__ void pv_one(f32x16& od, int vb, bf16x8 pa0, bf16x8 pa1, bf16x8 pa2, bf16x8 pa3) {
  const s16x4 l0 = tr_read<v_rd_off(D0, 0, 0)>(vb), h0 = tr_read<v_rd_off(D0, 0, 1)>(vb), l1 = tr_read<v_rd_off(D0, 1, 0)>(vb), h1 = tr_read<v_rd_off(D0, 1, 1)>(vb);
  const s16x4 l2 = tr_read<v_rd_off(D0, 2, 0)>(vb), h2 = tr_read<v_rd_off(D0, 2, 1)>(vb), l3 = tr_read<v_rd_off(D0, 3, 0)>(vb), h3 = tr_read<v_rd_off(D0, 3, 1)>(vb);
  asm volatile("s_waitcnt lgkmcnt(0)" ::: "memory"); SBAR();
#define PK(L, H) (bf16x8){L[0], L[1], L[2], L[3], H[0], H[1], H[2], H[3]}
  od = __builtin_amdgcn_mfma_f32_32x32x16_bf16(pa0, PK(l0, h0), od, 0, 0, 0);
  od = __builtin_amdgcn_mfma_f32_32x32x16_bf16(pa1, PK(l1, h1), od, 0, 0, 0);
  od = __builtin_amdgcn_mfma_f32_32x32x16_bf16(pa2, PK(l2, h2), od, 0, 0, 0);
  od = __builtin_amdgcn_mfma_f32_32x32x16_bf16(pa3, PK(l3, h3), od, 0, 0, 0);
#undef PK
}
__device__ __forceinline__ void pv_d0(f32x16* o, int vb, bf16x8 pa0, bf16x8 pa1, bf16x8 pa2, bf16x8 pa3) {
  pv_one<0>(o[0], vb, pa0, pa1, pa2, pa3); pv_one<1>(o[1], vb, pa0, pa1, pa2, pa3); pv_one<2>(o[2], vb, pa0, pa1, pa2, pa3); pv_one<3>(o[3], vb, pa0, pa1, pa2, pa3);
}
__device__ __forceinline__ void attn_mask_body(const bf16* __restrict__ Qb, const bf16* __restrict__ Kh, const bf16* __restrict__ Vh, const unsigned* __restrict__ Mb,
                                               unsigned char* __restrict__ Ob, int seq, float slopeS, char* lds) {
  const int tid = threadIdx.x, wid = tid >> 6, lane = tid & 63, r32 = lane & 31, hi = lane >> 5;
  bf16* V_lds = (bf16*)lds; bf16* K_lds = (bf16*)(lds + 2 * SHM_V);
  float* ws = (float*)(lds + 2 * SHM_V + 2 * SHM_K) + wid * 64; float* li_l = ws; float* al_l = ws + 32;
  float m_reg = -1e30f, l_reg = 0; f32x16 o[4] = {}; bf16x8 qr[8];
  const bf16* Qw = Qb + (long)(wid * QBLK + r32) * NPROJ + hi * 8;
#pragma unroll
  for (int d0 = 0; d0 < 8; ++d0) qr[d0] = *reinterpret_cast<const bf16x8*>(Qw + d0 * 16);
  const unsigned mvoff = (unsigned)(wid * QBLK + r32) * 256u;
#define MWLD(j) __builtin_bit_cast(v2u, __builtin_amdgcn_raw_buffer_load_b64(rm, mvoff, (j) * 8, 0))
  const float hb = slopeS * (float)(4 * hi);
  const int sr = tid >> 4, sc = (tid & 15) * 8, vst0 = v_st(sr, sc), vst1 = v_st(32 + sr, sc);
  const int vb0 = (int)(uintptr_t)V_lds + v_rd_base(lane);
  struct { bf16x8 vs0, vs1, ks0, ks1; } sr_[2];
  const unsigned kvoff = (unsigned)(sr * LDK + sc) * 2u;
  const __amdgpu_buffer_rsrc_t rk = __builtin_amdgcn_make_buffer_rsrc((void*)Kh, 0, SEQ * NPROJ * 2, 0x00020000);
  const __amdgpu_buffer_rsrc_t rv = __builtin_amdgcn_make_buffer_rsrc((void*)Vh, 0, SEQ * NPROJ * 2, 0x00020000);
  const __amdgpu_buffer_rsrc_t rm = __builtin_amdgcn_make_buffer_rsrc((void*)Mb, 0, 256 * 256, 0x00020000);
#define BL16(rs, so) __builtin_bit_cast(bf16x8, __builtin_amdgcn_raw_buffer_load_b128(rs, kvoff, (so), 0))
#define SLOAD(i, k0) do { const int so_ = (k0) * (LDK * 2); \
    sr_[i].vs0 = BL16(rv, so_); sr_[i].vs1 = BL16(rv, so_ + 32 * LDK * 2); sr_[i].ks0 = BL16(rk, so_); sr_[i].ks1 = BL16(rk, so_ + 32 * LDK * 2); } while (0)
#define SWRITE(b, i) do { *(bf16x8*)((char*)V_lds + (b) * SHM_V + vst0) = sr_[i].vs0;          \
    *(bf16x8*)((char*)V_lds + (b) * SHM_V + vst1) = sr_[i].vs1; int kc = sc * 2;               \
    *(bf16x8*)((char*)K_lds + (b) * SHM_K + KSWZ(sr, kc)) = sr_[i].ks0;                       \
    *(bf16x8*)((char*)K_lds + (b) * SHM_K + KSWZ(32 + sr, kc)) = sr_[i].ks1; } while (0)
#define SWAIT() asm volatile("s_waitcnt vmcnt(4)" ::: "memory")
#define RESC(a) do { if (__any((a) < 1.f)) { if (hi == 0) al_l[r32] = (a); asm volatile("s_waitcnt lgkmcnt(0)" ::: "memory"); \
    for (int d = 0; d < 4; ++d) for (int r = 0; r < 16; ++r) o[d][r] *= al_l[crow(r, hi)]; } } while (0)
#define TBASE(j) fmaf(slopeS, (float)(64 * (j)), hb)
  f32x16 pA0, pA1, pB0, pB1; float mnA, mnB, alA, alB; bf16x8 pa0, pa1, pa2, pa3; const int NT = seq / KVBLK;
  constexpr int SE = 0, SO = 1;
  v2u mwA = MWLD(0), mwB = MWLD(1);
  SLOAD(SE, 0); asm volatile("s_waitcnt vmcnt(0)" ::: "memory"); SWRITE(0, SE); __syncthreads();
  qkt(pA0, pA1, K_lds, qr, r32, hi, slopeS, mwA); partialSM(pA0, pA1, m_reg, mnA, alA, TBASE(0));
  SLOAD(SO, KVBLK); if (2 < NT) SLOAD(SE, 2 * KVBLK);
  SWAIT(); SWRITE(1, SO); __syncthreads();
  for (int j = 1; j + 1 < NT; j += 2) {
    mwA = MWLD(j + 1);
    SBAR(); qkt(pB0, pB1, (bf16*)((char*)K_lds + SHM_K), qr, r32, hi, slopeS, mwB);
    finishSM(pA0, pA1, alA, l_reg, pa0, pa1, pa2, pa3); SBAR();
    SLOAD(SO, (j + 2) * KVBLK); SBAR();
    pv_d0(o, vb0, pa0, pa1, pa2, pa3); partialSM(pB0, pB1, m_reg, mnB, alB, TBASE(j));
    __syncthreads(); SWAIT(); SWRITE(0, SE);
    RESC(alB); __syncthreads();
    mwB = MWLD(j + 2);
    SBAR(); qkt(pA0, pA1, K_lds, qr, r32, hi, slopeS, mwA);
    finishSM(pB0, pB1, alB, l_reg, pa0, pa1, pa2, pa3); SBAR();
    if (j + 3 < NT) SLOAD(SE, (j + 3) * KVBLK); SBAR();
    pv_d0(o, vb0 + (int)SHM_V, pa0, pa1, pa2, pa3); partialSM(pA0, pA1, m_reg, mnA, alA, TBASE(j + 1));
    __syncthreads(); SWAIT(); SWRITE(1, SO);
    RESC(alA); __syncthreads();
  }
  SBAR(); qkt(pB0, pB1, (bf16*)((char*)K_lds + SHM_K), qr, r32, hi, slopeS, mwB);
  finishSM(pA0, pA1, alA, l_reg, pa0, pa1, pa2, pa3); SBAR();
  pv_d0(o, vb0, pa0, pa1, pa2, pa3); partialSM(pB0, pB1, m_reg, mnB, alB, TBASE(NT - 1));
  __syncthreads(); RESC(alB);
  finishSM(pB0, pB1, alB, l_reg, pa0, pa1, pa2, pa3); SBAR();
  pv_d0(o, vb0 + (int)SHM_V, pa0, pa1, pa2, pa3);
  if (hi == 0) li_l[r32] = l_reg; asm volatile("s_waitcnt lgkmcnt(0)" ::: "memory");
  float rli[16];
#pragma unroll
  for (int r = 0; r < 16; ++r) rli[r] = __builtin_amdgcn_rcpf(li_l[crow(r, hi)]);
  unsigned char* Ow = Ob + (long)(wid * QBLK) * 2048;
#pragma unroll
  for (int r = 0; r < 16; ++r) { int orow = crow(r, hi); const float sc = rli[r] * SC_MIX;
    const unsigned w = pk4_fp8(o[0][r] * sc, o[1][r] * sc, o[2][r] * sc, o[3][r] * sc);
    for (int d0 = 0; d0 < 4; ++d0) Ow[(long)orow * 2048 + d0 * 32 + r32] = (unsigned char)(w >> (8 * d0)); }
#undef SLOAD
#undef SWRITE
#undef SWAIT
#undef RESC
#undef TBASE
#undef MWLD
#undef BL16
}
#undef KSWZ
#undef SBAR
}

template <bool OUT_BF16, bool IN_BF16 = false>
__device__ __forceinline__ void ln_row(const void* xrow, void* orow, const float* gam, const float* bet, int lane, unsigned* q8row = nullptr, float q8scale = 1.f) {
    const f32x4* xr = (const f32x4*)xrow + lane; const v2u* xh = (const v2u*)xrow + lane; const f32x4* gr = (const f32x4*)gam + lane; const f32x4* br = (const f32x4*)bet + lane;
    f32x4 v[8]; float s = 0.f;
#pragma unroll
    for (int j = 0; j < 8; ++j) { if constexpr (IN_BF16) { const v2u w = xh[64 * j]; v[j] = (f32x4){bflo(w.x), bfhi(w.x), bflo(w.y), bfhi(w.y)}; } else v[j] = xr[64 * j];
        s += (v[j][0] + v[j][1]) + (v[j][2] + v[j][3]); }
    const float mean = wave_sum(s) * (1.f / DM); float s2 = 0.f;
#pragma unroll
    for (int j = 0; j < 8; ++j) { v[j] = v[j] - mean; s2 += (v[j][0] * v[j][0] + v[j][1] * v[j][1]) + (v[j][2] * v[j][2] + v[j][3] * v[j][3]); }
    const float rstd = 1.f / sqrtf(wave_sum(s2) * (1.f / DM) + LN_EPS);
#pragma unroll
    for (int j = 0; j < 8; ++j) { const f32x4 o = v[j] * rstd * gr[64 * j] + br[64 * j];
        if constexpr (OUT_BF16) { v2u w; w.x = pk2(o[0], o[1]); w.y = pk2(o[2], o[3]); ((v2u*)orow)[lane + 64 * j] = w;
            if (q8row) q8row[lane + 64 * j] = pk4_fp8(o[0] * q8scale, o[1] * q8scale, o[2] * q8scale, o[3] * q8scale); }
        else ((f32x4*)orow)[lane + 64 * j] = o; }
}
template <bool OUT_BF16, bool IN_BF16 = false>
__device__ __forceinline__ void ln_row2(const void* xa, const void* xb_, void* oa, void* ob, const float* gam, const float* bet, int lane, unsigned* qa = nullptr, unsigned* qb = nullptr, float q8scale = 1.f, float2* sa = nullptr, float2* sb = nullptr) {
    const f32x4* gr = (const f32x4*)gam + lane; const f32x4* br = (const f32x4*)bet + lane;
    f32x4 v[2][8]; float s[2] = {0.f, 0.f};
#pragma unroll
    for (int r = 0; r < 2; ++r) { const void* xrow = r ? xb_ : xa; const f32x4* xr = (const f32x4*)xrow + lane; const v2u* xh = (const v2u*)xrow + lane;
#pragma unroll
        for (int j = 0; j < 8; ++j) { if constexpr (IN_BF16) { const v2u w = OUT_BF16 ? xh[64 * j] : __builtin_nontemporal_load(&xh[64 * j]); v[r][j] = (f32x4){bflo(w.x), bfhi(w.x), bflo(w.y), bfhi(w.y)}; } else v[r][j] = xr[64 * j]; } }
#pragma unroll
    for (int r = 0; r < 2; ++r)
#pragma unroll
        for (int j = 0; j < 8; ++j) s[r] += (v[r][j][0] + v[r][j][1]) + (v[r][j][2] + v[r][j][3]);
    const float mean0 = wave_sum(s[0]) * (1.f / DM), mean1 = wave_sum(s[1]) * (1.f / DM); float s2[2] = {0.f, 0.f};
#pragma unroll
    for (int r = 0; r < 2; ++r) { const float mean = r ? mean1 : mean0;
#pragma unroll
        for (int j = 0; j < 8; ++j) { v[r][j] = v[r][j] - mean; s2[r] += (v[r][j][0] * v[r][j][0] + v[r][j][1] * v[r][j][1]) + (v[r][j][2] * v[r][j][2] + v[r][j][3] * v[r][j][3]); } }
    const float rstd0 = 1.f / sqrtf(wave_sum(s2[0]) * (1.f / DM) + LN_EPS), rstd1 = 1.f / sqrtf(wave_sum(s2[1]) * (1.f / DM) + LN_EPS);
    if (sa && lane == 0) { *sa = make_float2(mean0, rstd0); *sb = make_float2(mean1, rstd1); }
#pragma unroll
    for (int j = 0; j < 8; ++j) { const f32x4 g = gr[64 * j], b = br[64 * j];
#pragma unroll
        for (int r = 0; r < 2; ++r) { const f32x4 o = v[r][j] * (r ? rstd1 : rstd0) * g + b; void* orow = r ? ob : oa; unsigned* q8row = r ? qb : qa;
            if constexpr (OUT_BF16) { if (orow) { v2u w; w.x = pk2(o[0], o[1]); w.y = pk2(o[2], o[3]); ((v2u*)orow)[lane + 64 * j] = w; }
                if (q8row) q8row[lane + 64 * j] = pk4_fp8(o[0] * q8scale, o[1] * q8scale, o[2] * q8scale, o[3] * q8scale); }
            else __builtin_nontemporal_store(o, &((f32x4*)orow)[lane + 64 * j]); } }
}
__device__ __forceinline__ float gelu_erf(float v) { return 0.5f * v * (1.0f + erff(v * 0.70710678118654752f)); }

__device__ __forceinline__ void ln_row2_mx6(const bf16* ra, const bf16* rb, const f32x4 (&g8)[8], const f32x4 (&b8)[8], int lane, unsigned char* qa, unsigned char* qb, float2* sa, float2* sb) {
    float v[2][32];
#pragma unroll
    for (int q = 0; q < 2; ++q) { const v4u* rp = (const v4u*)((q ? rb : ra) + 32 * lane);
#pragma unroll
        for (int j = 0; j < 4; ++j) { const v4u w = rp[j]; v[q][8 * j] = bflo(w.x); v[q][8 * j + 1] = bfhi(w.x); v[q][8 * j + 2] = bflo(w.y); v[q][8 * j + 3] = bfhi(w.y);
            v[q][8 * j + 4] = bflo(w.z); v[q][8 * j + 5] = bfhi(w.z); v[q][8 * j + 6] = bflo(w.w); v[q][8 * j + 7] = bfhi(w.w); } }
    float s0 = 0.f, s1 = 0.f;
#pragma unroll
    for (int i = 0; i < 32; ++i) { s0 += v[0][i]; s1 += v[1][i]; }
    const float mean0 = wave_sum(s0) * (1.f / DM), mean1 = wave_sum(s1) * (1.f / DM);
    float t0 = 0.f, t1 = 0.f;
#pragma unroll
    for (int i = 0; i < 32; ++i) { const float d0 = v[0][i] - mean0, d1 = v[1][i] - mean1; t0 = fmaf(d0, d0, t0); t1 = fmaf(d1, d1, t1); }
    const float rstd0 = 1.f / sqrtf(wave_sum(t0) * (1.f / DM) + LN_EPS), rstd1 = 1.f / sqrtf(wave_sum(t1) * (1.f / DM) + LN_EPS);
    if (lane == 0) { *sa = make_float2(mean0, rstd0); *sb = make_float2(mean1, rstd1); }
    v16f32 x0, y0, x1, y1;
#pragma unroll
    for (int j = 0; j < 8; ++j) { const f32x4 g = g8[j], b = b8[j];
#pragma unroll
        for (int e = 0; e < 4; ++e) { const int i = 4 * j + e; const float o0 = (v[0][i] - mean0) * rstd0 * g[e] + b[e], o1 = (v[1][i] - mean1) * rstd1 * g[e] + b[e];
            if (i < 16) { x0[i] = o0; x1[i] = o1; } else { y0[i - 16] = o0; y1[i - 16] = o1; } } }
    float a0, a1; MX6_AMAX(x0, y0, a0); MX6_AMAX(x1, y1, a1);
    mx6_store_block(qa, lane, x0, y0, a0); mx6_store_block(qb, lane, x1, y1, a1);
}

__device__ __forceinline__ void pretouch(Frame& F, const void* p, size_t bytes) {
    const unsigned* q = (const unsigned*)p; const size_t n = bytes / 128; unsigned acc = 0u;
#pragma unroll 4
    for (size_t i = (size_t)F.vcu * 512 + F.tid; i < n; i += (size_t)F.G * 512) acc ^= q[i * 32];
    asm volatile("" :: "v"(acc));
}
struct Args { const float* in[22]; float* out; unsigned char* ws; int ph_lo, ph_hi; };
constexpr int N_PHASES = 11;
__global__ void __launch_bounds__(NWAVES * 64, 2) mk_fwd(Args args) {
    extern __shared__ __attribute__((aligned(16))) unsigned char lds[];
    Frame F;
    F.lds = (LAS unsigned char*)lds;
    F.MISC = (volatile LAS unsigned*)(F.lds + MISC_OFF);
    F.tid = threadIdx.x; F.lane = F.tid & 63; F.wave = __builtin_amdgcn_readfirstlane(F.tid >> 6);
    F.G = gridDim.x; { const int bx = blockIdx.x; F.vcu = (F.G % 8 == 0) ? (bx % 8) * (F.G / 8) + bx / 8 : bx; }
    F.ws = args.ws; F.out = args.out; F.ctl = (unsigned*)(args.ws + WS_CTL);
#pragma unroll
    for (int i = 0; i < 22; ++i) F.in[i] = args.in[i];
    for (int u = F.tid; u < (LDS_BYTES - LDSCTL_OFF) / 4; u += NWAVES * 64) ((LAS unsigned*)(F.lds + LDSCTL_OFF))[u] = 0u;
    __syncthreads();
    const int lo = args.ph_lo, hi = args.ph_hi;
    XcdBarrier bar; bar.bar = F.ctl + CW_BAR; bar.x = 0; bar.st = nullptr;
    if (hi - lo > 1) bar = xcd_barrier_post(F.ctl + CW_BAR, F.MISC + 8);
    if (hi - lo > 1 && F.tid == 0) { const unsigned xg = (unsigned)blockIdx.x & 7u; atomicMax(F.ctl + CW_XCHK + xg, bar.x + 1u); atomicMax(F.ctl + CW_XCHK + 8 + xg, 16u - bar.x); }
    bool seam_local = false;
#define IN(k) (lo <= (k) && (k) < hi)
#define SEAM(k) do { if (IN(k) && IN((k) + 1)) xcd_barrier(bar); } while (0)
#define SEAML(k) do { if (IN(k) && IN((k) + 1)) xcd_barrier(bar, seam_local); } while (0)
    const int gw = F.vcu * NWAVES + F.wave, NGW = F.G * NWAVES;
    bf16* xb = (bf16*)(F.ws + WS_XB); bf16* proj = (bf16*)(F.ws + WS_PROJ); bf16* ygb = (bf16*)(F.ws + WS_YG); unsigned char* mix8 = (unsigned char*)(F.ws + WS_MIX);   unsigned char* act8 = (unsigned char*)(F.ws + WS_ACT);

    if (IN(0)) { p0_prologue(F); } SEAM(0);
    if (IN(0) && IN(1)) { bool okx = (F.G & 7) == 0;
#pragma unroll
        for (int xg = 0; xg < 8; ++xg) okx = okx && (__hip_atomic_load(F.ctl + CW_XCHK + xg, __ATOMIC_RELAXED, __HIP_MEMORY_SCOPE_AGENT) + __hip_atomic_load(F.ctl + CW_XCHK + 8 + xg, __ATOMIC_RELAXED, __HIP_MEMORY_SCOPE_AGENT) == 17u);
        seam_local = okx; }
    if (IN(1)) {
        const int c = (int)blockIdx.x; const bool g256 = (F.G == 256);
        pg8::ListOrder Sb, Sf;
        if (g256) { Sb.init(M, NPROJ - NP8, c, 256, c < 64 ? 2 : 1); Sf.init(M, NP8, c, 192, c < 64 ? 1 : 3); }
        else { Sb.init(M, NPROJ - NP8, c, F.G, 1 << 20); Sf.init(M, NP8, c, F.G, 1 << 20); }
        { pg8::Gemm g{xb, (const bf16*)(F.ws + WS_WIN) + (size_t)NP8 * DM, M, NPROJ - NP8, DM};
          pg8::EpiProj E{proj, NPROJ, (bf16*)(F.ws + WS_KIPACK), KI_OFF, SEQ, NP8, 1.f};
          pg8::gemm_phase<pg8::EpiProj, pg8::ListOrder, true, true, false>(F.lds + RING_OFF, g, Sb, E); }
        { pg8::Gemm g{(const bf16*)(F.ws + WS_MIX + 32 * MiB), (const bf16*)(F.ws + WS_WIN8), M, NP8, DM / 2};
          pg8::EpiProj E{proj, NPROJ, (bf16*)(F.ws + WS_KIPACK), KI_OFF, SEQ, 0, 1.f / (SC_X * SC_WIN)};
          pg8::gemm_phase<pg8::EpiProj, pg8::ListOrder, true, true, true>(F.lds + RING_OFF, g, Sf, E); }
    } SEAM(1);
    if (IN(2)) {
        { const int g = (F.vcu >> 2) & (NG - 1); LAS fl4* tInv = (LAS fl4*)(F.lds + RING_OFF); LAS fl4* tW = tInv + 2 * 8 * 64;
          for (int i = F.tid; i < 1024; i += NWAVES * 64) { tInv[i] = ((const fl4*)(F.ws + WS_TABINV))[g * 1024 + i]; tW[i] = ((const fl4*)(F.ws + WS_TABW))[g * 1024 + i]; }
          const int ib = F.vcu & 7;
          { const v4u* ksrc = (const v4u*)(F.ws + WS_KIPACK + (size_t)ib * 64 * 4096); LAS v4u* kdst = (LAS v4u*)(F.lds + RING_OFF + 32768);
#pragma unroll 4
            for (int i = F.tid; i < IDX_NLDS * 256; i += NWAVES * 64) kdst[i] = ksrc[i]; }
          LDS_WAIT(); __syncthreads();
          if ((F.wave & 2) == 0) { const int bb = 2 * (F.vcu & 3) + (F.wave & 1), half = F.wave >> 2;
              if (F.vcu < 4 * NG) ssm_mfma_task(F, bb, g, tInv, tW, ygb, 0, half ? SEQ / 64 : 0, half ? SEQ / 32 : SEQ / 64); }
          { LAS unsigned* ctr = (LAS unsigned*)(F.lds + MISC_OFF + 64); LAS unsigned* ctr2 = (LAS unsigned*)(F.lds + MISC_OFF + 68); const int ic = F.vcu >> 3, inb = (F.G - ib + 7) >> 3, npb = (SEQ / 2 + inb - 1) / inb;
            const LAS bf16* kl = (const LAS bf16*)(F.lds + RING_OFF + 32768) + F.lane * 8;
#pragma unroll 1
            for (int pass = 0; pass < 3; ++pass) {
                if (pass == 1) {
                    for (;;) { unsigned m = 0; if (F.lane == 0) m = __hip_atomic_fetch_add(ctr, 1u, __ATOMIC_RELAXED, __HIP_MEMORY_SCOPE_WORKGROUP);
                        m = __builtin_amdgcn_readfirstlane(m); if ((int)m >= npb) break;
                        const int k = (int)m * inb + ((m & 1u) ? inb - 1 - ic : ic); if (k >= SEQ / 2) continue;
                        int ibo; asm volatile("s_mov_b32 %0, %1" : "=s"(ibo) : "s"(ib));
                        idx_mfma_pair(F, ibo, 1023 - k, (unsigned*)(F.ws + WS_MASK), kl); }
                } else if (pass == 2 || F.wave == 7) {
                    for (;;) { unsigned m = 0; if (F.lane == 0) m = __hip_atomic_fetch_add(ctr2, 1u, __ATOMIC_RELAXED, __HIP_MEMORY_SCOPE_WORKGROUP);
                        m = __builtin_amdgcn_readfirstlane(m); const int it = (int)m * F.G + F.vcu; if (it >= P2W_ITEMS) break;
                        p2_weight_item(F, it); } }
            } } }
        pretouch(F, F.ws + WS_WGLU, (size_t)SSMW * SSMW * 2);
    } SEAM(2);
    if (IN(3)) {
        const unsigned* maskw = (const unsigned*)(F.ws + WS_MASK);
#pragma unroll 1
        for (int pi = F.vcu; pi < 256; pi += F.G) { const int b = pi >> 5, h = (pi >> 2) & 7, qp = pi & 3, c = h >> 2;
#pragma unroll 1
            for (int half = 0; half < 2; ++half) { const int qb = half ? qp : 7 - qp; const size_t row0 = (size_t)b * SEQ + qb * 256;
                att::attn_mask_body(proj + row0 * NPROJ + Q_OFF + h * HD, proj + (size_t)b * SEQ * NPROJ + K_OFF + c * HD, proj + (size_t)b * SEQ * NPROJ + V_OFF + c * HD,
                                    maskw + row0 * 64, mix8 + row0 * 2048 + 1024 + h * HD, 256 * (qb + 1), exp2f(-(float)(h + 1)) / att::SCALE, (char*)lds + RING_OFF);
                __syncthreads(); } }
    }
    if (IN(4)) { pg8::Gemm g{ygb, (const bf16*)(F.ws + WS_WGLU), M, SSMW, SSMW}; pg8::StaticOrder S; S.init(M, SSMW, F.G, (int)blockIdx.x);
        pg8::EpiGlu E{ygb, mix8, SSMW, 2048, F.in[I_BGLU], SC_MIX};
        pg8::gemm_phase<pg8::EpiGlu, pg8::StaticOrder, true, true>(F.lds + RING_OFF, g, S, E); } SEAM(4);
    if (IN(5)) { pg8::Gemm g{(const bf16*)mix8, (const bf16*)(F.ws + WS_WOUT), M, DM, 2048 / 2}; pg8::StaticOrder S; S.init(M, DM, F.G, (int)blockIdx.x);
        pg8::EpiRes<true, true> E{xb, F.out, DM, DN_ALPHA, 1.f / (SC_MIX * SC_WOUT)};
        pg8::gemm_phase<pg8::EpiRes<true, true>, pg8::StaticOrder, true, true, true>(F.lds + RING_OFF, g, S, E); } SEAML(5);
    if (IN(6)) { unsigned* q8 = (unsigned*)(F.ws + WS_MIX + 32 * MiB); const bf16* r1b = (const bf16*)F.out;
        f32x4 g8[8], b8[8];
#pragma unroll
        for (int j = 0; j < 8; ++j) { g8[j] = ((const f32x4*)(F.in[I_LN1G] + 32 * F.lane))[j]; b8[j] = ((const f32x4*)(F.in[I_LN1B] + 32 * F.lane))[j]; }
        const int ng6 = (F.G & 7) ? 1 : 8, gper = F.G / ng6, rows6 = M / ng6, xg6 = F.vcu / gper, lw6 = (F.vcu - xg6 * gper) * NWAVES + F.wave, nlw6 = gper * NWAVES;
        for (int i6 = lw6; i6 < rows6; i6 += 2 * nlw6) { const int m = xg6 * rows6 + i6, m2 = (i6 + nlw6 < rows6) ? m + nlw6 : m;
            ln_row2_mx6(r1b + (size_t)m * DM, r1b + (size_t)m2 * DM, g8, b8, F.lane, (unsigned char*)q8 + (size_t)m * DM, (unsigned char*)q8 + (size_t)m2 * DM,
                        (float2*)(F.ws + WS_RSTAT) + m, (float2*)(F.ws + WS_RSTAT) + m2); }
        pretouch(F, F.ws + WS_WUG, (size_t)NUG * DM); } SEAML(6);
    if (IN(7)) { pg8::Gemm g{(const bf16*)(F.ws + WS_MIX + 32 * MiB), (const bf16*)(F.ws + WS_WUG), M, NUG, DM / 2}; pg8::StaticOrder S; S.init(M, NUG, F.G, (int)blockIdx.x);
        pg8::EpiFfn E{act8, (float*)(F.ws + WS_PEND_UP), (float*)(F.ws + WS_PEND_G), (float*)(F.ws + WS_HALO), F.in[I_CONVW], F.in[I_CONVB], DFF, 1.f, SC_ACT};
        if (F.G % 8 == 0) { pg8::DynOrder D; D.init(M, NUG, F.G, (int)blockIdx.x, F.ctl + CW_DYN7, (LAS unsigned*)(F.lds + MISC_OFF + 96));
            pg8::gemm_phase<pg8::EpiFfn, pg8::DynOrder, true, true, true, true>(F.lds + RING_OFF, g, D, E); }
        else pg8::gemm_phase<pg8::EpiFfn, pg8::StaticOrder, true, true, true, true>(F.lds + RING_OFF, g, S, E); } SEAML(7);
    if (IN(8)) { const float* pu = (const float*)(F.ws + WS_PEND_UP); const float* pg = (const float*)(F.ws + WS_PEND_G); const float* ph = (const float*)(F.ws + WS_HALO);
        const float* cw = F.in[I_CONVW]; const float* cb = F.in[I_CONVB];
        const int ng8 = (F.G & 7) ? 1 : 8, gper8 = F.G / ng8, rows8 = 512 / ng8, xg8 = F.vcu / gper8;
        for (int i8 = (F.vcu - xg8 * gper8) * 512 + F.tid; i8 < rows8 * (DFF / 4); i8 += gper8 * 512) { const int r2 = xg8 * rows8 + i8 / (DFF / 4), f = (i8 % (DFF / 4)) * 4, rb = r2 >> 1, rho = r2 & 1; const bool first = (rb & 31) == 0;
            const f32x4 x0 = *(const f32x4*)(pu + (size_t)r2 * DFF + f), gt = *(const f32x4*)(pg + (size_t)r2 * DFF + f); const f32x4 z = {0.f, 0.f, 0.f, 0.f};
            f32x4 h1, h2;
            if (rho == 0) { h1 = first ? z : *(const f32x4*)(ph + (size_t)((rb - 1) * 2 + 1) * DFF + f); h2 = first ? z : *(const f32x4*)(ph + (size_t)((rb - 1) * 2) * DFF + f); }
            else { h1 = *(const f32x4*)(pu + (size_t)(rb * 2) * DFF + f); h2 = first ? z : *(const f32x4*)(ph + (size_t)((rb - 1) * 2 + 1) * DFF + f); }
            const f32x4 hc = *(const f32x4*)(cb + f) + *(const f32x4*)(cw + f) * h2 + *(const f32x4*)(cw + DFF + f) * h1 + *(const f32x4*)(cw + 2 * DFF + f) * x0;
            *(unsigned*)(act8 + (size_t)(rb * 64 + rho) * DFF + f) = pk4_fp8(gelu_erf(hc[0]) * gt[0] * SC_ACT, gelu_erf(hc[1]) * gt[1] * SC_ACT, gelu_erf(hc[2]) * gt[2] * SC_ACT, gelu_erf(hc[3]) * gt[3] * SC_ACT); } } SEAML(8);
    if (IN(9)) { pg8::Gemm g{(const bf16*)act8, (const bf16*)(F.ws + WS_WDOWN), M, DM, DFF / 2}; pg8::StaticOrder S; S.init(M, DM, F.G, (int)blockIdx.x);
        pg8::EpiDownLN E{(const bf16*)F.out, (bf16*)(F.ws + WS_XB), (const pg8::f32x2*)(F.ws + WS_RSTAT), F.in[I_LN1G], F.in[I_LN1B], DM, DN_ALPHA, 1.f / (SC_ACT * SC_WDN)};
        pg8::gemm_phase<pg8::EpiDownLN, pg8::StaticOrder, true, true, true>(F.lds + RING_OFF, g, S, E); } SEAM(9);
    if (IN(10)) { const bf16* r2b = (const bf16*)(F.ws + WS_XB);
        for (int m = gw; m < M; m += 2 * NGW) { const int m2 = (m + NGW < M) ? m + NGW : m;
            ln_row2<false, true>(r2b + (size_t)m * DM, r2b + (size_t)m2 * DM, F.out + (size_t)m * DM, F.out + (size_t)m2 * DM, F.in[I_LN2G], F.in[I_LN2B], F.lane); }
    }
#undef IN
#undef SEAM
}

#ifndef MK_ONE_LAUNCH
#define MK_ONE_LAUNCH 1
#endif
extern "C" void kernel_launch(void* const* d_in, const int* in_sizes, int n_in, void* d_out, int out_size, void* d_ws, size_t ws_size, hipStream_t stream) {
    static int grid = 0;
    if (grid == 0) {
        if (n_in != 22 || in_sizes[0] != M * DM || out_size != M * DM || ws_size < WS_END) { fprintf(stderr, "kernel_launch: shape/workspace mismatch (n_in %d, in0 %d, out %d, ws %zu, need %zu)\n", n_in, n_in > 0 ? in_sizes[0] : -1, out_size, ws_size, (size_t)WS_END); grid = -1; return; }
        int dev = 0, cus = 0, per_cu = 0;
        if (hipGetDevice(&dev) != hipSuccess || hipDeviceGetAttribute(&cus, hipDeviceAttributeMultiprocessorCount, dev) != hipSuccess) { grid = -1; return; }
        if (hipFuncSetAttribute((const void*)mk_fwd, hipFuncAttributeMaxDynamicSharedMemorySize, LDS_BYTES) != hipSuccess) { fprintf(stderr, "kernel_launch: hipFuncSetAttribute failed\n"); grid = -1; return; }
        if (hipOccupancyMaxActiveBlocksPerMultiprocessor(&per_cu, (const void*)mk_fwd, NWAVES * 64, LDS_BYTES) != hipSuccess || per_cu < 1) fprintf(stderr, "kernel_launch: occupancy query reports %d\n", per_cu);
        (void)hipGetLastError();
        grid = cus;
    }
    if (grid < 0) return;
    if (hipMemsetAsync((char*)d_ws + WS_CTL, 0, CTL_ZERO_BYTES, stream) != hipSuccess) return;
    Args a{};
    for (int i = 0; i < 22; ++i) a.in[i] = (const float*)d_in[i];
    a.out = (float*)d_out; a.ws = (unsigned char*)d_ws;
#if MK_ONE_LAUNCH
    a.ph_lo = 0; a.ph_hi = N_PHASES;
    hipLaunchKernelGGL(mk_fwd, dim3(grid), dim3(NWAVES * 64), LDS_BYTES, stream, a);
#else
    for (int p = 0; p < N_PHASES; ++p) { a.ph_lo = p; a.ph_hi = p + 1; hipLaunchKernelGGL(mk_fwd, dim3(grid), dim3(NWAVES * 64), LDS_BYTES, stream, a); }
#endif
}
```
